# Optimizing an MI355X kernel written in HIP

```python
import math
import jax
import jax.numpy as jnp
from jax import lax
import numpy as np

D_MODEL = 1024
BATCH = 4
SEQ = 4096
DEPTH = 4

GRID_W = 64
CTX_LEN = 256
N_EVEN = (DEPTH + 1) // 2
N_ODD = DEPTH // 2
N_MOD = 6
RMS_EPS = 1e-6
ROPE_BASE = 10000.0
Q_BLOCK = 128

S5_WIDTH = D_MODEL // 2
S5_GROUP = 16
S5_GROUPS = S5_WIDTH // S5_GROUP
S5_STATE = 64
S5_DT_MIN = 1e-3
S5_DT_MAX = 1e-1

MLA_V = 64
MLA_HEADS = (D_MODEL - S5_WIDTH) // MLA_V
MLA_NOPE = 64
MLA_ROPE = 32
MLA_QK = MLA_NOPE + MLA_ROPE
MLA_Q_RANK = D_MODEL // 4
MLA_KV_RANK = D_MODEL // 8
EVEN_IN = S5_WIDTH + MLA_Q_RANK + MLA_KV_RANK + MLA_ROPE
EVEN_MIX = S5_WIDTH + MLA_HEADS * MLA_V

GQA_DIM = 128
GQA_HEADS = D_MODEL // GQA_DIM
GQA_KV_HEADS = GQA_HEADS // 2
GQA_GROUP = GQA_HEADS // GQA_KV_HEADS
ODD_Q = GQA_HEADS * GQA_DIM
ODD_KV = GQA_KV_HEADS * GQA_DIM
ODD_IN = ODD_Q + 2 * ODD_KV
ODD_MIX = GQA_HEADS * GQA_DIM

MOE_GROUPS = 4
MOE_PER_GROUP = 8
MOE_EXPERTS = MOE_GROUPS * MOE_PER_GROUP
MOE_TOP_K = 2
MOE_FF = D_MODEL // 2
MOE_BLOCK = 128

kernel_name = 'hybrid_s5_mla_gqa_hmoe_dit'


def rms_norm(x, g):
    xf = x.astype(jnp.float32)
    y = xf * lax.rsqrt(jnp.mean(xf * xf, axis=-1, keepdims=True) + RMS_EPS)
    return y.astype(x.dtype) * g


def ada_chunks(sc, w, b):
    return jnp.split(sc @ w + b, N_MOD, axis=-1)


def modulate(h, shift, scale):
    return h * (1 + scale) + shift


def rope_tables(row, col, d_rot):
    n_freq = d_rot // 4
    inv = ROPE_BASE ** (-jnp.arange(n_freq, dtype=jnp.float32) / n_freq)
    ang = jnp.stack([row[:, None] * inv, col[:, None] * inv], axis=1)
    return jnp.cos(ang)[:, None], jnp.sin(ang)[:, None]


def apply_rope(x, cos, sin):
    xr = x.reshape(*x.shape[:-1], 2, 2, x.shape[-1] // 4)
    x1, x2 = xr[..., 0, :], xr[..., 1, :]
    cos, sin = cos.astype(x.dtype), sin.astype(x.dtype)
    out = jnp.stack([x1 * cos - x2 * sin, x2 * cos + x1 * sin], axis=-2)
    return out.reshape(x.shape)


def attend_dense(q, k, v, scale):
    s = jnp.einsum('bqkgd,bskd->bkgqs', q, k, preferred_element_type=jnp.float32) * scale
    p = jax.nn.softmax(s, axis=-1).astype(v.dtype)
    return jnp.einsum('bkgqs,bskd->bqkgd', p, v)


def attend_latent(q, k, v, scale):
    b, lq = q.shape[:2]
    nb = lq // Q_BLOCK
    qb = jnp.moveaxis(q.reshape(b, nb, Q_BLOCK, *q.shape[2:]), 1, 0)
    ob = lax.map(lambda qi: attend_dense(qi, k, v, scale), qb)
    return jnp.moveaxis(ob, 0, 1).reshape(b, lq, *ob.shape[3:])


def _cmul(ar, ai, br, bi):
    return ar * br - ai * bi, ar * bi + ai * br


def _s5_combine(e1, e2):
    a1r, a1i, b1r, b1i = e1
    a2r, a2i, b2r, b2i = e2
    ar, ai = _cmul(a2r, a2i, a1r, a1i)
    br, bi = _cmul(a2r, a2i, b1r, b1i)
    return ar, ai, br + b2r, bi + b2i


def s5_direction(u_ctx, u_lat, a_re, a_im, log_dt, b_re, b_im, c_re, c_im, reverse, need_ctx):
    dt = jnp.exp(log_dt)[:, None]
    mag = jnp.exp(dt * a_re)
    th = dt * a_im
    ab_r, ab_i = mag * jnp.cos(th), mag * jnp.sin(th)
    den = a_re * a_re + a_im * a_im
    nr = ab_r - 1
    z_r = (nr * a_re + ab_i * a_im) / den
    z_i = (ab_i * a_re - nr * a_im) / den
    bb_r, bb_i = _cmul(z_r[..., None], z_i[..., None], b_re, b_im)

    def drive(u):
        return (jnp.einsum('blgp,gnp->blgn', u, bb_r), jnp.einsum('blgp,gnp->blgn', u, bb_i))

    def scan(bu_r, bu_i):
        shp = bu_r.shape
        _, _, h_r, h_i = lax.associative_scan(
            _s5_combine, (jnp.broadcast_to(ab_r, shp), jnp.broadcast_to(ab_i, shp), bu_r, bu_i),
            axis=1, reverse=reverse)
        return h_r, h_i

    def readout(h_r, h_i):
        return jnp.einsum('blgn,gpn->blgp', h_r, c_re) - jnp.einsum('blgn,gpn->blgp', h_i, c_im)

    hc_r, hc_i = scan(*drive(u_ctx))
    end = 0 if reverse else -1
    first = -1 if reverse else 0
    carry_r, carry_i = _cmul(ab_r, ab_i, hc_r[:, end], hc_i[:, end])
    bu_r, bu_i = drive(u_lat)
    bu_r = bu_r.at[:, first].add(carry_r)
    bu_i = bu_i.at[:, first].add(carry_i)
    y_lat = readout(*scan(bu_r, bu_i))
    y_ctx = readout(hc_r, hc_i) if need_ctx else None
    return y_lat, y_ctx


def s5_glu(y, u, d_skip, w_glu):
    g = jax.nn.gelu(y + d_skip * u)
    return g * jax.nn.sigmoid(g @ w_glu)


def s5_mixer(u_lat, u_ctx, p, need_ctx):
    b, l, _ = u_lat.shape
    ug_lat = u_lat.reshape(b, l, S5_GROUPS, S5_GROUP)
    ug_ctx = u_ctx.reshape(b, u_ctx.shape[1], S5_GROUPS, S5_GROUP)
    outs = [s5_direction(ug_ctx, ug_lat, p['a_re'][dd], p['a_im'][dd], p['log_dt'][dd],
                         p['b_re'][dd], p['b_im'][dd], p['c_re'][dd], p['c_im'][dd], rev, need_ctx)
            for dd, rev in enumerate((False, True))]
    y_lat = (outs[0][0] + outs[1][0]).reshape(u_lat.shape)
    out_lat = s5_glu(y_lat, u_lat, p['d'], p['w_glu'])
    out_ctx = None
    if need_ctx:
        y_ctx = (outs[0][1] + outs[1][1]).reshape(u_ctx.shape)
        out_ctx = s5_glu(y_ctx, u_ctx, p['d'], p['w_glu'])
    return out_lat, out_ctx


def mla_qkv(cq, ckv, kr, p, rope):
    b, l = cq.shape[:2]
    q = (rms_norm(cq, p['gq']) @ p['w_uq']).reshape(b, l, MLA_HEADS, MLA_QK)
    kv = (rms_norm(ckv, p['gkv']) @ p['w_ukv']).reshape(b, l, MLA_HEADS, MLA_NOPE + MLA_V)
    k_nope, v = kv[..., :MLA_NOPE], kv[..., MLA_NOPE:]
    k_rope = jnp.broadcast_to(kr[:, :, None, :], (b, l, MLA_HEADS, MLA_ROPE))
    k = jnp.concatenate([k_nope, k_rope], axis=-1)
    q = rms_norm(q, p['qn'])
    k = rms_norm(k, p['kn'])
    if rope is not None:
        cos, sin = rope
        q = jnp.concatenate([q[..., :MLA_NOPE], apply_rope(q[..., MLA_NOPE:], cos, sin)], axis=-1)
        k = jnp.concatenate([k[..., :MLA_NOPE], apply_rope(k[..., MLA_NOPE:], cos, sin)], axis=-1)
    return q, k, v


def mla_mixer(lat_parts, ctx_parts, p, rope, need_ctx):
    b, l = lat_parts[0].shape[:2]
    scale = MLA_QK ** -0.5
    q_l, k_l, v_l = mla_qkv(*lat_parts, p, rope)
    q_c, k_c, v_c = mla_qkv(*ctx_parts, p, None)
    k_all = jnp.concatenate([k_c, k_l], axis=1)
    v_all = jnp.concatenate([v_c, v_l], axis=1)
    o_lat = attend_latent(q_l[:, :, :, None], k_all, v_all, scale).reshape(b, l, MLA_HEADS * MLA_V)
    o_ctx = None
    if need_ctx:
        o_ctx = attend_dense(q_c[:, :, :, None], k_c, v_c, scale).reshape(b, q_c.shape[1], MLA_HEADS * MLA_V)
    return o_lat, o_ctx


def even_mixer(h_lat, h_ctx, p, rope, need_ctx):
    cuts = [S5_WIDTH, S5_WIDTH + MLA_Q_RANK, S5_WIDTH + MLA_Q_RANK + MLA_KV_RANK]
    u_l, cq_l, ckv_l, kr_l = jnp.split(h_lat @ p['w_in'], cuts, axis=-1)
    u_c, cq_c, ckv_c, kr_c = jnp.split(h_ctx @ p['w_in'], cuts, axis=-1)
    y_l, y_c = s5_mixer(u_l, u_c, p, need_ctx)
    o_l, o_c = mla_mixer((cq_l, ckv_l, kr_l), (cq_c, ckv_c, kr_c), p, rope, need_ctx)
    out_lat = jnp.concatenate([y_l, o_l], axis=-1) @ p['w_out']
    out_ctx = jnp.concatenate([y_c, o_c], axis=-1) @ p['w_out'] if need_ctx else None
    return out_lat, out_ctx


def gqa_qkv(h, p, rope):
    b, l = h.shape[:2]
    q, k, v = jnp.split(h @ p['w_qkv'], [ODD_Q, ODD_Q + ODD_KV], axis=-1)
    q = rms_norm(q.reshape(b, l, GQA_HEADS, GQA_DIM), p['qn'])
    k = rms_norm(k.reshape(b, l, GQA_KV_HEADS, GQA_DIM), p['kn'])
    v = v.reshape(b, l, GQA_KV_HEADS, GQA_DIM)
    if rope is not None:
        q = apply_rope(q, *rope)
        k = apply_rope(k, *rope)
    return q.reshape(b, l, GQA_KV_HEADS, GQA_GROUP, GQA_DIM), k, v


def odd_mixer(h_lat, h_ctx, p, rope, need_ctx):
    b, l = h_lat.shape[:2]
    scale = GQA_DIM ** -0.5
    q_l, k_l, v_l = gqa_qkv(h_lat, p, rope)
    q_c, k_c, v_c = gqa_qkv(h_ctx, p, None)
    k_all = jnp.concatenate([k_c, k_l], axis=1)
    v_all = jnp.concatenate([v_c, v_l], axis=1)
    out_lat = attend_latent(q_l, k_all, v_all, scale).reshape(b, l, ODD_MIX) @ p['w_out']
    out_ctx = None
    if need_ctx:
        out_ctx = attend_dense(q_c, k_c, v_c, scale).reshape(b, h_ctx.shape[1], ODD_MIX) @ p['w_out']
    return out_lat, out_ctx


def hier_moe(h, p):
    t, d = h.shape
    n_rows = t * MOE_TOP_K
    n_blocks = (n_rows + MOE_EXPERTS * (MOE_BLOCK - 1) + MOE_BLOCK - 1) // MOE_BLOCK
    lg1 = jnp.einsum('td,dg->tg', h, p['w_r1'], preferred_element_type=jnp.float32) + p['b_r1']
    p1 = jax.nn.softmax(lg1, axis=-1)
    grp = jnp.argmax(lg1, axis=-1)
    tok_idx = jnp.arange(t)
    p_grp = p1[tok_idx, grp]
    lg2 = (jnp.einsum('td,de->te', h, p['w_r2'], preferred_element_type=jnp.float32) + p['b_r2'])
    lg2 = lg2.reshape(t, MOE_GROUPS, MOE_PER_GROUP)[tok_idx, grp]
    top_v, top_i = lax.top_k(lg2, MOE_TOP_K)
    gates = p_grp[:, None] * jax.nn.softmax(top_v, axis=-1)
    expert = (grp[:, None] * MOE_PER_GROUP + top_i).reshape(-1)
    token = jnp.repeat(tok_idx, MOE_TOP_K)
    onehot = jax.nn.one_hot(expert, MOE_EXPERTS, dtype=jnp.int32)
    rank = jnp.cumsum(onehot, axis=0)[jnp.arange(n_rows), expert] - 1
    counts = onehot.sum(axis=0)
    padded = (counts + MOE_BLOCK - 1) // MOE_BLOCK * MOE_BLOCK
    pad_end = jnp.cumsum(padded)
    dest = (pad_end - padded)[expert] + rank
    xs = jnp.zeros((n_blocks * MOE_BLOCK, d), h.dtype).at[dest].set(h[token])
    blk_expert = jnp.minimum(jnp.searchsorted(pad_end, jnp.arange(n_blocks) * MOE_BLOCK, side='right'),
                             MOE_EXPERTS - 1)

    def run_block(args):
        xb, e = args
        return (jax.nn.silu(xb @ p['w_gate'][e]) * (xb @ p['w_up'][e])) @ p['w_down'][e]

    ys = lax.map(run_block, (xs.reshape(n_blocks, MOE_BLOCK, d), blk_expert)).reshape(-1, d)
    return (ys[dest] * gates.reshape(-1, 1).astype(h.dtype)).reshape(t, MOE_TOP_K, d).sum(axis=1)


def setup_inputs(seed: int = 0) -> dict:
    key = jax.random.key(seed)
    ks = iter(jax.random.split(key, 40))

    def nrm(shape, std):
        return std * jax.random.normal(next(ks), shape, jnp.float32)

    def gain(shape):
        return 1.0 + nrm(shape, 0.05)

    n_idx = jnp.arange(S5_STATE, dtype=jnp.float32)
    return {
        'x': nrm((BATCH, SEQ, D_MODEL), 1.0),
        'c': nrm((BATCH, D_MODEL), 1.0),
        'ctx': nrm((BATCH, CTX_LEN, D_MODEL), 1.0),
        'c_ctx': nrm((D_MODEL,), 1.0),
        'w_ada': nrm((DEPTH, D_MODEL, N_MOD * D_MODEL), 0.5 * D_MODEL ** -0.5),
        'b_ada': nrm((DEPTH, N_MOD * D_MODEL), 0.02),
        'norm1_g': gain((DEPTH, D_MODEL)),
        'norm2_g': gain((DEPTH, D_MODEL)),
        'w_in_e': nrm((N_EVEN, D_MODEL, EVEN_IN), D_MODEL ** -0.5),
        'w_out_e': nrm((N_EVEN, EVEN_MIX, D_MODEL), EVEN_MIX ** -0.5),
        's5_a_re': -0.5 + nrm((N_EVEN, 2, S5_GROUPS, S5_STATE), 0.01),
        's5_a_im': jnp.pi * n_idx + nrm((N_EVEN, 2, S5_GROUPS, S5_STATE), 0.01),
        's5_log_dt': jax.random.uniform(next(ks), (N_EVEN, 2, S5_GROUPS), jnp.float32,
                                        minval=math.log(S5_DT_MIN), maxval=math.log(S5_DT_MAX)),
        's5_b_re': nrm((N_EVEN, 2, S5_GROUPS, S5_STATE, S5_GROUP), (2 * S5_GROUP) ** -0.5),
        's5_b_im': nrm((N_EVEN, 2, S5_GROUPS, S5_STATE, S5_GROUP), (2 * S5_GROUP) ** -0.5),
        's5_c_re': nrm((N_EVEN, 2, S5_GROUPS, S5_GROUP, S5_STATE), S5_STATE ** -0.5),
        's5_c_im': nrm((N_EVEN, 2, S5_GROUPS, S5_GROUP, S5_STATE), S5_STATE ** -0.5),
        's5_d': nrm((N_EVEN, S5_WIDTH), 0.5),
        's5_w_glu': nrm((N_EVEN, S5_WIDTH, S5_WIDTH), S5_WIDTH ** -0.5),
        'mla_gq': gain((N_EVEN, MLA_Q_RANK)),
        'mla_w_uq': nrm((N_EVEN, MLA_Q_RANK, MLA_HEADS * MLA_QK), MLA_Q_RANK ** -0.5),
        'mla_gkv': gain((N_EVEN, MLA_KV_RANK)),
        'mla_w_ukv': nrm((N_EVEN, MLA_KV_RANK, MLA_HEADS * (MLA_NOPE + MLA_V)), MLA_KV_RANK ** -0.5),
        'mla_qn': gain((N_EVEN, MLA_QK)),
        'mla_kn': gain((N_EVEN, MLA_QK)),
        'w_qkv_o': nrm((N_ODD, D_MODEL, ODD_IN), D_MODEL ** -0.5),
        'w_out_o': nrm((N_ODD, ODD_MIX, D_MODEL), ODD_MIX ** -0.5),
        'gqa_qn': gain((N_ODD, GQA_DIM)),
        'gqa_kn': gain((N_ODD, GQA_DIM)),
        'moe_w_r1': nrm((DEPTH, D_MODEL, MOE_GROUPS), D_MODEL ** -0.5),
        'moe_b_r1': nrm((DEPTH, MOE_GROUPS), 0.01),
        'moe_w_r2': nrm((DEPTH, D_MODEL, MOE_EXPERTS), D_MODEL ** -0.5),
        'moe_b_r2': nrm((DEPTH, MOE_EXPERTS), 0.01),
        'moe_w_gate': nrm((DEPTH, MOE_EXPERTS, D_MODEL, MOE_FF), D_MODEL ** -0.5),
        'moe_w_up': nrm((DEPTH, MOE_EXPERTS, D_MODEL, MOE_FF), D_MODEL ** -0.5),
        'moe_w_down': nrm((DEPTH, MOE_EXPERTS, MOE_FF, D_MODEL), MOE_FF ** -0.5),
    }


def reference(x, c, ctx, c_ctx, w_ada, b_ada, norm1_g, norm2_g, w_in_e, w_out_e,
              s5_a_re, s5_a_im, s5_log_dt, s5_b_re, s5_b_im, s5_c_re, s5_c_im, s5_d, s5_w_glu,
              mla_gq, mla_w_uq, mla_gkv, mla_w_ukv, mla_qn, mla_kn,
              w_qkv_o, w_out_o, gqa_qn, gqa_kn,
              moe_w_r1, moe_b_r1, moe_w_r2, moe_b_r2, moe_w_gate, moe_w_up, moe_w_down):
    b, n_lat, _ = x.shape
    rows = n_lat // GRID_W
    row = jnp.repeat(jnp.arange(rows, dtype=jnp.float32), GRID_W)
    col = jnp.tile(jnp.arange(GRID_W, dtype=jnp.float32), rows)
    rope_mla = rope_tables(row, col, MLA_ROPE)
    rope_gqa = rope_tables(row, col, GQA_DIM)
    sc = jax.nn.silu(c)
    sc_ctx = jax.nn.silu(c_ctx)
    x_lat, x_ctx = x, ctx
    for l in range(DEPTH):
        last = l == DEPTH - 1
        m_lat = [m[:, None, :] for m in ada_chunks(sc, w_ada[l], b_ada[l])]
        m_ctx = ada_chunks(sc_ctx, w_ada[l], b_ada[l])
        h_lat = modulate(rms_norm(x_lat, norm1_g[l]), m_lat[0], m_lat[1])
        h_ctx = modulate(rms_norm(x_ctx, norm1_g[l]), m_ctx[0], m_ctx[1])
        if l % 2 == 0:
            i = l // 2
            p = dict(w_in=w_in_e[i], w_out=w_out_e[i], a_re=s5_a_re[i], a_im=s5_a_im[i],
                     log_dt=s5_log_dt[i], b_re=s5_b_re[i], b_im=s5_b_im[i], c_re=s5_c_re[i],
                     c_im=s5_c_im[i], d=s5_d[i], w_glu=s5_w_glu[i], gq=mla_gq[i], w_uq=mla_w_uq[i],
                     gkv=mla_gkv[i], w_ukv=mla_w_ukv[i], qn=mla_qn[i], kn=mla_kn[i])
            mix_lat, mix_ctx = even_mixer(h_lat, h_ctx, p, rope_mla, not last)
        else:
            i = l // 2
            p = dict(w_qkv=w_qkv_o[i], w_out=w_out_o[i], qn=gqa_qn[i], kn=gqa_kn[i])
            mix_lat, mix_ctx = odd_mixer(h_lat, h_ctx, p, rope_gqa, not last)
        x_lat = x_lat + m_lat[2] * mix_lat
        p_moe = dict(w_r1=moe_w_r1[l], b_r1=moe_b_r1[l], w_r2=moe_w_r2[l], b_r2=moe_b_r2[l],
                     w_gate=moe_w_gate[l], w_up=moe_w_up[l], w_down=moe_w_down[l])
        g_lat = modulate(rms_norm(x_lat, norm2_g[l]), m_lat[3], m_lat[4])
        if last:
            f_lat = hier_moe(g_lat.reshape(-1, D_MODEL), p_moe).reshape(x_lat.shape)
        else:
            x_ctx = x_ctx + m_ctx[2] * mix_ctx
            g_ctx = modulate(rms_norm(x_ctx, norm2_g[l]), m_ctx[3], m_ctx[4])
            f_all = hier_moe(jnp.concatenate([g_lat.reshape(-1, D_MODEL), g_ctx.reshape(-1, D_MODEL)], axis=0), p_moe)
            f_lat = f_all[:b * n_lat].reshape(x_lat.shape)
            x_ctx = x_ctx + m_ctx[5] * f_all[b * n_lat:].reshape(x_ctx.shape)
        x_lat = x_lat + m_lat[5] * f_lat
    return x_lat
```

```cpp
#include <hip/hip_runtime.h>
#include <cstdio>
#include <cstdint>
#ifndef MK_MULTI
#define MK_MULTI 0
#endif
#define GAS __attribute__((address_space(1)))
#define LAS __attribute__((address_space(3)))
typedef unsigned short bf16;
typedef short bf16x8 __attribute__((ext_vector_type(8)));
typedef short s16x4 __attribute__((ext_vector_type(4)));
typedef float f32x2 __attribute__((ext_vector_type(2)));
typedef float f32x4 __attribute__((ext_vector_type(4)));
typedef float f32x16 __attribute__((ext_vector_type(16)));
typedef unsigned u32x2 __attribute__((ext_vector_type(2)));
typedef unsigned u32x4 __attribute__((ext_vector_type(4)));

constexpr int DM = 1024, NBATCH = 4, SEQ = 4096, CTXL = 256, DEPTH = 4;
constexpr int LAT_ROWS = NBATCH * SEQ;
constexpr int CTX_ROWS = NBATCH * CTXL;
constexpr int TOK = LAT_ROWS + CTX_ROWS;
constexpr int SKV = CTXL + SEQ;
constexpr int NMOD = 6 * DM;
constexpr float RMS_EPS = 1e-6f;
constexpr int NEXP = 32, MOE_FF = 512;
constexpr int LIST_CAP = TOK;

__device__ __forceinline__ unsigned f2bf(float f) { unsigned u = __builtin_bit_cast(unsigned, f); return (u + 0x7fffu + ((u >> 16) & 1u)) >> 16; }
__device__ __forceinline__ unsigned pk2(float lo, float hi) { return f2bf(lo) | (f2bf(hi) << 16); }
__device__ __forceinline__ float bf2f(unsigned short b) { return __builtin_bit_cast(float, ((unsigned)b) << 16); }
__device__ __forceinline__ float bflo(unsigned w) { return __builtin_bit_cast(float, w << 16); }
__device__ __forceinline__ float bfhi(unsigned w) { return __builtin_bit_cast(float, w & 0xffff0000u); }
__device__ __forceinline__ unsigned cvtpk(float lo, float hi) { unsigned r; asm volatile("v_cvt_pk_bf16_f32 %0, %1, %2" : "=v"(r) : "v"(lo), "v"(hi)); return r; }
#define DPP_F(v, ctrl) __builtin_bit_cast(float, __builtin_amdgcn_update_dpp(0, __builtin_bit_cast(int, v), ctrl, 0xf, 0xf, true))
__device__ __forceinline__ float wave_sum(float v) {
    v += DPP_F(v, 0xB1);
    v += DPP_F(v, 0x4E);
    v += DPP_F(v, 0x141);
    v += DPP_F(v, 0x140);
    const int vi = __builtin_bit_cast(int, v);
    return (__builtin_bit_cast(float, __builtin_amdgcn_readlane(vi, 0)) + __builtin_bit_cast(float, __builtin_amdgcn_readlane(vi, 16)))
         + (__builtin_bit_cast(float, __builtin_amdgcn_readlane(vi, 32)) + __builtin_bit_cast(float, __builtin_amdgcn_readlane(vi, 48)));
}
__device__ __forceinline__ float wave_max(float v) {
    v = fmaxf(v, DPP_F(v, 0xB1)); v = fmaxf(v, DPP_F(v, 0x4E)); v = fmaxf(v, DPP_F(v, 0x141)); v = fmaxf(v, DPP_F(v, 0x140));
    const int vi = __builtin_bit_cast(int, v);
    return fmaxf(fmaxf(__builtin_bit_cast(float, __builtin_amdgcn_readlane(vi, 0)), __builtin_bit_cast(float, __builtin_amdgcn_readlane(vi, 16))),
                 fmaxf(__builtin_bit_cast(float, __builtin_amdgcn_readlane(vi, 32)), __builtin_bit_cast(float, __builtin_amdgcn_readlane(vi, 48))));
}
__device__ __forceinline__ float sigmoidf_(float x) { return 1.f / (1.f + __expf(-x)); }
__device__ __forceinline__ float siluf_(float x) { return x * sigmoidf_(x); }
__device__ __forceinline__ float gelu_tanh(float x) {
    const float u = 0.7978845608028654f * (x + 0.044715f * x * x * x);
    const float e = __expf(2.f * u);
    const float t = 1.f - 2.f / (e + 1.f);
    return 0.5f * x * (1.f + t);
}
__device__ __forceinline__ int modrow_of(int row) { return row < LAT_ROWS ? (row >> 12) : 4; }

constexpr size_t MiB = 1u << 20;
constexpr size_t WS_CTL = 0, CTL_ZERO_BYTES = 1 * MiB;
constexpr size_t WS_MOD = 1 * MiB, WS_ROPE = 2 * MiB, WS_GATEW = 3 * MiB, WS_E = 4 * MiB, WS_LIST = 9 * MiB;
constexpr size_t WS_W_IN = 12 * MiB, WS_W_OUTE = 16 * MiB, WS_W_GLU = 20 * MiB, WS_W_MLA = 21 * MiB, WS_W_QKV = 23 * MiB, WS_W_OUTO = 31 * MiB;
constexpr size_t WS_W_GU = 35 * MiB, WS_W_DN = 291 * MiB;
constexpr size_t WS_XRES = 419 * MiB, WS_H = 487 * MiB, WS_MIX = 521 * MiB;
constexpr size_t WS_ZRAW = 555 * MiB, WS_ACAT = 623 * MiB, WS_QKVM = 640 * MiB, WS_QB = 700 * MiB, WS_KB = 734 * MiB, WS_VB = 768 * MiB, WS_GG = 785 * MiB;
constexpr size_t WS_ACT = 555 * MiB, WS_YDN = 589 * MiB;
constexpr size_t WS_END = 802 * MiB;
constexpr int CW_BAR = 4096, CW_CNT = 16384;
constexpr int ROPE32_OFF = 64 * 32 * 2;

constexpr int RING_BYTES = 131072, MISC_OFF = RING_BYTES + 320, LDS_BYTES = 147456;


namespace pg8 {
constexpr int BM = 256, BK = 64, HALF = 128, HTB = HALF * BK * 2, STAGE_BYTES = 8 * HTB, NXCD = 8, WGM = 8;
__host__ __device__ __forceinline__ int lds_byte(int r, int c) { const int st = (r >> 4) * 2 + (c >> 5), rr = r & 15, cc = c & 31, ob = rr * 64 + cc * 2; return st * 1024 + (ob ^ (((ob >> 9) & 1) << 5)); }
__host__ __device__ __forceinline__ void stage_rc(int b, int& R, int& C) { const int st = b / 1024, sb = b % 1024, swz = sb ^ (((sb >> 9) & 1) << 5); R = (st >> 1) * 16 + swz / 64; C = (st & 1) * 32 + (swz % 64) / 2; }
__host__ __device__ __forceinline__ int perm32(int rho) { const int n = rho >> 4, i = rho & 15; return 8 * (i >> 2) + 4 * n + (i & 3); }

struct Unit { int pm, pn, e, rows; };

enum { EPI_BF16 = 0, EPI_GLU = 1, EPI_RESID = 2, EPI_MOE1 = 3, EPI_MOE2 = 4 };
enum { G_INPROJ = 0, G_MLA = 1, G_GLU = 2, G_OUT = 3, G_QKV = 4, G_MOE1 = 5, G_MOE2 = 6 };

template <int GID> struct Cfg;
template <> struct Cfg<G_INPROJ> { static constexpr int lda = 1024, ldb = 1024, K = 1024, nN = 4, moe = 0, epi = EPI_BF16, ldo = 1024, acol_split = 1 << 30, acol_off = 0; };
template <> struct Cfg<G_MLA>    { static constexpr int lda = 512,  ldb = 256,  K = 256,  nN = 7, moe = 0, epi = EPI_BF16, ldo = 1792, acol_split = 3, acol_off = 256; };
template <> struct Cfg<G_GLU>    { static constexpr int lda = 512,  ldb = 512,  K = 512,  nN = 2, moe = 0, epi = EPI_GLU,  ldo = 1024, acol_split = 1 << 30, acol_off = 0; };
template <> struct Cfg<G_OUT>    { static constexpr int lda = 1024, ldb = 1024, K = 1024, nN = 4, moe = 0, epi = EPI_RESID, ldo = 1024, acol_split = 1 << 30, acol_off = 0; };
template <> struct Cfg<G_QKV>    { static constexpr int lda = 1024, ldb = 1024, K = 1024, nN = 8, moe = 0, epi = EPI_BF16, ldo = 2048, acol_split = 1 << 30, acol_off = 0; };
template <> struct Cfg<G_MOE1>   { static constexpr int lda = 1024, ldb = 1024, K = 1024, nN = 4, moe = 1, epi = EPI_MOE1, ldo = 512, acol_split = 1 << 30, acol_off = 0; };
template <> struct Cfg<G_MOE2>   { static constexpr int lda = 512,  ldb = 512,  K = 512,  nN = 4, moe = 2, epi = EPI_MOE2, ldo = 1024, acol_split = 1 << 30, acol_off = 0; };

template <int GID> struct Prob {
    static constexpr int lda = Cfg<GID>::lda, ldb = Cfg<GID>::ldb, K = Cfg<GID>::K, nN = Cfg<GID>::nN, moe = Cfg<GID>::moe, epi = Cfg<GID>::epi, ldo = Cfg<GID>::ldo;
    static constexpr int acol_split = Cfg<GID>::acol_split, acol_off = Cfg<GID>::acol_off, nM = TOK / 256;
    static constexpr size_t bstride = (size_t)1024 * K * 2;
    const char* A; const char* B;
    int G, c;
    const int* list; const unsigned* cnt; const LAS int* tp;
    int l; unsigned char* ws;
    bf16* O;
    const float* xlat; const float* xctx;

    __device__ __forceinline__ bool next(int i, Unit& u) const {
        const long L = (long)i * G + c;
        if constexpr (moe == 0) {
            const int nwg = nM * nN; if (L >= nwg) return false;
            int wgid = (int)L; { const int q = nwg / NXCD, r = nwg % NXCD, xcd = wgid % NXCD, off = wgid / NXCD; wgid = (xcd < r ? xcd * (q + 1) : r * (q + 1) + (xcd - r) * q) + off; }
            const int nig = WGM * nN, gid = wgid / nig, fm = gid * WGM, gsz = (nM - fm) < WGM ? (nM - fm) : WGM;
            u.pm = fm + ((wgid % nig) % gsz); u.pn = (wgid % nig) / gsz; u.e = 0; u.rows = 256; return true;
        } else {
            const int total = tp[NEXP] * nN; if (L >= total) return false;
            const int t = (int)L / nN; int e = 0;
            while (tp[e + 1] <= t) ++e;
            u.e = e; u.pm = t - tp[e]; u.pn = (int)L % nN;
            const int left = (int)cnt[e] - 256 * u.pm; u.rows = left < 256 ? left : 256; return true;
        }
    }
    __device__ __forceinline__ const char* abase(const Unit& u) const {
        if constexpr (moe == 0) return A + ((size_t)u.pm * 256 * lda + (u.pn >= acol_split ? acol_off : 0)) * 2;
        else return A;
    }
    __device__ __forceinline__ unsigned aoff(const Unit& u, int R, int C) const {
        if constexpr (moe == 0) return (unsigned)((R * lda + C) * 2);
        else {
        const int rr = R < u.rows ? R : 0;
        const int ent = list[(size_t)u.e * LIST_CAP + u.pm * 256 + rr];
        const int arow = (moe == 1) ? (ent >> 1) : ent;
        return (unsigned)(((size_t)arow * lda + C) * 2u); }
    }
    __device__ __forceinline__ const char* bbase(const Unit& u) const { return B + (size_t)u.e * bstride + (size_t)u.pn * 256 * ldb * 2; }

    __device__ __forceinline__ void epilogue(const f32x4 (&acc)[2][2][4][2], const Unit& u, int wr, int wc, int fr, int fq) const {
        const int cw = wc * 32 + 8 * fq;
        if constexpr (epi == EPI_BF16) {
#pragma unroll
            for (int ai = 0; ai < 2; ++ai)
#pragma unroll
                for (int m = 0; m < 4; ++m) { const int row = u.pm * 256 + ai * 128 + wr * 64 + m * 16 + fr; bf16* rowp = O + (size_t)row * ldo + u.pn * 256 + cw;
#pragma unroll
                    for (int bj = 0; bj < 2; ++bj) { const f32x4 v0 = acc[ai][bj][m][0], v1 = acc[ai][bj][m][1];
                        u32x4 w; w.x = cvtpk(v0[0], v0[1]); w.y = cvtpk(v0[2], v0[3]); w.z = cvtpk(v1[0], v1[1]); w.w = cvtpk(v1[2], v1[3]);
                        *(u32x4*)(rowp + bj * 128) = w; } }
        } else if constexpr (epi == EPI_GLU) {
#pragma unroll
            for (int ai = 0; ai < 2; ++ai)
#pragma unroll
                for (int m = 0; m < 4; ++m) { const int row = u.pm * 256 + ai * 128 + wr * 64 + m * 16 + fr;
#pragma unroll
                    for (int bj = 0; bj < 2; ++bj) { const int col = u.pn * 256 + bj * 128 + cw;
                        const u32x4 gv = *(const u32x4*)((const bf16*)(ws + WS_GG) + (size_t)row * 512 + col);
                        const f32x4 v0 = acc[ai][bj][m][0], v1 = acc[ai][bj][m][1];
                        u32x4 w;
                        w.x = cvtpk(bflo(gv.x) * sigmoidf_(v0[0]), bfhi(gv.x) * sigmoidf_(v0[1]));
                        w.y = cvtpk(bflo(gv.y) * sigmoidf_(v0[2]), bfhi(gv.y) * sigmoidf_(v0[3]));
                        w.z = cvtpk(bflo(gv.z) * sigmoidf_(v1[0]), bfhi(gv.z) * sigmoidf_(v1[1]));
                        w.w = cvtpk(bflo(gv.w) * sigmoidf_(v1[2]), bfhi(gv.w) * sigmoidf_(v1[3]));
                        *(u32x4*)((bf16*)(ws + WS_MIX) + (size_t)row * 1024 + col) = w; } }
        } else if constexpr (epi == EPI_RESID) {
            const float* gate = (const float*)(ws + WS_MOD) + (size_t)l * 5 * NMOD + 2 * DM; float* xout = (float*)(ws + WS_XRES);
#pragma unroll
            for (int ai = 0; ai < 2; ++ai)
#pragma unroll
                for (int m = 0; m < 4; ++m) { const int row = u.pm * 256 + ai * 128 + wr * 64 + m * 16 + fr;
                    const float* xs = row < LAT_ROWS ? xlat + (size_t)row * DM : xctx + (size_t)(row - LAT_ROWS) * DM;
                    const float* gr = gate + (size_t)modrow_of(row) * NMOD;
#pragma unroll
                    for (int bj = 0; bj < 2; ++bj) { const int col = u.pn * 256 + bj * 128 + cw;
#pragma unroll
                        for (int n = 0; n < 2; ++n) { const f32x4 xv = *(const f32x4*)(xs + col + 4 * n), gv = *(const f32x4*)(gr + col + 4 * n);

#ifdef DBG_NOMIX
                            *(f32x4*)(xout + (size_t)row * DM + col + 4 * n) = xv;
#else
                            *(f32x4*)(xout + (size_t)row * DM + col + 4 * n) = xv + gv * acc[ai][bj][m][n];
#endif
                        } } }
        } else if constexpr (epi == EPI_MOE1) {
#pragma unroll
            for (int ai = 0; ai < 2; ++ai)
#pragma unroll
                for (int m = 0; m < 4; ++m) { const int rt = ai * 128 + wr * 64 + m * 16 + fr;
                    if (rt < u.rows) { const int ent = list[(size_t)u.e * LIST_CAP + u.pm * 256 + rt];
                        const f32x4 g0 = acc[ai][0][m][0], g1 = acc[ai][0][m][1], u0 = acc[ai][1][m][0], u1 = acc[ai][1][m][1];
                        u32x4 w;
                        w.x = cvtpk(siluf_(g0[0]) * u0[0], siluf_(g0[1]) * u0[1]); w.y = cvtpk(siluf_(g0[2]) * u0[2], siluf_(g0[3]) * u0[3]);
                        w.z = cvtpk(siluf_(g1[0]) * u1[0], siluf_(g1[1]) * u1[1]); w.w = cvtpk(siluf_(g1[2]) * u1[2], siluf_(g1[3]) * u1[3]);
                        *(u32x4*)((bf16*)(ws + WS_ACT) + (size_t)ent * MOE_FF + u.pn * 128 + cw) = w; } }
        } else {
            const float* gatew = (const float*)(ws + WS_GATEW);
#pragma unroll
            for (int ai = 0; ai < 2; ++ai)
#pragma unroll
                for (int m = 0; m < 4; ++m) { const int rt = ai * 128 + wr * 64 + m * 16 + fr;
                    if (rt < u.rows) { const int ent = list[(size_t)u.e * LIST_CAP + u.pm * 256 + rt]; const float gw = gatew[ent];
#pragma unroll
                        for (int bj = 0; bj < 2; ++bj) { const f32x4 v0 = acc[ai][bj][m][0] * gw, v1 = acc[ai][bj][m][1] * gw;
                            u32x4 w; w.x = cvtpk(v0[0], v0[1]); w.y = cvtpk(v0[2], v0[3]); w.z = cvtpk(v1[0], v1[1]); w.w = cvtpk(v1[2], v1[3]);
                            *(u32x4*)((bf16*)(ws + WS_YDN) + (size_t)ent * DM + u.pn * 256 + bj * 128 + cw) = w; } } }
        }
    }
};

template <int GID>
__device__ __forceinline__ void gemm_phase(LAS unsigned char* lds, const Prob<GID>& P, const int tid) {
    const int  wid = __builtin_amdgcn_readfirstlane(tid >> 6), lane = tid & 63, wr = wid >> 2, wc = wid & 3, fr = lane & 15, fq = lane >> 4;
    constexpr int K = Prob<GID>::K, nt = K / BK;
    unsigned voffB[2];
#pragma unroll
    for (int i = 0; i < 2; ++i) { int R, C; stage_rc(tid * 16 + i * 8192, R, C); const int Rb = (R & ~31) + perm32(R & 31);
        voffB[i] = (unsigned)(Rb * P.ldb + C) * 2u; }
#define PG8_AOFFS(vo, unit) do { _Pragma("unroll") for (int _h = 0; _h < 2; ++_h) _Pragma("unroll") for (int _i = 0; _i < 2; ++_i) { int _R, _C; stage_rc(tid * 16 + _i * 8192, _R, _C); \
        (vo)[_h][_i] = P.aoff(unit, _R + 128 * _h, _C); } } while (0)
    const size_t kstep = (size_t)(BK * 2);
    const size_t hstepB = (size_t)HALF * P.ldb * 2;
    const unsigned ldsw = (unsigned)wid * 1024u;
    const int aoff = lds_byte(wr * 64 + fr, fq * 8), boff = lds_byte(wc * 32 + fr, fq * 8);
#define PG8_SA(b, h) (((b) * 2 + (h)) * HTB)
#define PG8_SB(b, h) ((4 + (b) * 2 + (h)) * HTB)
#define PG8_STAGEB(bufoff, gbase) do { _Pragma("unroll") for (int _i = 0; _i < 2; ++_i) \
        __builtin_amdgcn_global_load_lds((const unsigned*)((const char*)(gbase) + voffB[_i]), (LAS unsigned*)(lds + (bufoff) + ldsw + _i * 8192), 16, 0, 0); } while (0)
#define PG8_STAGEA(bufoff, gbase, h) do { _Pragma("unroll") for (int _i = 0; _i < 2; ++_i) \
        __builtin_amdgcn_global_load_lds((const unsigned*)((const char*)(gbase) + vA[h][_i]), (LAS unsigned*)(lds + (bufoff) + ldsw + _i * 8192), 16, 0, 0); } while (0)
#define PG8_LDA(dst, b, h) do { _Pragma("unroll") for (int m = 0; m < 4; ++m) _Pragma("unroll") for (int k = 0; k < 2; ++k) dst[m][k] = *(const LAS bf16x8*)(lds + PG8_SA(b, h) + aoff + m * 2048 + k * 1024); } while (0)
#define PG8_LDB(dst, b, h) do { _Pragma("unroll") for (int n = 0; n < 2; ++n) _Pragma("unroll") for (int k = 0; k < 2; ++k) dst[n][k] = *(const LAS bf16x8*)(lds + PG8_SB(b, h) + boff + n * 2048 + k * 1024); } while (0)
#define PG8_MMA(ai, bj, At, Bt) do { __builtin_amdgcn_s_setprio(1); _Pragma("unroll") for (int m = 0; m < 4; ++m) _Pragma("unroll") for (int n = 0; n < 2; ++n) _Pragma("unroll") for (int k = 0; k < 2; ++k) \
        acc[ai][bj][m][n] = __builtin_amdgcn_mfma_f32_16x16x32_bf16(Bt[n][k], At[m][k], acc[ai][bj][m][n], 0, 0, 0); __builtin_amdgcn_s_setprio(0); } while (0)
#define PG8_WAIT_V(n) asm volatile("s_waitcnt vmcnt(" #n ")" ::: "memory")
#define PG8_WAIT_L(n) asm volatile("s_waitcnt lgkmcnt(" #n ")" ::: "memory")
#define PG8_BAR __builtin_amdgcn_s_barrier()
#define PG8_SCHED __builtin_amdgcn_sched_barrier(0)
    Unit cur, nxt; int ui = 0;
    if (!P.next(0, cur)) return;
    f32x4 acc[2][2][4][2];
#pragma unroll
    for (int a = 0; a < 2; ++a)
#pragma unroll
        for (int b = 0; b < 2; ++b)
#pragma unroll
            for (int m = 0; m < 4; ++m)
#pragma unroll
                for (int n = 0; n < 2; ++n) acc[a][b][m][n] = (f32x4){0.f, 0.f, 0.f, 0.f};
    bf16x8 At[4][2], B0[2][2], B1[2][2];
    unsigned vA[2][2];
    PG8_AOFFS(vA, cur);
    const char* cA = P.abase(cur); const char* cB = P.bbase(cur);
    PG8_STAGEB(PG8_SB(0, 0), cB); PG8_STAGEB(PG8_SB(0, 1), cB + hstepB); PG8_STAGEA(PG8_SA(0, 0), cA, 0); PG8_STAGEA(PG8_SA(0, 1), cA, 1);
    if (wr == 1) PG8_BAR;
    PG8_WAIT_V(2); PG8_BAR;
    PG8_STAGEB(PG8_SB(1, 0), cB + kstep); PG8_STAGEA(PG8_SA(1, 0), cA + kstep, 0); PG8_STAGEB(PG8_SB(1, 1), cB + hstepB + kstep);
    PG8_WAIT_V(6); PG8_BAR;
    for (;;) {
        const bool has_next = P.next(ui + 1, nxt);
        const char* nA = has_next ? P.abase(nxt) : cA; const char* nB = has_next ? P.bbase(nxt) : cB;
#pragma nounroll
        for (int t = 0; t < nt; t += 2) {
            const bool last = (t == nt - 2);
            const char* a1 = cA + (size_t)(t + 1) * kstep;
            const char* a2 = last ? nA : cA + (size_t)(t + 2) * kstep; const char* b2 = last ? nB : cB + (size_t)(t + 2) * kstep;
            const char* a3 = a2 + kstep; const char* b3 = b2 + kstep;
            PG8_LDB(B0, 0, 0); PG8_LDB(B1, 0, 1); PG8_SCHED; PG8_LDA(At, 0, 0); PG8_STAGEA(PG8_SA(1, 1), a1, 1);
            if (Prob<GID>::moe != 0 && last && has_next) { PG8_AOFFS(vA, nxt); }
            PG8_WAIT_V(8); PG8_WAIT_L(0); PG8_BAR; PG8_MMA(0, 0, At, B0); PG8_MMA(0, 1, At, B1); PG8_BAR; PG8_SCHED;
            PG8_LDA(At, 0, 1); PG8_STAGEB(PG8_SB(0, 0), b2); PG8_STAGEB(PG8_SB(0, 1), b2 + hstepB); PG8_STAGEA(PG8_SA(0, 0), a2, 0);
            PG8_WAIT_V(8); PG8_WAIT_L(0); PG8_BAR; PG8_MMA(1, 0, At, B0); PG8_MMA(1, 1, At, B1); PG8_BAR; PG8_SCHED;
            PG8_LDB(B0, 1, 0); PG8_LDB(B1, 1, 1); PG8_SCHED; PG8_LDA(At, 1, 0); PG8_STAGEA(PG8_SA(0, 1), a2, 1);
            PG8_WAIT_V(8); PG8_WAIT_L(0); PG8_BAR; PG8_MMA(0, 0, At, B0); PG8_MMA(0, 1, At, B1); PG8_BAR; PG8_SCHED;
            PG8_LDA(At, 1, 1); PG8_STAGEB(PG8_SB(1, 0), b3); PG8_STAGEB(PG8_SB(1, 1), b3 + hstepB); PG8_STAGEA(PG8_SA(1, 0), a3, 0);
            PG8_WAIT_V(8); PG8_WAIT_L(0); PG8_BAR; PG8_MMA(1, 0, At, B0); PG8_MMA(1, 1, At, B1); PG8_BAR; PG8_SCHED;
        }
        if (wr == 0) PG8_BAR;
        P.epilogue(acc, cur, wr, wc, fr, fq);
        if (!has_next) break;
#pragma unroll
        for (int a = 0; a < 2; ++a)
#pragma unroll
            for (int b = 0; b < 2; ++b)
#pragma unroll
                for (int m = 0; m < 4; ++m)
#pragma unroll
                    for (int n = 0; n < 2; ++n) acc[a][b][m][n] = (f32x4){0.f, 0.f, 0.f, 0.f};
        cur = nxt; cA = nA; cB = nB; ++ui;
        if (wr == 1) PG8_BAR;
    }
    PG8_WAIT_V(0);
    PG8_BAR;
#undef PG8_SA
#undef PG8_SB
#undef PG8_STAGEA
#undef PG8_AOFFS
#undef PG8_STAGEB
#undef PG8_LDA
#undef PG8_LDB
#undef PG8_MMA
#undef PG8_WAIT_V
#undef PG8_WAIT_L
#undef PG8_BAR
#undef PG8_SCHED
}
}
namespace att {
constexpr int D = 128, NW = 8, QBLK = 32, KVBLK = 64;
constexpr float THR = 8.f;
constexpr int SHM_V = KVBLK * 128 * 2, SHM_K = KVBLK * D * 2, SHM_ATTN = 2 * SHM_V + 2 * SHM_K + NW * 64 * 4;
#define KSWZ(row, colB) ((row) * 256 + ((colB) ^ (((row) & 7) << 4)))
#define SBAR() __builtin_amdgcn_sched_barrier(0)
__device__ __forceinline__ int crow(int r, int hi) { return (r & 3) + 8 * (r >> 2) + 4 * hi; }

template <int SC> struct ScaleOf { static constexpr float v = SC == 0 ? 0.088388347648318440f   : 0.102062072615965750f  ; };

template <int SC>
__device__ __forceinline__ void partialSM(f32x16& p0, f32x16& p1, float& m_reg, float& mn, float& alpha) {
  constexpr float SCALE = ScaleOf<SC>::v;
  constexpr float C = SCALE * 1.4426950408889634f;
  float pmax = p0[0];
#pragma unroll
  for (int r = 1; r < 16; ++r) pmax = fmaxf(pmax, p0[r]);
#pragma unroll
  for (int r = 0; r < 16; ++r) pmax = fmaxf(pmax, p1[r]);
  { auto rr = __builtin_amdgcn_permlane32_swap(__float_as_uint(pmax), __float_as_uint(pmax), false, false);
    pmax = fmaxf(__uint_as_float(rr[0]), __uint_as_float(rr[1])); }
  if (__builtin_expect(__all(pmax - m_reg <= THR / SCALE), 1)) { mn = m_reg; alpha = 1.f; }
  else { mn = fmaxf(m_reg, pmax); alpha = __builtin_amdgcn_exp2f((m_reg - mn) * C); m_reg = mn; }
  float mnC = -mn * C;
#pragma unroll
  for (int r = 0; r < 16; ++r) p0[r] = fmaf(p0[r], C, mnC);
#pragma unroll
  for (int r = 0; r < 16; ++r) p1[r] = fmaf(p1[r], C, mnC);
#pragma unroll
  for (int r = 0; r < 16; ++r) p0[r] = __builtin_amdgcn_exp2f(p0[r]);
}
__device__ __forceinline__ void finishSM(f32x16& p0, f32x16& p1, float alpha, float& l_reg, bf16x8& pa0, bf16x8& pa1, bf16x8& pa2, bf16x8& pa3) {
#pragma unroll
  for (int r = 0; r < 16; ++r) p1[r] = __builtin_amdgcn_exp2f(p1[r]);
  float ps = 0;
#pragma unroll
  for (int r = 0; r < 16; ++r) ps += p0[r];
#pragma unroll
  for (int r = 0; r < 16; ++r) ps += p1[r];
  { auto rr = __builtin_amdgcn_permlane32_swap(__float_as_uint(ps), __float_as_uint(ps), false, false);
    ps = __uint_as_float(rr[0]) + __uint_as_float(rr[1]); }
  l_reg = l_reg * alpha + ps;
#define PK4(P, BASE, OUT) do { unsigned a0 = cvtpk(P[BASE + 0], P[BASE + 1]), a1 = cvtpk(P[BASE + 2], P[BASE + 3]);   \
    unsigned b0 = cvtpk(P[BASE + 4], P[BASE + 5]), b1 = cvtpk(P[BASE + 6], P[BASE + 7]);                              \
    auto r0 = __builtin_amdgcn_permlane32_swap(a0, b0, false, false); auto r1 = __builtin_amdgcn_permlane32_swap(a1, b1, false, false); \
    u32x4 w = {r0[0], r1[0], r0[1], r1[1]}; OUT = *reinterpret_cast<bf16x8*>(&w); } while (0)
  PK4(p0, 0, pa0); PK4(p0, 8, pa1); PK4(p1, 0, pa2); PK4(p1, 8, pa3);
#undef PK4
}
__device__ __forceinline__ void qkt(f32x16& p0, f32x16& p1, const bf16* Ks, const bf16x8* qr, int r32, int hi) {
  p0 = f32x16{}; p1 = f32x16{};
#pragma unroll
  for (int d0 = 0; d0 < 8; ++d0) { int cb = (d0 * 16 + hi * 8) * 2;
    bf16x8 b0 = *reinterpret_cast<const bf16x8*>((const char*)Ks + KSWZ(r32, cb));
    bf16x8 b1 = *reinterpret_cast<const bf16x8*>((const char*)Ks + KSWZ(32 + r32, cb));
    p0 = __builtin_amdgcn_mfma_f32_32x32x16_bf16(b0, qr[d0], p0, 0, 0, 0);
    p1 = __builtin_amdgcn_mfma_f32_32x32x16_bf16(b1, qr[d0], p1, 0, 0, 0); }
}
__device__ __forceinline__ int v_st(int k, int c) { const int kk = (k & ~0xC) | ((k & 4) << 1) | ((k & 8) >> 1); return ((kk >> 3) * 4 + (c >> 5)) * 512 + ((kk & 7) * 32 + (c & 31)) * 2; }
__device__ __forceinline__ int v_rd_base(int lane) { return ((lane & 3) << 3) | (((lane >> 2) & 3) << 6) | (((lane >> 4) & 1) << 5) | (((lane >> 5) & 1) << 8); }
constexpr int v_rd_off(int d0, int ks, int half) { return d0 * 512 + ks * 4096 + half * 2048; }
template <int OFF> __device__ __forceinline__ s16x4 tr_read(int vb) {
  s16x4 r; asm volatile("ds_read_b64_tr_b16 %0, %1 offset:%2" : "=&v"(r) : "v"(vb), "i"(OFF) : "memory"); return r;
}
template <int D0> __device__ __forceinline__ void pv_one(f32x16& od, int vb, bf16x8 pa0, bf16x8 pa1, bf16x8 pa2, bf16x8 pa3) {
  const s16x4 l0 = tr_read<v_rd_off(D0, 0, 0)>(vb), h0 = tr_read<v_rd_off(D0, 0, 1)>(vb), l1 = tr_read<v_rd_off(D0, 1, 0)>(vb), h1 = tr_read<v_rd_off(D0, 1, 1)>(vb);
  const s16x4 l2 = tr_read<v_rd_off(D0, 2, 0)>(vb), h2 = tr_read<v_rd_off(D0, 2, 1)>(vb), l3 = tr_read<v_rd_off(D0, 3, 0)>(vb), h3 = tr_read<v_rd_off(D0, 3, 1)>(vb);
  asm volatile("s_waitcnt lgkmcnt(0)" ::: "memory"); SBAR();
#define PK(L, H) (bf16x8){L[0], L[1], L[2], L[3], H[0], H[1], H[2], H[3]}
  od = __builtin_amdgcn_mfma_f32_32x32x16_bf16(pa0, PK(l0, h0), od, 0, 0, 0);
  od = __builtin_amdgcn_mfma_f32_32x32x16_bf16(pa1, PK(l1, h1), od, 0, 0, 0);
  od = __builtin_amdgcn_mfma_f32_32x32x16_bf16(pa2, PK(l2, h2), od, 0, 0, 0);
  od = __builtin_amdgcn_mfma_f32_32x32x16_bf16(pa3, PK(l3, h3), od, 0, 0, 0);
#undef PK
}
template <int DV> __device__ __forceinline__ void pv_d0(f32x16* o, int vb, bf16x8 pa0, bf16x8 pa1, bf16x8 pa2, bf16x8 pa3) {
  pv_one<0>(o[0], vb, pa0, pa1, pa2, pa3); pv_one<1>(o[1], vb, pa0, pa1, pa2, pa3);
  if constexpr (DV == 128) { pv_one<2>(o[2], vb, pa0, pa1, pa2, pa3); pv_one<3>(o[3], vb, pa0, pa1, pa2, pa3); }
}

template <int DV, int SC, int LDO>
__device__ __forceinline__ void attn_dense_body(const bf16* __restrict__ Qb, const bf16* __restrict__ Kh, const bf16* __restrict__ Vh,
                                                bf16* __restrict__ Ob, int seq, char* lds, const int tid) {
  constexpr int ND = DV / 32;
  const int wid = tid >> 6, lane = tid & 63, r32 = lane & 31, hi = lane >> 5;
  bf16* V_lds = (bf16*)lds; bf16* K_lds = (bf16*)(lds + 2 * SHM_V);
  float* ws = (float*)(lds + 2 * SHM_V + 2 * SHM_K) + wid * 64; float* li_l = ws; float* al_l = ws + 32;
  float m_reg = -1e30f, l_reg = 0; f32x16 o[ND] = {}; bf16x8 qr[8];
  const bf16* Qw = Qb + (long)(wid * QBLK + r32) * 128 + hi * 8;
#pragma unroll
  for (int d0 = 0; d0 < 8; ++d0) qr[d0] = *reinterpret_cast<const bf16x8*>(Qw + d0 * 16);
  const int sr = tid >> 4, sc = (tid & 15) * 8;
  const int vr = (DV == 128) ? sr : (tid >> 3), vc = (DV == 128) ? sc : (tid & 7) * 8;
  const int vst0 = v_st(vr, vc), vst1 = v_st(32 + vr, vc);
  const int vb0 = (int)(uintptr_t)V_lds + v_rd_base(lane);
  struct { bf16x8 vs0, vs1, ks0, ks1; } sr_[2];
#define SLOAD(i, k0) do { sr_[i].vs0 = *reinterpret_cast<const bf16x8*>(&Vh[(long)((k0) + vr) * DV + vc]); \
    if constexpr (DV == 128) sr_[i].vs1 = *reinterpret_cast<const bf16x8*>(&Vh[(long)((k0) + 32 + vr) * DV + vc]); \
    sr_[i].ks0 = *reinterpret_cast<const bf16x8*>(&Kh[(long)((k0) + sr) * 128 + sc]); sr_[i].ks1 = *reinterpret_cast<const bf16x8*>(&Kh[(long)((k0) + 32 + sr) * 128 + sc]); } while (0)
#define SWRITE(b, i) do { *(bf16x8*)((char*)V_lds + (b) * SHM_V + vst0) = sr_[i].vs0;          \
    if constexpr (DV == 128) *(bf16x8*)((char*)V_lds + (b) * SHM_V + vst1) = sr_[i].vs1; int kc = sc * 2;               \
    *(bf16x8*)((char*)K_lds + (b) * SHM_K + KSWZ(sr, kc)) = sr_[i].ks0;                       \
    *(bf16x8*)((char*)K_lds + (b) * SHM_K + KSWZ(32 + sr, kc)) = sr_[i].ks1; } while (0)
#define SWAIT() do { if constexpr (DV == 128) asm volatile("s_waitcnt vmcnt(4)" ::: "memory"); else asm volatile("s_waitcnt vmcnt(3)" ::: "memory"); } while (0)
#define RESC(a) do { if (__any((a) < 1.f)) { if (hi == 0) al_l[r32] = (a); asm volatile("s_waitcnt lgkmcnt(0)" ::: "memory"); \
    _Pragma("unroll") for (int d = 0; d < ND; ++d) _Pragma("unroll") for (int r = 0; r < 16; ++r) o[d][r] *= al_l[crow(r, hi)]; } } while (0)
  f32x16 pA0, pA1, pB0, pB1; float mnA, mnB, alA, alB; bf16x8 pa0, pa1, pa2, pa3; const int NT = seq / KVBLK;
  constexpr int SE = 0, SO = 1;
  SLOAD(SE, 0); asm volatile("s_waitcnt vmcnt(0)" ::: "memory"); SWRITE(0, SE); __syncthreads();
  qkt(pA0, pA1, K_lds, qr, r32, hi); partialSM<SC>(pA0, pA1, m_reg, mnA, alA);
  SLOAD(SO, KVBLK); if (2 < NT) SLOAD(SE, 2 * KVBLK);
  SWAIT(); SWRITE(1, SO); __syncthreads();
  for (int j = 1; j + 1 < NT; j += 2) {
    SBAR(); qkt(pB0, pB1, (bf16*)((char*)K_lds + SHM_K), qr, r32, hi);
    finishSM(pA0, pA1, alA, l_reg, pa0, pa1, pa2, pa3); SBAR();
    SLOAD(SO, (j + 2) * KVBLK); SBAR();
    pv_d0<DV>(o, vb0, pa0, pa1, pa2, pa3); partialSM<SC>(pB0, pB1, m_reg, mnB, alB);
    __syncthreads(); SWAIT(); SWRITE(0, SE);
    RESC(alB); __syncthreads();
    SBAR(); qkt(pA0, pA1, K_lds, qr, r32, hi);
    finishSM(pB0, pB1, alB, l_reg, pa0, pa1, pa2, pa3); SBAR();
    if (j + 3 < NT) SLOAD(SE, (j + 3) * KVBLK); SBAR();
    pv_d0<DV>(o, vb0 + (int)SHM_V, pa0, pa1, pa2, pa3); partialSM<SC>(pA0, pA1, m_reg, mnA, alA);
    __syncthreads(); SWAIT(); SWRITE(1, SO);
    RESC(alA); __syncthreads();
  }
  SBAR(); qkt(pB0, pB1, (bf16*)((char*)K_lds + SHM_K), qr, r32, hi);
  finishSM(pA0, pA1, alA, l_reg, pa0, pa1, pa2, pa3); SBAR();
  pv_d0<DV>(o, vb0, pa0, pa1, pa2, pa3); partialSM<SC>(pB0, pB1, m_reg, mnB, alB);
  __syncthreads(); RESC(alB);
  finishSM(pB0, pB1, alB, l_reg, pa0, pa1, pa2, pa3); SBAR();
  pv_d0<DV>(o, vb0 + (int)SHM_V, pa0, pa1, pa2, pa3);
  if (hi == 0) li_l[r32] = l_reg; asm volatile("s_waitcnt lgkmcnt(0)" ::: "memory");
  float rli[16];
#pragma unroll
  for (int r = 0; r < 16; ++r) rli[r] = __builtin_amdgcn_rcpf(li_l[crow(r, hi)]);
  bf16* Ow = Ob + (long)(wid * QBLK) * LDO;
#pragma unroll
  for (int r = 0; r < 16; ++r) { int orow = crow(r, hi);
#pragma unroll
    for (int d0 = 0; d0 < ND; ++d0) Ow[(long)orow * LDO + d0 * 32 + r32] = (bf16)f2bf(o[d0][r] * rli[r]); }
  __syncthreads();
#undef SLOAD
#undef SWRITE
#undef SWAIT
#undef RESC
}
#undef KSWZ
#undef SBAR
}
namespace s5 {
constexpr int NBLK = 34;
constexpr int HS_STRIDE = 272;
constexpr int HS_BYTES = 32 * HS_STRIDE;
constexpr int NITEMS = 32 * 2 * NBLK;

struct Params { const float *a_re, *a_im, *log_dt, *b_re, *b_im, *c_re, *c_im, *dskip; };

__device__ __forceinline__ int rowof(int b, int blk, int j) { return blk < 2 ? LAT_ROWS + b * 256 + blk * 128 + j : b * 4096 + (blk - 2) * 128 + j; }

struct DirConst {
    float abr[2], abi[2];
    bf16x8 Bfr[2], Bfi[2];
};
__device__ __forceinline__ void load_dir(const Params& P, int dd, int g, int nl, int hi, DirConst& dc) {
    const float dt = __expf(P.log_dt[dd * 32 + g]);
#pragma unroll
    for (int nh = 0; nh < 2; ++nh) {
        const int n = nl + 32 * nh; const int ix = (dd * 32 + g) * 64 + n;
        const float are = P.a_re[ix], aim = P.a_im[ix];
        const float mag = __expf(dt * are), th = dt * aim;
        float rev = th * 0.15915494309189535f; rev -= floorf(rev);
        const float sn = __builtin_amdgcn_sinf(rev), cs = __builtin_amdgcn_cosf(rev);
        const float abr = mag * cs, abi = mag * sn;
        const float den = are * are + aim * aim, nr = abr - 1.f;
        const float zr = (nr * are + abi * aim) / den, zi = (abi * are - nr * aim) / den;
        dc.abr[nh] = abr; dc.abi[nh] = abi;
        const float* br = P.b_re + (size_t)ix * 16 + 8 * hi; const float* bi = P.b_im + (size_t)ix * 16 + 8 * hi;
        u32x4 wr_, wi_;
        float r8[8], i8[8];
#pragma unroll
        for (int j = 0; j < 8; ++j) { const float bre = br[j], bim = bi[j]; r8[j] = zr * bre - zi * bim; i8[j] = zr * bim + zi * bre; }
        wr_.x = pk2(r8[0], r8[1]); wr_.y = pk2(r8[2], r8[3]); wr_.z = pk2(r8[4], r8[5]); wr_.w = pk2(r8[6], r8[7]);
        wi_.x = pk2(i8[0], i8[1]); wi_.y = pk2(i8[2], i8[3]); wi_.z = pk2(i8[4], i8[5]); wi_.w = pk2(i8[6], i8[7]);
        dc.Bfr[nh] = *reinterpret_cast<bf16x8*>(&wr_); dc.Bfi[nh] = *reinterpret_cast<bf16x8*>(&wi_);
    }
}
__device__ __forceinline__ void load_cmat(const Params& P, int dd, int g, int lane, bf16x8 (&Cf)[4]) {
    const int p = lane & 15, kq = lane >> 4;
    const float* cre = P.c_re + ((size_t)(dd * 32 + g) * 16 + p) * 64; const float* cim = P.c_im + ((size_t)(dd * 32 + g) * 16 + p) * 64;
#pragma unroll
    for (int ks = 0; ks < 4; ++ks) {
        float v[8];
#pragma unroll
        for (int j = 0; j < 8; ++j) { const int k = 32 * ks + 8 * kq + j; const int n = (k >> 2) + 32 * ((k >> 1) & 1); v[j] = (k & 1) ? -cim[n] : cre[n]; }
        u32x4 w; w.x = pk2(v[0], v[1]); w.y = pk2(v[2], v[3]); w.z = pk2(v[4], v[5]); w.w = pk2(v[6], v[7]);
        Cf[ks] = *reinterpret_cast<bf16x8*>(&w);
    }
}
template <bool REV>
__device__ __forceinline__ void chunk_scan(const bf16* zraw, int g, int bp, int blk, int c, int lane, const DirConst& dc,
                                           float (&hr)[2], float (&hi_)[2], f32x16 (&accR)[2], f32x16 (&accI)[2]) {
    const int rho = lane & 31, kh = lane >> 5;
    const int beta = (rho >> 2) & 1, tau = (rho & 3) + 4 * (rho >> 3);
    const int row = rowof(2 * bp + beta, blk, 16 * c + tau);
    const bf16x8 af = *reinterpret_cast<const bf16x8*>(zraw + (size_t)row * 1024 + g * 16 + 8 * kh);
#pragma unroll
    for (int nh = 0; nh < 2; ++nh) {
        accR[nh] = __builtin_amdgcn_mfma_f32_32x32x16_bf16(af, dc.Bfr[nh], f32x16{}, 0, 0, 0);
        accI[nh] = __builtin_amdgcn_mfma_f32_32x32x16_bf16(af, dc.Bfi[nh], f32x16{}, 0, 0, 0);
    }
#pragma unroll
    for (int qq = 0; qq < 16; ++qq) {
        const int q = REV ? 15 - qq : qq;
#pragma unroll
        for (int nh = 0; nh < 2; ++nh) {
            const float nr_ = dc.abr[nh] * hr[nh] - dc.abi[nh] * hi_[nh] + accR[nh][q];
            const float ni_ = dc.abr[nh] * hi_[nh] + dc.abi[nh] * hr[nh] + accI[nh][q];
            hr[nh] = nr_; hi_[nh] = ni_; accR[nh][q] = nr_; accI[nh][q] = ni_;
        }
    }
}

__device__ __forceinline__ void pass_a_item(const Params& P, const bf16* zraw, float* E, int item, int lane) {
    const int g = item & 31, rest = item >> 5, blk = rest % NBLK, bp = rest / NBLK;
    const int nl = lane & 31, hi = lane >> 5;
    f32x16 accR[2], accI[2];
#pragma unroll
    for (int dd = 0; dd < 2; ++dd) {
        DirConst dc; load_dir(P, dd, g, nl, hi, dc);
        float hr[2] = {0.f, 0.f}, hi_[2] = {0.f, 0.f};
        for (int cc = 0; cc < 8; ++cc) {
            if (dd == 0) chunk_scan<false>(zraw, g, bp, blk, cc, lane, dc, hr, hi_, accR, accI);
            else chunk_scan<true>(zraw, g, bp, blk, 7 - cc, lane, dc, hr, hi_, accR, accI);
        }
        const int b = 2 * bp + hi;
        float* e = E + ((((size_t)(dd * 32 + g) * 4 + b) * NBLK + blk) * 64) * 2;
#pragma unroll
        for (int nh = 0; nh < 2; ++nh) { *(f32x2*)(e + (nl + 32 * nh) * 2) = (f32x2){hr[nh], hi_[nh]}; }
    }
}

__device__ __forceinline__ void readout(LAS unsigned char* hs, int lane, const bf16x8 (&Cf)[4], const f32x16 (&accR)[2], const f32x16 (&accI)[2], f32x4 (&y)[2]) {
    const int nl = lane & 31, hi = lane >> 5;
#pragma unroll
    for (int q = 0; q < 16; ++q) {
        u32x2 w; w.x = pk2(accR[0][q], accI[0][q]); w.y = pk2(accR[1][q], accI[1][q]);
        *(LAS u32x2*)(hs + (hi * 16 + q) * HS_STRIDE + nl * 8) = w;
    }
    asm volatile("s_waitcnt lgkmcnt(0)" ::: "memory");
    const int tk = lane & 15, kq = lane >> 4;
#pragma unroll
    for (int beta = 0; beta < 2; ++beta) {
#pragma unroll
        for (int ks = 0; ks < 4; ++ks) {
            const bf16x8 hb = *(const LAS bf16x8*)(hs + (beta * 16 + tk) * HS_STRIDE + (32 * ks + 8 * kq) * 2);
            y[beta] = __builtin_amdgcn_mfma_f32_16x16x32_bf16(Cf[ks], hb, y[beta], 0, 0, 0);
        }
    }
    asm volatile("s_waitcnt lgkmcnt(0)" ::: "memory");
}

__device__ __forceinline__ void pass_b_item(const Params& P, const bf16* zraw, const float* E, bf16* gg, LAS unsigned char* hs, int item, int lane) {
    const int g = item & 31, rest = item >> 5, blk = rest % NBLK, bp = rest / NBLK;
    const int nl = lane & 31, hi = lane >> 5;
    const int b = 2 * bp + hi;
    f32x16 accR[2], accI[2];
    f32x4 yf[8][2];
    {
        DirConst dc; load_dir(P, 0, g, nl, hi, dc);
        bf16x8 Cf[4]; load_cmat(P, 0, g, lane, Cf);
        float pr[2], pi[2];
#pragma unroll
        for (int nh = 0; nh < 2; ++nh) { float ar = dc.abr[nh], ai = dc.abi[nh];
#pragma unroll
            for (int s = 0; s < 7; ++s) { const float t = ar * ar - ai * ai; ai = 2.f * ar * ai; ar = t; }
            pr[nh] = ar; pi[nh] = ai; }
        float hr[2] = {0.f, 0.f}, hi_[2] = {0.f, 0.f};
        const float* e = E + ((((size_t)(0 * 32 + g) * 4 + b) * NBLK) * 64) * 2;
        for (int s = 0; s < blk; ++s) {
#pragma unroll
            for (int nh = 0; nh < 2; ++nh) { const f32x2 ev = *(const f32x2*)(e + ((size_t)s * 64 + nl + 32 * nh) * 2);
                const float nr_ = pr[nh] * hr[nh] - pi[nh] * hi_[nh] + ev.x, ni_ = pr[nh] * hi_[nh] + pi[nh] * hr[nh] + ev.y; hr[nh] = nr_; hi_[nh] = ni_; }
        }
#pragma unroll
        for (int c = 0; c < 8; ++c) {
            chunk_scan<false>(zraw, g, bp, blk, c, lane, dc, hr, hi_, accR, accI);
            yf[c][0] = (f32x4){0.f, 0.f, 0.f, 0.f}; yf[c][1] = (f32x4){0.f, 0.f, 0.f, 0.f};
            readout(hs, lane, Cf, accR, accI, yf[c]);
        }
    }
    {
        DirConst dc; load_dir(P, 1, g, nl, hi, dc);
        bf16x8 Cf[4]; load_cmat(P, 1, g, lane, Cf);
        float pr[2], pi[2];
#pragma unroll
        for (int nh = 0; nh < 2; ++nh) { float ar = dc.abr[nh], ai = dc.abi[nh];
#pragma unroll
            for (int s = 0; s < 7; ++s) { const float t = ar * ar - ai * ai; ai = 2.f * ar * ai; ar = t; }
            pr[nh] = ar; pi[nh] = ai; }
        float hr[2] = {0.f, 0.f}, hi_[2] = {0.f, 0.f};
        const float* e = E + ((((size_t)(1 * 32 + g) * 4 + b) * NBLK) * 64) * 2;
        const int pos = blk == 1 ? 0 : (blk == 0 ? 1 : 35 - blk);
        for (int ci = 0; ci < pos; ++ci) {
            const int s = ci == 0 ? 1 : (ci == 1 ? 0 : 35 - ci);
#pragma unroll
            for (int nh = 0; nh < 2; ++nh) { const f32x2 ev = *(const f32x2*)(e + ((size_t)s * 64 + nl + 32 * nh) * 2);
                const float nr_ = pr[nh] * hr[nh] - pi[nh] * hi_[nh] + ev.x, ni_ = pr[nh] * hi_[nh] + pi[nh] * hr[nh] + ev.y; hr[nh] = nr_; hi_[nh] = ni_; }
        }
        const int tk = lane & 15, kq = lane >> 4;
        const f32x4 dv = *(const f32x4*)(P.dskip + g * 16 + 4 * kq);
#pragma unroll
        for (int cc = 0; cc < 8; ++cc) {
            const int c = 7 - cc;
            chunk_scan<true>(zraw, g, bp, blk, c, lane, dc, hr, hi_, accR, accI);
            readout(hs, lane, Cf, accR, accI, yf[c]);
#pragma unroll
            for (int beta = 0; beta < 2; ++beta) {
                const int row = rowof(2 * bp + beta, blk, 16 * c + tk);
                const u32x2 uw = *(const u32x2*)(zraw + (size_t)row * 1024 + g * 16 + 4 * kq);
                const f32x4 yv = yf[c][beta];
                const float v0 = yv[0] + dv[0] * bflo(uw.x), v1 = yv[1] + dv[1] * bfhi(uw.x), v2 = yv[2] + dv[2] * bflo(uw.y), v3 = yv[3] + dv[3] * bfhi(uw.y);
                u32x2 ow; ow.x = pk2(gelu_tanh(v0), gelu_tanh(v1)); ow.y = pk2(gelu_tanh(v2), gelu_tanh(v3));
                *(u32x2*)(gg + (size_t)row * 512 + g * 16 + 4 * kq) = ow;
            }
        }
    }
}
}
typedef const float* __attribute__((address_space(4))) const* KargPtrTable;
#define KIN(k) (((KargPtrTable)__builtin_amdgcn_kernarg_segment_ptr())[k])
struct Ctx {
    float* out; unsigned char* ws;
    LAS unsigned char* lds;
    int tid, lane, wave, G, gw, NGW, bid;
};

__device__ __forceinline__ void tr_item(const float* src, int sld, int c0, int k0, int srcK, bf16* dst, int dld, int n0, bool zero, LAS float* scr, int lane) {
    const int c = lane & 7;
    if (zero || k0 >= srcK) {
#pragma unroll
        for (int j = 0; j < 4; ++j) { const int n = (lane >> 3) + 8 * j; *(u32x4*)(dst + (size_t)(n0 + n) * dld + k0 + 8 * c) = (u32x4){0u, 0u, 0u, 0u}; }
        return;
    }
#pragma unroll 8
    for (int i = 0; i < 32; ++i) { const int kk = 2 * i + (lane >> 5); scr[kk * 33 + (lane & 31)] = src[(size_t)(k0 + kk) * sld + c0 + (lane & 31)]; }
    asm volatile("s_waitcnt lgkmcnt(0)" ::: "memory");
#pragma unroll
    for (int j = 0; j < 4; ++j) { const int n = (lane >> 3) + 8 * j; const LAS float* s = scr + (8 * c) * 33 + n;
        u32x4 o; o.x = pk2(s[0 * 33], s[1 * 33]); o.y = pk2(s[2 * 33], s[3 * 33]); o.z = pk2(s[4 * 33], s[5 * 33]); o.w = pk2(s[6 * 33], s[7 * 33]);
        *(u32x4*)(dst + (size_t)(n0 + n) * dld + k0 + 8 * c) = o; }
    asm volatile("s_waitcnt lgkmcnt(0)" ::: "memory");
}

__device__ __forceinline__ void p0_weights(const Ctx& F) {
    LAS float* scr = (LAS float*)(F.lds + F.wave * 16384);
    constexpr int PER_I = 512 + 512 + 128 + 96 + 128 + 1024 + 512;
    constexpr int DENSE = 2 * PER_I, PER_LE = 512 + 256, TOTAL = DENSE + 128 * PER_LE;
    for (int it = F.gw; it < TOTAL; it += F.NGW) {
        if (it < DENSE) {
            const int i = it / PER_I; int r = it % PER_I;
            if (r < 512) { const int nb = r >> 4, kb = r & 15;
                tr_item(KIN(8) + (size_t)i * 1024 * 928, 928, nb * 32, kb * 64, 1024, (bf16*)(F.ws + WS_W_IN) + (size_t)i * 1024 * 1024, 1024, nb * 32, nb >= 29, scr, F.lane); continue; } r -= 512;
            if (r < 512) { const int nb = r >> 4, kb = r & 15;
                tr_item(KIN(9) + (size_t)i * 1024 * 1024, 1024, nb * 32, kb * 64, 1024, (bf16*)(F.ws + WS_W_OUTE) + (size_t)i * 1024 * 1024, 1024, nb * 32, false, scr, F.lane); continue; } r -= 512;
            if (r < 128) { const int nb = r >> 3, kb = r & 7;
                tr_item(KIN(18) + (size_t)i * 512 * 512, 512, nb * 32, kb * 64, 512, (bf16*)(F.ws + WS_W_GLU) + (size_t)i * 512 * 512, 512, nb * 32, false, scr, F.lane); continue; } r -= 128;
            if (r < 96) { const int nb = r >> 2, kb = r & 3;
                tr_item(KIN(20) + (size_t)i * 256 * 768, 768, nb * 32, kb * 64, 256, (bf16*)(F.ws + WS_W_MLA) + (size_t)i * 1792 * 256, 256, nb * 32, false, scr, F.lane); continue; } r -= 96;
            if (r < 128) { const int nb = r >> 2, kb = r & 3;
                tr_item(KIN(22) + (size_t)i * 128 * 1024, 1024, nb * 32, kb * 64, 128, (bf16*)(F.ws + WS_W_MLA) + (size_t)i * 1792 * 256, 256, 768 + nb * 32, false, scr, F.lane); continue; } r -= 128;
            if (r < 1024) { const int nb = r >> 4, kb = r & 15;
                tr_item(KIN(25) + (size_t)i * 1024 * 2048, 2048, nb * 32, kb * 64, 1024, (bf16*)(F.ws + WS_W_QKV) + (size_t)i * 2048 * 1024, 1024, nb * 32, false, scr, F.lane); continue; } r -= 1024;
            { const int nb = r >> 4, kb = r & 15;
                tr_item(KIN(26) + (size_t)i * 1024 * 1024, 1024, nb * 32, kb * 64, 1024, (bf16*)(F.ws + WS_W_OUTO) + (size_t)i * 1024 * 1024, 1024, nb * 32, false, scr, F.lane); }
        } else {
            const int q = it - DENSE, le = q / PER_LE; int r = q % PER_LE;
            if (r < 512) { const int nb = r >> 4, kb = r & 15;
                const int n0 = nb * 32, pn = n0 >> 8, w = n0 & 255;
                const float* src = (w < 128 ? KIN(33) : KIN(34)) + (size_t)le * 1024 * 512;
                tr_item(src, 512, pn * 128 + (w & 127), kb * 64, 1024, (bf16*)(F.ws + WS_W_GU) + (size_t)le * 1024 * 1024, 1024, n0, false, scr, F.lane);
            } else { r -= 512; const int nb = r >> 3, kb = r & 7;
                tr_item(KIN(35) + (size_t)le * 512 * 1024, 1024, nb * 32, kb * 64, 512, (bf16*)(F.ws + WS_W_DN) + (size_t)le * 1024 * 512, 512, nb * 32, false, scr, F.lane); }
        }
    }
}

__device__ __forceinline__ void p0_ada(const Ctx& F) {
    LAS float* sc = (LAS float*)(F.lds);
    LAS float* red = (LAS float*)(F.lds + 32768);
    for (int i = F.tid; i < 5 * 1024; i += 512) { const int r = i >> 10, k = i & 1023; const float v = r < 4 ? KIN(1)[r * 1024 + k] : KIN(3)[k]; sc[i] = siluf_(v); }
    __syncthreads();
    const int id = F.bid, l = id / 48, col0 = (id % 48) * 128;
    float a[5][2];
#pragma unroll
    for (int r = 0; r < 5; ++r) { a[r][0] = 0.f; a[r][1] = 0.f; }
    const float* wp = KIN(4) + ((size_t)l * 1024 + F.wave * 128) * NMOD + col0 + 2 * F.lane;
#pragma unroll 8
    for (int k = 0; k < 128; ++k) { const f32x2 w2 = *(const f32x2*)(wp + (size_t)k * NMOD);
#pragma unroll
        for (int r = 0; r < 5; ++r) { const float s = sc[r * 1024 + F.wave * 128 + k]; a[r][0] += s * w2.x; a[r][1] += s * w2.y; } }
#pragma unroll
    for (int r = 0; r < 5; ++r) { red[(F.wave * 5 + r) * 128 + 2 * F.lane] = a[r][0]; red[(F.wave * 5 + r) * 128 + 2 * F.lane + 1] = a[r][1]; }
    __syncthreads();
    for (int i = F.tid; i < 5 * 128; i += 512) { const int r = i >> 7, cc = i & 127; float s = KIN(5)[l * NMOD + col0 + cc];
#pragma unroll
        for (int w = 0; w < 8; ++w) s += red[(w * 5 + r) * 128 + cc];
        ((float*)(F.ws + WS_MOD))[((size_t)l * 5 + r) * NMOD + col0 + cc] = s; }
    __syncthreads();
}
__device__ __forceinline__ void p0_rope(const Ctx& F) {
    float* t = (float*)(F.ws + WS_ROPE);
    for (int i = F.tid; i < 64 * 32; i += 512) { const int p = i >> 5, f = i & 31; const float inv = __builtin_amdgcn_exp2f(-(float)f * (13.287712379549449f / 32.f));
        float rev = (float)p * inv * 0.15915494309189535f; rev -= floorf(rev);
        t[2 * i] = __builtin_amdgcn_cosf(rev); t[2 * i + 1] = __builtin_amdgcn_sinf(rev); }
    for (int i = F.tid; i < 64 * 8; i += 512) { const int p = i >> 3, f = i & 7; const float inv = __builtin_amdgcn_exp2f(-(float)f * (13.287712379549449f / 8.f));
        float rev = (float)p * inv * 0.15915494309189535f; rev -= floorf(rev);
        t[ROPE32_OFF + 2 * i] = __builtin_amdgcn_cosf(rev); t[ROPE32_OFF + 2 * i + 1] = __builtin_amdgcn_sinf(rev); }
}

struct RowV { f32x4 v[4]; };
__device__ __forceinline__ void ld_row_f32(const float* p, int lane, RowV& r) {
#pragma unroll
    for (int j = 0; j < 4; ++j) r.v[j] = *(const f32x4*)(p + 4 * lane + 256 * j);
}
__device__ __forceinline__ float row_sumsq(const RowV& r) {
    float s = 0.f;
#pragma unroll
    for (int j = 0; j < 4; ++j) s += (r.v[j][0] * r.v[j][0] + r.v[j][1] * r.v[j][1]) + (r.v[j][2] * r.v[j][2] + r.v[j][3] * r.v[j][3]);
    return wave_sum(s);
}
__device__ __forceinline__ const float* xsrc_row(const Ctx& F, int l, int row) {
    if (l == 0) return row < LAT_ROWS ? KIN(0) + (size_t)row * DM : KIN(2) + (size_t)(row - LAT_ROWS) * DM;
    return (const float*)(F.ws + WS_XRES) + (size_t)row * DM;
}
__device__ __forceinline__ void rows_norm1(const Ctx& F, int l) {
    const float* mod = (const float*)(F.ws + WS_MOD);
    const bf16* ydn = (const bf16*)(F.ws + WS_YDN);
    float* xres = (float*)(F.ws + WS_XRES);
    bf16* h = (bf16*)(F.ws + WS_H);
    const float* g1 = KIN(6) + l * DM;
    for (int row = F.gw; row < TOK; row += F.NGW) {
        const int mr = modrow_of(row);
        RowV x; ld_row_f32(xsrc_row(F, l, row), F.lane, x);
        if (l > 0) {
            const float* g2 = mod + ((size_t)(l - 1) * 5 + mr) * NMOD + 5 * DM;
#pragma unroll
            for (int j = 0; j < 4; ++j) { const int col = 4 * F.lane + 256 * j;
                const u32x2 y0 = *(const u32x2*)(ydn + (size_t)(2 * row) * DM + col), y1 = *(const u32x2*)(ydn + (size_t)(2 * row + 1) * DM + col);
                const f32x4 gv = *(const f32x4*)(g2 + col);
                x.v[j][0] += gv[0] * (bflo(y0.x) + bflo(y1.x)); x.v[j][1] += gv[1] * (bfhi(y0.x) + bfhi(y1.x));
                x.v[j][2] += gv[2] * (bflo(y0.y) + bflo(y1.y)); x.v[j][3] += gv[3] * (bfhi(y0.y) + bfhi(y1.y));
                *(f32x4*)(xres + (size_t)row * DM + col) = x.v[j]; }
        }
        const float rinv = rsqrtf(row_sumsq(x) * (1.f / DM) + RMS_EPS);
        const float* mrow = mod + ((size_t)l * 5 + mr) * NMOD;
#pragma unroll
        for (int j = 0; j < 4; ++j) { const int col = 4 * F.lane + 256 * j;
            const f32x4 gv = *(const f32x4*)(g1 + col), sh = *(const f32x4*)(mrow + col), scl = *(const f32x4*)(mrow + DM + col);
            float o[4];
#pragma unroll
            for (int i = 0; i < 4; ++i) o[i] = x.v[j][i] * rinv * gv[i] * (1.f + scl[i]) + sh[i];
            u32x2 w; w.x = pk2(o[0], o[1]); w.y = pk2(o[2], o[3]);
            *(u32x2*)(h + (size_t)row * DM + col) = w; }
    }
}
__device__ __forceinline__ void rows_norm2_router(const Ctx& F, int l) {
    const float* mod = (const float*)(F.ws + WS_MOD);
    const float* xres = (const float*)(F.ws + WS_XRES);
    bf16* gb = (bf16*)(F.ws + WS_H);
    const float* g2w = KIN(7) + l * DM;
    const float* wr1 = KIN(29) + (size_t)l * DM * 4; const float* br1 = KIN(30) + l * 4;
    const float* wr2 = KIN(31) + (size_t)l * DM * 32; const float* br2 = KIN(32) + l * 32;
    unsigned* cnt = (unsigned*)(F.ws + WS_CTL) + CW_CNT + l * 64;
    int* list = (int*)(F.ws + WS_LIST);
    float* gatew = (float*)(F.ws + WS_GATEW);
    const int nrows = (l == DEPTH - 1) ? LAT_ROWS : TOK;
    for (int row = F.gw; row < nrows; row += F.NGW) {
        const int mr = modrow_of(row);
        RowV x; ld_row_f32(xres + (size_t)row * DM, F.lane, x);
        const float rinv = rsqrtf(row_sumsq(x) * (1.f / DM) + RMS_EPS);
        const float* mrow = mod + ((size_t)l * 5 + mr) * NMOD;
        float l1[4] = {0.f, 0.f, 0.f, 0.f};
#pragma unroll
        for (int j = 0; j < 4; ++j) { const int col = 4 * F.lane + 256 * j;
            const f32x4 gv = *(const f32x4*)(g2w + col), sh = *(const f32x4*)(mrow + 3 * DM + col), scl = *(const f32x4*)(mrow + 4 * DM + col);
#pragma unroll
            for (int i = 0; i < 4; ++i) { x.v[j][i] = x.v[j][i] * rinv * gv[i] * (1.f + scl[i]) + sh[i];
                const f32x4 w = *(const f32x4*)(wr1 + (size_t)(col + i) * 4);
                l1[0] += x.v[j][i] * w[0]; l1[1] += x.v[j][i] * w[1]; l1[2] += x.v[j][i] * w[2]; l1[3] += x.v[j][i] * w[3]; }
            u32x2 w2; w2.x = pk2(x.v[j][0], x.v[j][1]); w2.y = pk2(x.v[j][2], x.v[j][3]);
            *(u32x2*)(gb + (size_t)row * DM + col) = w2; }
#pragma unroll
        for (int i = 0; i < 4; ++i) l1[i] = wave_sum(l1[i]) + br1[i];
        int grp = 0; float best = l1[0];
#pragma unroll
        for (int i = 1; i < 4; ++i) if (l1[i] > best) { best = l1[i]; grp = i; }
        float den = 0.f;
#pragma unroll
        for (int i = 0; i < 4; ++i) den += __expf(l1[i] - best);
        const float pgrp = 1.f / den;
        float l2[8] = {0.f, 0.f, 0.f, 0.f, 0.f, 0.f, 0.f, 0.f};
#pragma unroll
        for (int j = 0; j < 4; ++j) { const int col = 4 * F.lane + 256 * j;
#pragma unroll
            for (int i = 0; i < 4; ++i) { const float* wp = wr2 + (size_t)(col + i) * 32 + grp * 8; const f32x4 wa = *(const f32x4*)wp, wb = *(const f32x4*)(wp + 4);
                const float xv = x.v[j][i];
                l2[0] += xv * wa[0]; l2[1] += xv * wa[1]; l2[2] += xv * wa[2]; l2[3] += xv * wa[3];
                l2[4] += xv * wb[0]; l2[5] += xv * wb[1]; l2[6] += xv * wb[2]; l2[7] += xv * wb[3]; } }
#pragma unroll
        for (int i = 0; i < 8; ++i) l2[i] = wave_sum(l2[i]) + br2[grp * 8 + i];
        int i0 = 0; float v0 = l2[0];
#pragma unroll
        for (int i = 1; i < 8; ++i) if (l2[i] > v0) { v0 = l2[i]; i0 = i; }
        int i1 = -1; float v1 = -3.0e38f;
#pragma unroll
        for (int i = 0; i < 8; ++i) if (i != i0 && l2[i] > v1) { v1 = l2[i]; i1 = i; }
        const float e1 = __expf(v1 - v0), w0 = 1.f / (1.f + e1), w1 = e1 * w0;
        if (F.lane == 0) {
            const int ea = grp * 8 + i0, eb = grp * 8 + i1;
            const unsigned ra = atomicAdd(&cnt[ea], 1u); list[(size_t)ea * LIST_CAP + ra] = row * 2;
            const unsigned rb = atomicAdd(&cnt[eb], 1u); list[(size_t)eb * LIST_CAP + rb] = row * 2 + 1;
            gatew[row * 2] = pgrp * w0; gatew[row * 2 + 1] = pgrp * w1;
        }
    }
}
__device__ __forceinline__ void rows_mla_pre(const Ctx& F, int i) {
    const bf16* z = (const bf16*)(F.ws + WS_ZRAW); bf16* ac = (bf16*)(F.ws + WS_ACAT);
    const float* gq = KIN(19) + i * 256; const float* gkv = KIN(21) + i * 128;
    for (int row = F.gw; row < TOK; row += F.NGW) {
        const u32x2 qv = *(const u32x2*)(z + (size_t)row * 1024 + 512 + 4 * F.lane);
        const float q0 = bflo(qv.x), q1 = bfhi(qv.x), q2 = bflo(qv.y), q3 = bfhi(qv.y);
        const float rq = rsqrtf(wave_sum(q0 * q0 + q1 * q1 + q2 * q2 + q3 * q3) * (1.f / 256.f) + RMS_EPS);
        const f32x4 gv = *(const f32x4*)(gq + 4 * F.lane);
        u32x2 w; w.x = pk2(q0 * rq * gv[0], q1 * rq * gv[1]); w.y = pk2(q2 * rq * gv[2], q3 * rq * gv[3]);
        *(u32x2*)(ac + (size_t)row * 512 + 4 * F.lane) = w;
        float k0 = 0.f, k1 = 0.f, k2 = 0.f, k3 = 0.f;
        if (F.lane < 32) { const u32x2 kv = *(const u32x2*)(z + (size_t)row * 1024 + 768 + 4 * F.lane); k0 = bflo(kv.x); k1 = bfhi(kv.x); k2 = bflo(kv.y); k3 = bfhi(kv.y); }
        const float rk = rsqrtf(wave_sum(k0 * k0 + k1 * k1 + k2 * k2 + k3 * k3) * (1.f / 128.f) + RMS_EPS);
        u32x2 w2 = (u32x2){0u, 0u};
        if (F.lane < 32) { const f32x4 gk = *(const f32x4*)(gkv + 4 * F.lane); w2.x = pk2(k0 * rk * gk[0], k1 * rk * gk[1]); w2.y = pk2(k2 * rk * gk[2], k3 * rk * gk[3]); }
        *(u32x2*)(ac + (size_t)row * 512 + 256 + 4 * F.lane) = w2;
    }
}
__device__ __forceinline__ void rows_mla_post(const Ctx& F, int i) {
    const bf16* qk = (const bf16*)(F.ws + WS_QKVM); const bf16* z = (const bf16*)(F.ws + WS_ZRAW);
    bf16* Qb = (bf16*)(F.ws + WS_QB); bf16* Kb = (bf16*)(F.ws + WS_KB); bf16* Vb = (bf16*)(F.ws + WS_VB);
    const float* qn = KIN(23) + i * 96; const float* kn = KIN(24) + i * 96;
    const float* rope = (const float*)(F.ws + WS_ROPE) + ROPE32_OFF;
    const int lane = F.lane, a = (lane >> 3) & 1, f = lane & 7;
    const float qn_n = qn[lane], kn_n = kn[lane];
    const float qn_1 = qn[64 + a * 16 + f], qn_2 = qn[64 + a * 16 + 8 + f], kn_1 = kn[64 + a * 16 + f], kn_2 = kn[64 + a * 16 + 8 + f];
    for (int row = F.gw; row < TOK; row += F.NGW) {
        int b, pos; bool lat = row < LAT_ROWS; float cs = 1.f, sn = 0.f;
        if (lat) { b = row >> 12; const int t = row & 4095; pos = 256 + t; const int pa = a == 0 ? (t >> 6) : (t & 63); cs = rope[(pa * 8 + f) * 2]; sn = rope[(pa * 8 + f) * 2 + 1]; }
        else { b = (row - LAT_ROWS) >> 8; pos = (row - LAT_ROWS) & 255; }
        const bf16* qr = qk + (size_t)row * 1792; const bf16* kr = z + (size_t)row * 1024 + 896;
        float kx1 = 0.f, kx2 = 0.f;
        if (lane < 16) { kx1 = bf2f(kr[a * 16 + f]); kx2 = bf2f(kr[a * 16 + 8 + f]); }
        for (int hd = 0; hd < 8; ++hd) {
            const size_t obase = ((size_t)(b * 8 + hd) * SKV + pos);
            { const float xn = bf2f(qr[96 * hd + lane]); float x1 = 0.f, x2 = 0.f;
              if (lane < 16) { x1 = bf2f(qr[96 * hd + 64 + a * 16 + f]); x2 = bf2f(qr[96 * hd + 64 + a * 16 + 8 + f]); }
              const float rinv = rsqrtf(wave_sum(xn * xn + x1 * x1 + x2 * x2) * (1.f / 96.f) + RMS_EPS);
              bf16* o = Qb + obase * 128;
              o[lane] = (bf16)f2bf(xn * rinv * qn_n);
              if (lane < 16) { const float y1 = x1 * rinv * qn_1, y2 = x2 * rinv * qn_2;
                  o[64 + a * 16 + f] = (bf16)f2bf(y1 * cs - y2 * sn); o[64 + a * 16 + 8 + f] = (bf16)f2bf(y2 * cs + y1 * sn); }
              else if (lane >= 32) o[96 + lane - 32] = 0; }
            { const float xn = bf2f(qr[768 + hd * 128 + lane]);
              const float rinv = rsqrtf(wave_sum(xn * xn + kx1 * kx1 + kx2 * kx2) * (1.f / 96.f) + RMS_EPS);
              bf16* o = Kb + obase * 128;
              o[lane] = (bf16)f2bf(xn * rinv * kn_n);
              if (lane < 16) { const float y1 = kx1 * rinv * kn_1, y2 = kx2 * rinv * kn_2;
                  o[64 + a * 16 + f] = (bf16)f2bf(y1 * cs - y2 * sn); o[64 + a * 16 + 8 + f] = (bf16)f2bf(y2 * cs + y1 * sn); }
              else if (lane >= 32) o[96 + lane - 32] = 0;
              Vb[obase * 64 + lane] = qr[768 + hd * 128 + 64 + lane]; }
        }
    }
}
__device__ __forceinline__ void rows_gqa_post(const Ctx& F, int i) {
    const bf16* z = (const bf16*)(F.ws + WS_ZRAW);
    bf16* Qb = (bf16*)(F.ws + WS_QB); bf16* Kb = (bf16*)(F.ws + WS_KB); bf16* Vb = (bf16*)(F.ws + WS_VB);
    const float* qn = KIN(27) + i * 128; const float* kn = KIN(28) + i * 128;
    const float* rope = (const float*)(F.ws + WS_ROPE);
    const int lane = F.lane, a = lane >> 5, f = lane & 31;
    const float qn1 = qn[a * 64 + f], qn2 = qn[a * 64 + 32 + f], kn1 = kn[a * 64 + f], kn2 = kn[a * 64 + 32 + f];
    for (int row = F.gw; row < TOK; row += F.NGW) {
        int b, pos; const bool lat = row < LAT_ROWS; float cs = 1.f, sn = 0.f;
        if (lat) { b = row >> 12; const int t = row & 4095; pos = 256 + t; const int pa = a == 0 ? (t >> 6) : (t & 63); cs = rope[(pa * 32 + f) * 2]; sn = rope[(pa * 32 + f) * 2 + 1]; }
        else { b = (row - LAT_ROWS) >> 8; pos = (row - LAT_ROWS) & 255; }
        const bf16* r = z + (size_t)row * 2048;
        for (int hd = 0; hd < 12; ++hd) {
            const bf16* src = r + hd * 128;
            const float x1 = bf2f(src[a * 64 + f]), x2 = bf2f(src[a * 64 + 32 + f]);
            const float rinv = rsqrtf(wave_sum(x1 * x1 + x2 * x2) * (1.f / 128.f) + RMS_EPS);
            const float y1 = x1 * rinv * (hd < 8 ? qn1 : kn1), y2 = x2 * rinv * (hd < 8 ? qn2 : kn2);
            bf16* o = hd < 8 ? Qb + ((size_t)(b * 8 + hd) * SKV + pos) * 128 : Kb + ((size_t)(b * 4 + hd - 8) * SKV + pos) * 128;
            o[a * 64 + f] = (bf16)f2bf(y1 * cs - y2 * sn); o[a * 64 + 32 + f] = (bf16)f2bf(y2 * cs + y1 * sn);
        }
#pragma unroll
        for (int kvh = 0; kvh < 4; ++kvh) { const unsigned v = *(const unsigned*)(r + 1536 + kvh * 128 + 2 * lane);
            *(unsigned*)(Vb + ((size_t)(b * 4 + kvh) * SKV + pos) * 128 + 2 * lane) = v; }
    }
}
#ifndef DBG_FINAL_L
#define DBG_FINAL_L (DEPTH - 1)
#endif
__device__ __forceinline__ void rows_final(const Ctx& F) {
    const float* mod = (const float*)(F.ws + WS_MOD); const bf16* ydn = (const bf16*)(F.ws + WS_YDN); const float* xres = (const float*)(F.ws + WS_XRES);
#ifdef DBG_X_ONLY
    xres = KIN(0);
#endif
    for (int row = F.gw; row < LAT_ROWS; row += F.NGW) {
        const float* g2 = mod + ((size_t)(DBG_FINAL_L < 0 ? 0 : DBG_FINAL_L) * 5 + (row >> 12)) * NMOD + 5 * DM;
#pragma unroll
        for (int j = 0; j < 4; ++j) { const int col = 4 * F.lane + 256 * j;
            f32x4 xv = *(const f32x4*)(xres + (size_t)row * DM + col);
            if (DBG_FINAL_L < 0) { *(f32x4*)(F.out + (size_t)row * DM + col) = xv; continue; }
            const u32x2 y0 = *(const u32x2*)(ydn + (size_t)(2 * row) * DM + col), y1 = *(const u32x2*)(ydn + (size_t)(2 * row + 1) * DM + col);
            const f32x4 gv = *(const f32x4*)(g2 + col);
            xv[0] += gv[0] * (bflo(y0.x) + bflo(y1.x)); xv[1] += gv[1] * (bfhi(y0.x) + bfhi(y1.x));
            xv[2] += gv[2] * (bflo(y0.y) + bflo(y1.y)); xv[3] += gv[3] * (bfhi(y0.y) + bfhi(y1.y));
            *(f32x4*)(F.out + (size_t)row * DM + col) = xv; }
    }
}
#define XB_TMO      128
#define XB_XCNT(j)  (256  + 64 * (j))
#define XB_XSUB(j)  (1280 + 64 * (j))
#define XB_XGEN(j)  (2304 + 64 * (j))
#define XB_TOP      3328
#define XB_TOPGEN   3392
#define XCD_BAR_WORDS 3456
#define XB_SPIN_CAP (1u << 22)
__device__ __forceinline__ unsigned xb_ld(unsigned* p)              { return __hip_atomic_load(p, __ATOMIC_RELAXED, __HIP_MEMORY_SCOPE_AGENT); }
__device__ __forceinline__ unsigned xb_add(unsigned* p, unsigned v) { return __hip_atomic_fetch_add(p, v, __ATOMIC_RELAXED, __HIP_MEMORY_SCOPE_AGENT); }
__device__ __forceinline__ unsigned xb_xcc_id() { return (unsigned)__builtin_amdgcn_s_getreg((3 << 11) | 20) & 0xFu; }
#define XB_SPIN(cond, bar) do { unsigned _sp = 0; while (cond) { __builtin_amdgcn_s_sleep(1); \
    if ((++_sp & 255u) == 0u) { if (xb_ld(&(bar)[XB_TMO])) break; if (_sp > XB_SPIN_CAP) { atomicAdd(&(bar)[XB_TMO], 1u); break; } } } } while (0)
struct XcdBarrier { unsigned* bar; unsigned x; volatile LAS unsigned* st; };
__device__ __forceinline__ XcdBarrier xcd_barrier_post(unsigned* bar, volatile LAS unsigned* st) {
    XcdBarrier b; b.bar = bar; b.x = xb_xcc_id(); b.st = st;
    if (threadIdx.x == 0) (void)xb_add(&bar[XB_XCNT(b.x)], 1u);
    return b;
}
__device__ __forceinline__ void xcd_barrier_complete(unsigned* bar, unsigned x, unsigned& nloc, unsigned& nx) {
    const unsigned G = gridDim.x * gridDim.y * gridDim.z;
    unsigned sum, cnt, mine, sp = 0u;
    for (;;) {
        sum = 0u; cnt = 0u; mine = 0u;
#pragma unroll
        for (unsigned j = 0; j < 16; ++j) { const unsigned c = xb_ld(&bar[XB_XCNT(j)]); sum += c; cnt += (c > 0u) ? 1u : 0u; mine = (j == x) ? c : mine; }
        if (sum == G) break;
        __builtin_amdgcn_s_sleep(1);
        if ((++sp & 255u) == 0u) { if (xb_ld(&bar[XB_TMO])) break; if (sp > XB_SPIN_CAP) { atomicAdd(&bar[XB_TMO], 1u); break; } }
    }
    nloc = mine > 0u ? mine : 1u; nx = cnt > 0u ? cnt : 1u;
}
__device__ __forceinline__ void xcd_barrier(const XcdBarrier& b) {
    asm volatile("s_waitcnt vmcnt(0)" ::: "memory");
    __syncthreads();
    if (threadIdx.x == 0) {
        unsigned* bar = b.bar;
        __builtin_amdgcn_s_waitcnt(0);
        unsigned nloc = b.st[0], nx = b.st[1];
        if (nloc == 0u) { xcd_barrier_complete(bar, b.x, nloc, nx); b.st[0] = nloc; b.st[1] = nx; }
        const unsigned old = xb_add(&bar[XB_XSUB(b.x)], 1u);
        const unsigned gen = old / nloc;
        if (old + 1u == (gen + 1u) * nloc) {
            __builtin_amdgcn_fence(__ATOMIC_RELEASE, "agent");
            asm volatile("s_waitcnt vmcnt(0)" ::: "memory");
            const unsigned og = xb_add(&bar[XB_TOP], 1u);
            const unsigned tg = og / nx;
            if (og + 1u == (tg + 1u) * nx) xb_add(&bar[XB_TOPGEN], 1u);
            else XB_SPIN(xb_ld(&bar[XB_TOPGEN]) == tg, bar);
            __builtin_amdgcn_fence(__ATOMIC_ACQUIRE, "agent");
            xb_add(&bar[XB_XGEN(b.x)], 1u);
            asm volatile("s_waitcnt vmcnt(0)" ::: "memory");
        } else {
            XB_SPIN(xb_ld(&bar[XB_XGEN(b.x)]) == gen, bar);
            __builtin_amdgcn_fence(__ATOMIC_ACQUIRE, "agent");
            asm volatile("s_waitcnt vmcnt(0)" ::: "memory");
        }
    }
    __syncthreads();
}

constexpr int NPH = 1 + 2 * 11 + 2 * 8 + 1;
constexpr int G_NONE = -1;
using pg8::G_INPROJ; using pg8::G_MLA; using pg8::G_GLU; using pg8::G_OUT; using pg8::G_QKV; using pg8::G_MOE1; using pg8::G_MOE2;
enum { K_NONE = 0, K_NORM1, K_MLA_PRE_S5A, K_MLA_POST, K_S5B_ATT, K_NORM2, K_GQA_POST, K_ATT_GQA };

__device__ __forceinline__ void attention_phase(const Ctx& F, int l, bool even) {
    const bf16* Qb = (const bf16*)(F.ws + WS_QB); const bf16* Kb = (const bf16*)(F.ws + WS_KB); const bf16* Vb = (const bf16*)(F.ws + WS_VB);
    bf16* mix = (bf16*)(F.ws + WS_MIX);
    const int c = F.bid, x = c & 7, slot = c >> 3;
    const int nround = (l == DEPTH - 1) ? 2 : 3;
    for (int round = 0; round < nround; ++round) {
        int b, h, qb; bool ctxu = false;
        if (round < 2) {
            if (even) { const int pair = round * 16 + x * 2 + (slot >> 4); b = pair >> 3; h = pair & 7; qb = slot & 15; }
            else { const int pair = round * 8 + x; b = pair >> 2; h = (pair & 3) * 2 + (slot >> 4); qb = slot & 15; }
        } else { if (c >= 32) break; b = c >> 3; h = c & 7; qb = 0; ctxu = true; }
        const size_t qrow = (size_t)(b * 8 + h) * SKV + (ctxu ? 0 : 256 + qb * 256);
        const int orow = ctxu ? LAT_ROWS + b * 256 : b * 4096 + qb * 256;
        const int seq = ctxu ? CTXL : SKV;
        if (even) {
            att::attn_dense_body<64, 1, 1024>(Qb + qrow * 128, Kb + (size_t)(b * 8 + h) * SKV * 128, Vb + (size_t)(b * 8 + h) * SKV * 64,
                                              mix + (size_t)orow * 1024 + 512 + h * 64, seq, (char*)F.lds, F.tid);
        } else {
            const int kvh = h >> 1;
            att::attn_dense_body<128, 0, 1024>(Qb + qrow * 128, Kb + (size_t)(b * 4 + kvh) * SKV * 128, Vb + (size_t)(b * 4 + kvh) * SKV * 128,
                                               mix + (size_t)orow * 1024 + h * 128, seq, (char*)F.lds, F.tid);
        }
    }
}


#ifdef DBG_CHECKS
constexpr int CW_FLAGS = 20000;
__device__ __forceinline__ void dbg_flag(const Ctx& F, int j) { atomicOr((unsigned*)(F.ws + WS_CTL) + CW_FLAGS, 1u << j); }
__device__ __forceinline__ void dbg_moe_check(const Ctx& F, int l) {
    const unsigned* cnt = (const unsigned*)(F.ws + WS_CTL) + CW_CNT + l * 64; const int* list = (const int*)(F.ws + WS_LIST);
    const bf16* g = (const bf16*)(F.ws + WS_H); const bf16* act = (const bf16*)(F.ws + WS_ACT); const bf16* ydn = (const bf16*)(F.ws + WS_YDN);
    const float* gatew = (const float*)(F.ws + WS_GATEW);
    for (int s = F.gw; s < 96; s += F.NGW) {
        const int e = s & 31, which = s >> 5; const int c = (int)cnt[e]; if (c == 0) continue;
        const int pos = which == 0 ? 0 : (which == 1 ? c - 1 : (c > 300 ? 300 : c / 2));
        const int ent = list[(size_t)e * LIST_CAP + pos], row = ent >> 1;
        const float* wg = KIN(33) + ((size_t)l * 32 + e) * 1024 * 512; const float* wu = KIN(34) + ((size_t)l * 32 + e) * 1024 * 512; const float* wd = KIN(35) + ((size_t)l * 32 + e) * 512 * 1024;
        float h1[8], h2[8];
        for (int j = 0; j < 8; ++j) { h1[j] = 0.f; h2[j] = 0.f; }
        for (int k = 0; k < 1024; ++k) { const float gv = bf2f(g[(size_t)row * 1024 + k]);
            for (int j = 0; j < 8; ++j) { h1[j] += gv * wg[(size_t)k * 512 + F.lane + 64 * j]; h2[j] += gv * wu[(size_t)k * 512 + F.lane + 64 * j]; } }
        float err = 0.f, ss = 0.f;
        for (int j = 0; j < 8; ++j) { const float r = siluf_(h1[j]) * h2[j]; const float a = bf2f(act[(size_t)ent * 512 + F.lane + 64 * j]); err = fmaxf(err, fabsf(a - r)); ss += r * r; }
        err = wave_max(err); ss = wave_sum(ss);
        if (!(err <= 0.1f * __builtin_amdgcn_sqrtf(ss / 512.f) + 1e-6f)) { if (F.lane == 0) dbg_flag(F, 0); }
        float y[16];
        for (int j = 0; j < 16; ++j) y[j] = 0.f;
        for (int f = 0; f < 512; ++f) { const float av = bf2f(act[(size_t)ent * 512 + f]);
            for (int j = 0; j < 16; ++j) y[j] += av * wd[(size_t)f * 1024 + F.lane + 64 * j]; }
        const float gw = gatew[ent]; float err2 = 0.f, ss2 = 0.f;
        for (int j = 0; j < 16; ++j) { const float r = y[j] * gw; const float a = bf2f(ydn[(size_t)ent * 1024 + F.lane + 64 * j]); err2 = fmaxf(err2, fabsf(a - r)); ss2 += r * r; }
        err2 = wave_max(err2); ss2 = wave_sum(ss2);
        if (!(err2 <= 0.1f * __builtin_amdgcn_sqrtf(ss2 / 1024.f) + 1e-6f)) { if (F.lane == 0) dbg_flag(F, 1); }
        else if (ss2 > 1e-8f && ss > 1e-8f && F.lane == 0) dbg_flag(F, 3);
    }
}
__device__ __forceinline__ void dbg_mod_check(const Ctx& F, int l) {
    const float* mod = (const float*)(F.ws + WS_MOD);
    for (int s = F.gw; s < 60; s += F.NGW) {
        const int r = s % 5, n = (s * 509 + 77) % 6144;
        float ser = 0.f;
        for (int k = 0; k < 1024; ++k) { const float cv = r < 4 ? KIN(1)[r * 1024 + k] : KIN(3)[k]; ser += siluf_(cv) * KIN(4)[((size_t)l * 1024 + k) * 6144 + n]; }
        ser += KIN(5)[l * 6144 + n];
        float acc = 0.f;
        for (int k = F.lane; k < 1024; k += 64) { const float cv = r < 4 ? KIN(1)[r * 1024 + k] : KIN(3)[k]; acc += siluf_(cv) * KIN(4)[((size_t)l * 1024 + k) * 6144 + n]; }
        acc = wave_sum(acc) + KIN(5)[l * 6144 + n];
        const float got = mod[((size_t)l * 5 + r) * 6144 + n];
        if (!(fabsf(got - ser) <= 1e-3f + 1e-3f * fabsf(ser))) { if (F.lane == 0) dbg_flag(F, 0); }
        if (!(fabsf(acc - ser) <= 1e-3f + 1e-3f * fabsf(ser))) { if (F.lane == 0) dbg_flag(F, 1); }
    }
    return;
    const float* xres = (const float*)(F.ws + WS_XRES); const unsigned* cnt = (const unsigned*)(F.ws + WS_CTL) + CW_CNT + l * 64; const int* list = (const int*)(F.ws + WS_LIST);
    const float* gatew = (const float*)(F.ws + WS_GATEW); const bf16* gb = (const bf16*)(F.ws + WS_H);
    for (int s = F.gw; s < 64; s += F.NGW) {
        const int row = (s * 263 + 11) % TOK; const int mr = modrow_of(row);
        float ssq = 0.f;
        for (int k = F.lane; k < 1024; k += 64) { const float v = xres[(size_t)row * 1024 + k]; ssq += v * v; }
        const float rinv = rsqrtf(wave_sum(ssq) / 1024.f + 1e-6f);
        float lg[36];
#pragma unroll
        for (int j = 0; j < 36; ++j) lg[j] = 0.f;
        float gerr = 0.f;
        for (int k = F.lane; k < 1024; k += 64) {
            const float gv = xres[(size_t)row * 1024 + k] * rinv * KIN(7)[l * 1024 + k] * (1.f + mod[((size_t)l * 5 + mr) * 6144 + 4096 + k]) + mod[((size_t)l * 5 + mr) * 6144 + 3072 + k];
            gerr = fmaxf(gerr, fabsf(bf2f(gb[(size_t)row * 1024 + k]) - gv));
#pragma unroll
            for (int j = 0; j < 4; ++j) lg[j] += gv * KIN(29)[((size_t)l * 1024 + k) * 4 + j];
#pragma unroll
            for (int j = 0; j < 32; ++j) lg[4 + j] += gv * KIN(31)[((size_t)l * 1024 + k) * 32 + j];
        }
        gerr = wave_max(gerr);
#pragma unroll
        for (int j = 0; j < 36; ++j) lg[j] = wave_sum(lg[j]);
#pragma unroll
        for (int j = 0; j < 4; ++j) lg[j] += KIN(30)[l * 4 + j];
#pragma unroll
        for (int j = 0; j < 32; ++j) lg[4 + j] += KIN(32)[l * 32 + j];
        int grp = 0; float bestg = lg[0];
#pragma unroll
        for (int j = 1; j < 4; ++j) if (lg[j] > bestg) { bestg = lg[j]; grp = j; }
        float den = 0.f;
#pragma unroll
        for (int j = 0; j < 4; ++j) den += __expf(lg[j] - bestg);
        float l8[8];
#pragma unroll
        for (int j = 0; j < 8; ++j) { float v = 0.f;
#pragma unroll
            for (int q = 0; q < 4; ++q) v = (grp == q) ? lg[4 + q * 8 + j] : v;
            l8[j] = v; }
        int i0 = 0; float v0 = l8[0];
#pragma unroll
        for (int j = 1; j < 8; ++j) if (l8[j] > v0) { v0 = l8[j]; i0 = j; }
        int i1 = -1; float v1 = -3.0e38f;
#pragma unroll
        for (int j = 0; j < 8; ++j) if (j != i0 && l8[j] > v1) { v1 = l8[j]; i1 = j; }
        const float e1 = __expf(v1 - v0), w0 = 1.f / (1.f + e1) / den, w1 = e1 / (1.f + e1) / den;
        if (gerr > 0.05f && F.lane == 0) dbg_flag(F, 1);
        bool bad = false;
        if (fabsf(gatew[row * 2] - w0) > 1e-3f || fabsf(gatew[row * 2 + 1] - w1) > 1e-3f) bad = true;
        const int ea = grp * 8 + i0, eb = grp * 8 + i1; bool fa = false, fb = false;
        for (int q = F.lane; q < (int)cnt[ea]; q += 64) if (list[(size_t)ea * LIST_CAP + q] == row * 2) fa = true;
        for (int q = F.lane; q < (int)cnt[eb]; q += 64) if (list[(size_t)eb * LIST_CAP + q] == row * 2 + 1) fb = true;
        if (!__any(fa) || !__any(fb)) bad = true;
        if (bad && F.lane == 0) dbg_flag(F, 2);
    }
}
__device__ __forceinline__ void dbg_final(const Ctx& F) {
    const unsigned flags = ((const unsigned*)(F.ws + WS_CTL))[CW_FLAGS];
    for (int row = F.gw; row < LAT_ROWS; row += F.NGW) {
        bool zero = false;
        for (int j = 0; j < 4; ++j) { const int lo = 512 * ((1 << j) - 1), hi = 512 * ((2 << j) - 1); if (((flags >> j) & 1u) && row >= lo && row < hi) zero = true; }
#pragma unroll
        for (int j = 0; j < 4; ++j) { const int col = 4 * F.lane + 256 * j; f32x4 xv = *(const f32x4*)(KIN(0) + (size_t)row * DM + col); if (zero) xv = (f32x4){0.f, 0.f, 0.f, 0.f};
            *(f32x4*)(F.out + (size_t)row * DM + col) = xv; }
    }
}
#endif

__device__ __forceinline__ void run_phase(const Ctx& F0, int ph) {
    Ctx F = F0;
    asm volatile("" : "+s"(F.ws), "+s"(F.out), "+s"(F.bid), "+s"(F.G));
    asm volatile("" : "+v"(F.tid));
    F.lane = F.tid & 63; F.wave = __builtin_amdgcn_readfirstlane(F.tid >> 6); F.gw = F.bid * 8 + F.wave; F.NGW = F.G * 8;
    { unsigned ldsb = (unsigned)(uintptr_t)F0.lds; asm volatile("" : "+s"(ldsb)); F.lds = (LAS unsigned char*)(uintptr_t)ldsb; }
#ifndef T_NO_P0
    if (ph == 0) {
        if (F.bid < 192) p0_ada(F);
        else if (F.bid == 192) p0_rope(F);
        p0_weights(F);
        return;
    }
#endif
#ifdef DBG_CHECKS
    if (ph == NPH - 1) { dbg_final(F); return; }
    if (ph >= 100) { dbg_mod_check(F, ph - 100); return; }
#endif
    if (ph == NPH - 1) { rows_final(F); return; }
    int l, step; { int q = ph - 1; if (q < 11) { l = 0; step = q; } else if (q < 19) { l = 1; step = q - 11; } else if (q < 30) { l = 2; step = q - 19; } else { l = 3; step = q - 30; } }
    const bool even = (l & 1) == 0; const int i = l >> 1;
    int gid = G_NONE, kind = K_NONE;
    if (even) {
        switch (step) { case 0: kind = K_NORM1; break; case 1: gid = G_INPROJ; break; case 2: kind = K_MLA_PRE_S5A; break; case 3: gid = G_MLA; break; case 4: kind = K_MLA_POST; break;
                        case 5: kind = K_S5B_ATT; break; case 6: gid = G_GLU; break; case 7: gid = G_OUT; break; case 8: kind = K_NORM2; break; case 9: gid = G_MOE1; break; default: gid = G_MOE2; break; }
    } else {
        switch (step) { case 0: kind = K_NORM1; break; case 1: gid = G_QKV; break; case 2: kind = K_GQA_POST; break; case 3: kind = K_ATT_GQA; break; case 4: gid = G_OUT; break;
                        case 5: kind = K_NORM2; break; case 6: gid = G_MOE1; break; default: gid = G_MOE2; break; }
    }
    if (gid != G_NONE) {
        unsigned char* ws = F.ws;
        const unsigned* cnt = (const unsigned*)(ws + WS_CTL) + CW_CNT + l * 64;
        if (gid == G_MOE1 || gid == G_MOE2) {
            if (F.tid == 0) { LAS int* tp = (LAS int*)(F.lds + MISC_OFF + 256); int acc = 0;
                for (int e = 0; e < NEXP; ++e) { tp[e] = acc; acc += ((int)cnt[e] + 255) >> 8; } tp[NEXP] = acc; }
            __syncthreads();
        }
#define PROB_COMMON(P) P.G = F.G; P.c = F.bid; P.list = (const int*)(ws + WS_LIST); P.cnt = cnt; P.tp = (const LAS int*)(F.lds + MISC_OFF + 256); \
        P.l = l; P.ws = ws; P.O = nullptr; P.xlat = nullptr; P.xctx = nullptr;
        switch (gid) {
#ifndef T_NO_GEMM
        case G_INPROJ: { pg8::Prob<G_INPROJ> P; PROB_COMMON(P); P.A = (const char*)(ws + WS_H); P.B = (const char*)(ws + WS_W_IN) + (size_t)i * 1024 * 1024 * 2; P.O = (bf16*)(ws + WS_ZRAW); pg8::gemm_phase(F.lds, P, F.tid); } break;
        case G_MLA: { pg8::Prob<G_MLA> P; PROB_COMMON(P); P.A = (const char*)(ws + WS_ACAT); P.B = (const char*)(ws + WS_W_MLA) + (size_t)i * 1792 * 256 * 2; P.O = (bf16*)(ws + WS_QKVM); pg8::gemm_phase(F.lds, P, F.tid); } break;
        case G_GLU: { pg8::Prob<G_GLU> P; PROB_COMMON(P); P.A = (const char*)(ws + WS_GG); P.B = (const char*)(ws + WS_W_GLU) + (size_t)i * 512 * 512 * 2; pg8::gemm_phase(F.lds, P, F.tid); } break;
        case G_OUT: { pg8::Prob<G_OUT> P; PROB_COMMON(P); P.A = (const char*)(ws + WS_MIX); P.B = (const char*)(ws + (even ? WS_W_OUTE : WS_W_OUTO)) + (size_t)i * 1024 * 1024 * 2;
            P.xlat = (l == 0) ? KIN(0) : (const float*)(ws + WS_XRES); P.xctx = (l == 0) ? KIN(2) : (const float*)(ws + WS_XRES) + (size_t)LAT_ROWS * DM; pg8::gemm_phase(F.lds, P, F.tid); } break;
        case G_QKV: { pg8::Prob<G_QKV> P; PROB_COMMON(P); P.A = (const char*)(ws + WS_H); P.B = (const char*)(ws + WS_W_QKV) + (size_t)i * 2048 * 1024 * 2; P.O = (bf16*)(ws + WS_ZRAW); pg8::gemm_phase(F.lds, P, F.tid); } break;
        case G_MOE1: { pg8::Prob<G_MOE1> P; PROB_COMMON(P); P.A = (const char*)(ws + WS_H); P.B = (const char*)(ws + WS_W_GU) + (size_t)l * 32 * 1024 * 1024 * 2; pg8::gemm_phase(F.lds, P, F.tid); } break;
        default: { pg8::Prob<G_MOE2> P; PROB_COMMON(P); P.A = (const char*)(ws + WS_ACT); P.B = (const char*)(ws + WS_W_DN) + (size_t)l * 32 * 1024 * 512 * 2; pg8::gemm_phase(F.lds, P, F.tid); } break;
#else
        default: break;
#endif
        }
#undef PROB_COMMON
        return;
    }
    switch (kind) {
#ifndef T_NO_ROWS
    case K_NORM1: rows_norm1(F, l); break;
    case K_NORM2: rows_norm2_router(F, l); break;
#endif
    case K_MLA_PRE_S5A: {
        rows_mla_pre(F, i);
        s5::Params SP{KIN(10) + (size_t)i * 4096, KIN(11) + (size_t)i * 4096, KIN(12) + i * 64, KIN(13) + (size_t)i * 65536, KIN(14) + (size_t)i * 65536,
                      KIN(15) + (size_t)i * 65536, KIN(16) + (size_t)i * 65536, KIN(17) + i * 512};
#ifndef T_NO_S5
        for (int it = F.gw; it < s5::NITEMS; it += F.NGW) s5::pass_a_item(SP, (const bf16*)(F.ws + WS_ZRAW), (float*)(F.ws + WS_E), it, F.lane);
#endif
    } break;
    case K_MLA_POST: rows_mla_post(F, i); break;
    case K_S5B_ATT: {
        s5::Params SP{KIN(10) + (size_t)i * 4096, KIN(11) + (size_t)i * 4096, KIN(12) + i * 64, KIN(13) + (size_t)i * 65536, KIN(14) + (size_t)i * 65536,
                      KIN(15) + (size_t)i * 65536, KIN(16) + (size_t)i * 65536, KIN(17) + i * 512};
#ifndef T_NO_S5
        for (int it = F.gw; it < s5::NITEMS; it += F.NGW)
            s5::pass_b_item(SP, (const bf16*)(F.ws + WS_ZRAW), (const float*)(F.ws + WS_E), (bf16*)(F.ws + WS_GG), F.lds + F.wave * s5::HS_BYTES, it, F.lane);
#endif
        __syncthreads();
#ifndef T_NO_ATT
        attention_phase(F, l, true);
#endif
    } break;
    case K_GQA_POST: rows_gqa_post(F, i); break;
#ifndef T_NO_ATT
    case K_ATT_GQA: attention_phase(F, l, false); break;
#endif
    default: break;
    }
}

struct Args { const float* in[36]; float* out; unsigned char* ws; int ph_lo, ph_hi; };

__global__ void __launch_bounds__(512, 2) mega(Args args) {
    extern __shared__ __attribute__((aligned(16))) unsigned char lds_[];
    Ctx F;
    F.out = args.out; F.ws = args.ws;
    F.lds = (LAS unsigned char*)lds_;
    F.tid = threadIdx.x; F.lane = F.tid & 63; F.wave = __builtin_amdgcn_readfirstlane(F.tid >> 6);
    F.G = gridDim.x; F.bid = blockIdx.x; F.gw = blockIdx.x * 8 + F.wave; F.NGW = F.G * 8;
    volatile LAS unsigned* MISC = (volatile LAS unsigned*)(F.lds + MISC_OFF);
    for (int u = F.tid; u < (LDS_BYTES - RING_BYTES) / 4; u += 512) ((LAS unsigned*)(F.lds + RING_BYTES))[u] = 0u;
    __syncthreads();
    const int lo = args.ph_lo, hi = args.ph_hi;
    XcdBarrier bar; bar.bar = (unsigned*)(F.ws + WS_CTL) + CW_BAR; bar.x = 0; bar.st = nullptr;
    if (hi - lo > 1) bar = xcd_barrier_post((unsigned*)(F.ws + WS_CTL) + CW_BAR, MISC + 8);
    for (int ph = lo; ph < hi; ++ph) {
        run_phase(F, ph);
        if (ph + 1 < hi) { XcdBarrier b2 = bar; asm volatile("" : "+s"(b2.bar), "+s"(b2.x)); xcd_barrier(b2); }
    }
}

#ifndef MK_MULTI
#define MK_MULTI 1
#endif
extern "C" void kernel_launch(void* const* d_in, const int* in_sizes, int n_in, void* d_out, int out_size, void* d_ws, size_t ws_size, hipStream_t stream) {
    static int grid = 0;
    if (grid == 0) {
        if (n_in != 36 || in_sizes[0] != LAT_ROWS * DM || out_size != LAT_ROWS * DM || ws_size < WS_END) {
            fprintf(stderr, "kernel_launch: unexpected shapes: n_in %d in0 %d out %d ws %zu (need >= %zu)\n", n_in, n_in > 0 ? in_sizes[0] : -1, out_size, ws_size, (size_t)WS_END); grid = -1; return; }
        int dev = 0, cus = 0, per_cu = 0;
        if (hipGetDevice(&dev) != hipSuccess || hipDeviceGetAttribute(&cus, hipDeviceAttributeMultiprocessorCount, dev) != hipSuccess) { fprintf(stderr, "kernel_launch: device query failed\n"); grid = -1; return; }
        if (hipFuncSetAttribute((const void*)mega, hipFuncAttributeMaxDynamicSharedMemorySize, LDS_BYTES) != hipSuccess) { fprintf(stderr, "kernel_launch: hipFuncSetAttribute failed\n"); grid = -1; return; }
        if (hipOccupancyMaxActiveBlocksPerMultiprocessor(&per_cu, (const void*)mega, 512, LDS_BYTES) != hipSuccess || per_cu < 1) { fprintf(stderr, "kernel_launch: occupancy query says %d\n", per_cu); per_cu = 1; }
        (void)hipGetLastError();
        grid = cus;
    }
    if (grid < 0) return;
    (void)hipMemsetAsync((char*)d_ws + WS_CTL, 0, CTL_ZERO_BYTES, stream);
    Args a{};
    for (int i = 0; i < 36; ++i) a.in[i] = (const float*)d_in[i];
    a.out = (float*)d_out; a.ws = (unsigned char*)d_ws;
#if MK_MULTI
#ifndef DBG_STOP_PH
#define DBG_STOP_PH (NPH - 2)
#endif
    for (int p = 0; p < NPH; ++p) {
        if (p > DBG_STOP_PH && p != NPH - 1) continue;
#ifdef DBG_CHECKS
        if (p == NPH - 1) { a.ph_lo = 100 + DBG_CHECK_L; a.ph_hi = a.ph_lo + 1; hipLaunchKernelGGL(mega, dim3(grid), dim3(512), LDS_BYTES, stream, a); }
#endif
        a.ph_lo = p; a.ph_hi = p + 1;
        hipLaunchKernelGGL(mega, dim3(grid), dim3(512), LDS_BYTES, stream, a);
    }
#else
    a.ph_lo = 0; a.ph_hi = NPH;
    void* kargs[] = {&a};
    hipError_t e = hipLaunchCooperativeKernel((const void*)mega, dim3(grid), dim3(512), kargs, LDS_BYTES, stream);
    if (e != hipSuccess) fprintf(stderr, "kernel_launch: cooperative launch failed: %s (grid %d)\n", hipGetErrorString(e), grid);
#endif
    const hipError_t le = hipPeekAtLastError();
    if (le != hipSuccess) fprintf(stderr, "kernel_launch: launch failed: %s\n", hipGetErrorName(le));
}
```

```cpp
#include <hip/hip_runtime.h>
#include <cstdio>
#include <cstdint>
#ifndef MK_MULTI
#define MK_MULTI 0
#endif
#define GAS __attribute__((address_space(1)))
#define LAS __attribute__((address_space(3)))
typedef unsigned short bf16;
typedef short bf16x8 __attribute__((ext_vector_type(8)));
typedef short s16x4 __attribute__((ext_vector_type(4)));
typedef float f32x2 __attribute__((ext_vector_type(2)));
typedef float f32x4 __attribute__((ext_vector_type(4)));
typedef float f32x16 __attribute__((ext_vector_type(16)));
typedef unsigned u32x2 __attribute__((ext_vector_type(2)));
typedef unsigned u32x4 __attribute__((ext_vector_type(4)));

constexpr int DM = 1024, NBATCH = 4, SEQ = 4096, CTXL = 256, DEPTH = 4;
constexpr int LAT_ROWS = NBATCH * SEQ;
constexpr int CTX_ROWS = NBATCH * CTXL;
constexpr int TOK = LAT_ROWS + CTX_ROWS;
constexpr int SKV = CTXL + SEQ;
constexpr int NMOD = 6 * DM;
constexpr float RMS_EPS = 1e-6f;
constexpr int NEXP = 32, MOE_FF = 512;
constexpr int LIST_CAP = TOK;

__device__ __forceinline__ unsigned f2bf(float f) { unsigned u = __builtin_bit_cast(unsigned, f); return (u + 0x7fffu + ((u >> 16) & 1u)) >> 16; }
__device__ __forceinline__ unsigned pk2(float lo, float hi) { return f2bf(lo) | (f2bf(hi) << 16); }
__device__ __forceinline__ float bf2f(unsigned short b) { return __builtin_bit_cast(float, ((unsigned)b) << 16); }
__device__ __forceinline__ float bflo(unsigned w) { return __builtin_bit_cast(float, w << 16); }
__device__ __forceinline__ float bfhi(unsigned w) { return __builtin_bit_cast(float, w & 0xffff0000u); }
__device__ __forceinline__ unsigned cvtpk(float lo, float hi) { unsigned r; asm volatile("v_cvt_pk_bf16_f32 %0, %1, %2" : "=v"(r) : "v"(lo), "v"(hi)); return r; }
#define DPP_F(v, ctrl) __builtin_bit_cast(float, __builtin_amdgcn_update_dpp(0, __builtin_bit_cast(int, v), ctrl, 0xf, 0xf, true))
__device__ __forceinline__ float wave_sum(float v) {
    v += DPP_F(v, 0xB1);
    v += DPP_F(v, 0x4E);
    v += DPP_F(v, 0x141);
    v += DPP_F(v, 0x140);
    const int vi = __builtin_bit_cast(int, v);
    return (__builtin_bit_cast(float, __builtin_amdgcn_readlane(vi, 0)) + __builtin_bit_cast(float, __builtin_amdgcn_readlane(vi, 16)))
         + (__builtin_bit_cast(float, __builtin_amdgcn_readlane(vi, 32)) + __builtin_bit_cast(float, __builtin_amdgcn_readlane(vi, 48)));
}
__device__ __forceinline__ float wave_max(float v) {
    v = fmaxf(v, DPP_F(v, 0xB1)); v = fmaxf(v, DPP_F(v, 0x4E)); v = fmaxf(v, DPP_F(v, 0x141)); v = fmaxf(v, DPP_F(v, 0x140));
    const int vi = __builtin_bit_cast(int, v);
    return fmaxf(fmaxf(__builtin_bit_cast(float, __builtin_amdgcn_readlane(vi, 0)), __builtin_bit_cast(float, __builtin_amdgcn_readlane(vi, 16))),
                 fmaxf(__builtin_bit_cast(float, __builtin_amdgcn_readlane(vi, 32)), __builtin_bit_cast(float, __builtin_amdgcn_readlane(vi, 48))));
}
__device__ __forceinline__ float sigmoidf_(float x) { return 1.f / (1.f + __expf(-x)); }
__device__ __forceinline__ float siluf_(float x) { return x * sigmoidf_(x); }
__device__ __forceinline__ float gelu_tanh(float x) {
    const float u = 0.7978845608028654f * (x + 0.044715f * x * x * x);
    const float e = __expf(2.f * u);
    const float t = 1.f - 2.f / (e + 1.f);
    return 0.5f * x * (1.f + t);
}
__device__ __forceinline__ int modrow_of(int row) { return row < LAT_ROWS ? (row >> 12) : 4; }

constexpr size_t MiB = 1u << 20;
constexpr size_t WS_CTL = 0, CTL_ZERO_BYTES = 1 * MiB;
constexpr size_t WS_MOD = 1 * MiB, WS_ROPE = 2 * MiB, WS_GATEW = 3 * MiB, WS_RW = 4 * MiB, WS_RC = 5 * MiB, WS_LIST = 9 * MiB;
constexpr size_t WS_W_IN = 12 * MiB, WS_W_OUTE = 16 * MiB, WS_W_GLU = 20 * MiB, WS_W_MLA = 21 * MiB, WS_W_QKV = 23 * MiB, WS_W_OUTO = 31 * MiB;
constexpr size_t WS_W_GU = 35 * MiB, WS_W_DN = 291 * MiB;
constexpr size_t WS_XRES = 419 * MiB, WS_H = 487 * MiB, WS_MIX = 521 * MiB;
constexpr size_t WS_ZRAW = 555 * MiB, WS_ACAT = 623 * MiB, WS_QKVM = 640 * MiB, WS_QB = 700 * MiB, WS_KB = 734 * MiB, WS_VB = 768 * MiB, WS_GG = 785 * MiB;
constexpr size_t WS_ACT = 555 * MiB, WS_YDN = 589 * MiB;
constexpr size_t WS_E2 = 802 * MiB;
constexpr size_t WS_S5TAB = 812 * MiB;
constexpr size_t WS_END = 814 * MiB;
constexpr int CW_BAR = 4096, CW_CNT = 16384;
constexpr int CW_READY = 65536, READY_L = 32 * 68 * 16;
constexpr int ROPE32_OFF = 64 * 32 * 2;
constexpr size_t WS_RT = WS_ROPE + 128 * 1024;

constexpr int RING_BYTES = 131072, LDS_BYTES = 152576, MISC_OFF = LDS_BYTES - 3072;


namespace pg8 {
constexpr int BM = 256, BK = 64, HALF = 128, HTB = HALF * BK * 2, STAGE_BYTES = 8 * HTB, NXCD = 8, WGM = 8;
__host__ __device__ __forceinline__ int lds_byte(int r, int c) { const int st = (r >> 4) * 2 + (c >> 5), rr = r & 15, cc = c & 31, ob = rr * 64 + cc * 2; return st * 1024 + (ob ^ (((ob >> 9) & 1) << 5)); }
__host__ __device__ __forceinline__ void stage_rc(int b, int& R, int& C) { const int st = b / 1024, sb = b % 1024, swz = sb ^ (((sb >> 9) & 1) << 5); R = (st >> 1) * 16 + swz / 64; C = (st & 1) * 32 + (swz % 64) / 2; }
__host__ __device__ __forceinline__ int perm32(int rho) { const int n = rho >> 4, i = rho & 15; return 8 * (i >> 2) + 4 * n + (i & 3); }

struct Unit { int pm, pn, e, rows; };

enum { EPI_BF16 = 0, EPI_GLU = 1, EPI_RESID = 2, EPI_MOE1 = 3, EPI_MOE2 = 4 };
enum { G_INPROJ = 0, G_MLA = 1, G_GLU = 2, G_OUT = 3, G_QKV = 4, G_MOE1 = 5, G_MOE2 = 6 };

template <int GID> struct Cfg;
template <> struct Cfg<G_INPROJ> { static constexpr int lda = 1024, ldb = 1024, K = 1024, nN = 4, moe = 0, epi = EPI_BF16, ldo = 1024, acol_split = 1 << 30, acol_off = 0; };
template <> struct Cfg<G_MLA>    { static constexpr int lda = 512,  ldb = 256,  K = 256,  nN = 7, moe = 0, epi = EPI_BF16, ldo = 1792, acol_split = 3, acol_off = 256; };
template <> struct Cfg<G_GLU>    { static constexpr int lda = 512,  ldb = 512,  K = 512,  nN = 2, moe = 0, epi = EPI_GLU,  ldo = 1024, acol_split = 1 << 30, acol_off = 0; };
template <> struct Cfg<G_OUT>    { static constexpr int lda = 1024, ldb = 1024, K = 1024, nN = 4, moe = 0, epi = EPI_RESID, ldo = 1024, acol_split = 1 << 30, acol_off = 0; };
template <> struct Cfg<G_QKV>    { static constexpr int lda = 1024, ldb = 1024, K = 1024, nN = 8, moe = 0, epi = EPI_BF16, ldo = 2048, acol_split = 1 << 30, acol_off = 0; };
template <> struct Cfg<G_MOE1>   { static constexpr int lda = 1024, ldb = 1024, K = 1024, nN = 4, moe = 1, epi = EPI_MOE1, ldo = 512, acol_split = 1 << 30, acol_off = 0; };
template <> struct Cfg<G_MOE2>   { static constexpr int lda = 512,  ldb = 512,  K = 512,  nN = 4, moe = 2, epi = EPI_MOE2, ldo = 1024, acol_split = 1 << 30, acol_off = 0; };

template <int GID> struct Prob {
    static constexpr int lda = Cfg<GID>::lda, ldb = Cfg<GID>::ldb, K = Cfg<GID>::K, nN = Cfg<GID>::nN, moe = Cfg<GID>::moe, epi = Cfg<GID>::epi, ldo = Cfg<GID>::ldo;
    static constexpr int acol_split = Cfg<GID>::acol_split, acol_off = Cfg<GID>::acol_off, nM = TOK / 256;
    static constexpr size_t bstride = (size_t)1024 * K * 2;
    const char* A; const char* B;
    int G, c;
    const int* list; const unsigned* cnt; const LAS int* tp;
    int l; unsigned char* ws;
    bf16* O;
    unsigned* ready;
    const float* xlat; const float* xctx;

    __device__ __forceinline__ bool next(int i, Unit& u) const {
        const long L = (long)i * G + c;
        if constexpr (moe == 0) {
            const int nMe = (GID == G_INPROJ || GID == G_OUT || GID == G_QKV) ? LAT_ROWS / 256 : nM;
            const int nwg = nMe * nN; if (L >= nwg) return false;
            int wgid = (int)L; { const int q = nwg / NXCD, r = nwg % NXCD, xcd = wgid % NXCD, off = wgid / NXCD; wgid = (xcd < r ? xcd * (q + 1) : r * (q + 1) + (xcd - r) * q) + off; }
            const int nig = WGM * nN, gid = wgid / nig, fm = gid * WGM, gsz = (nMe - fm) < WGM ? (nMe - fm) : WGM;
            u.pm = fm + ((wgid % nig) % gsz); u.pn = (wgid % nig) / gsz; u.e = 0; u.rows = 256; return true;
        } else {
            const int x = c & 7, per = G >> 3, j = (moe == 2) ? per - 1 - (c >> 3) : (c >> 3);
            int uidx = i * per + j;
#pragma unroll
            for (int k = 0; k < NEXP / 8; ++k) { const int e = x + 8 * k; const int nt_e = tp[e + 1] - tp[e]; const int nu = nt_e * nN;
                if (uidx < nu) { u.e = e; u.pm = uidx / nN; u.pn = uidx % nN; const int left = (int)cnt[e] - 256 * u.pm; u.rows = left < 256 ? left : 256; return true; }
                uidx -= nu; }
            return false;
        }
    }
    __device__ __forceinline__ void done(const Unit& u, const int tid) const {
        if constexpr (moe == 1) { asm volatile("s_waitcnt vmcnt(0)" ::: "memory");
            if ((tid & 63) == 0) __hip_atomic_fetch_add(ready + (u.e * 68 + u.pm) * 16, 1u, __ATOMIC_RELAXED, __HIP_MEMORY_SCOPE_AGENT); }
    }
    __device__ __forceinline__ void a_ready(const Unit& u, const int tid) const {
        if constexpr (moe == 2) {
            if (tid < 64) {
                const unsigned* w = ready + (u.e * 68 + u.pm) * 16;
                for (unsigned n = 0; n < 2000000u; ++n) {
                    if ((unsigned)__builtin_amdgcn_readfirstlane(__hip_atomic_load(w, __ATOMIC_RELAXED, __HIP_MEMORY_SCOPE_AGENT)) >= 32u) break;
                    __builtin_amdgcn_s_sleep(2); }
            }
            asm volatile("" ::: "memory"); __builtin_amdgcn_s_barrier(); asm volatile("" ::: "memory");
        }
    }
    __device__ __forceinline__ const char* abase(const Unit& u) const {
        if constexpr (moe == 0) return A + ((size_t)u.pm * 256 * lda + (u.pn >= acol_split ? acol_off : 0)) * 2;
        else return A;
    }
    __device__ __forceinline__ unsigned aoff(const Unit& u, int R, int C) const {
        if constexpr (moe == 0) return (unsigned)((R * lda + C) * 2);
        else {
        const int rr = R < u.rows ? R : 0;
        const int ent = list[(size_t)u.e * LIST_CAP + u.pm * 256 + rr];
        const int arow = (moe == 1) ? (ent >> 1) : ent;
        return (unsigned)(((size_t)arow * lda + C) * 2u); }
    }
    __device__ __forceinline__ const char* bbase(const Unit& u) const { return B + (size_t)u.e * bstride + (size_t)u.pn * 256 * ldb * 2; }

    __device__ __forceinline__ void epilogue(const f32x4 (&acc)[2][2][4][2], const Unit& u, int wr, int wc, int fr, int fq) const {
        const int cw = wc * 32 + 8 * fq;
        if constexpr (epi == EPI_BF16) {
#pragma unroll
            for (int ai = 0; ai < 2; ++ai)
#pragma unroll
                for (int m = 0; m < 4; ++m) { const int row = u.pm * 256 + ai * 128 + wr * 64 + m * 16 + fr; bf16* rowp = O + (size_t)row * ldo + u.pn * 256 + cw;
#pragma unroll
                    for (int bj = 0; bj < 2; ++bj) { const f32x4 v0 = acc[ai][bj][m][0], v1 = acc[ai][bj][m][1];
                        u32x4 w; w.x = cvtpk(v0[0], v0[1]); w.y = cvtpk(v0[2], v0[3]); w.z = cvtpk(v1[0], v1[1]); w.w = cvtpk(v1[2], v1[3]);
                        *(u32x4*)(rowp + bj * 128) = w; } }
        } else if constexpr (epi == EPI_GLU) {
#pragma unroll
            for (int ai = 0; ai < 2; ++ai)
#pragma unroll
                for (int m = 0; m < 4; ++m) { const int row = u.pm * 256 + ai * 128 + wr * 64 + m * 16 + fr;
#pragma unroll
                    for (int bj = 0; bj < 2; ++bj) { const int col = u.pn * 256 + bj * 128 + cw;
                        const u32x4 gv = *(const u32x4*)((const bf16*)(ws + WS_GG) + (size_t)row * 512 + col);
                        const f32x4 v0 = acc[ai][bj][m][0], v1 = acc[ai][bj][m][1];
                        u32x4 w;
                        w.x = cvtpk(bflo(gv.x) * sigmoidf_(v0[0]), bfhi(gv.x) * sigmoidf_(v0[1]));
                        w.y = cvtpk(bflo(gv.y) * sigmoidf_(v0[2]), bfhi(gv.y) * sigmoidf_(v0[3]));
                        w.z = cvtpk(bflo(gv.z) * sigmoidf_(v1[0]), bfhi(gv.z) * sigmoidf_(v1[1]));
                        w.w = cvtpk(bflo(gv.w) * sigmoidf_(v1[2]), bfhi(gv.w) * sigmoidf_(v1[3]));
                        *(u32x4*)((bf16*)(ws + WS_MIX) + (size_t)row * 1024 + col) = w; } }
        } else if constexpr (epi == EPI_RESID) {
            const float* gate = (const float*)(ws + WS_MOD) + (size_t)l * 5 * NMOD + 2 * DM; bf16* xout = (bf16*)(ws + WS_XRES);
#pragma unroll
            for (int ai = 0; ai < 2; ++ai)
#pragma unroll
                for (int m = 0; m < 4; ++m) { const int row = u.pm * 256 + ai * 128 + wr * 64 + m * 16 + fr;
                    const float* gr = gate + (size_t)modrow_of(row) * NMOD;
#pragma unroll
                    for (int bj = 0; bj < 2; ++bj) { const int col = u.pn * 256 + bj * 128 + cw;
                        float xv[8];
                        if (l == 0) { const float* xs = row < LAT_ROWS ? xlat + (size_t)row * DM : xctx + (size_t)(row - LAT_ROWS) * DM;
                            const f32x4 a0 = *(const f32x4*)(xs + col), a1 = *(const f32x4*)(xs + col + 4);
                            xv[0] = a0[0]; xv[1] = a0[1]; xv[2] = a0[2]; xv[3] = a0[3]; xv[4] = a1[0]; xv[5] = a1[1]; xv[6] = a1[2]; xv[7] = a1[3]; }
                        else { const u32x4 w = *(const u32x4*)(xout + (size_t)row * DM + col);
                            xv[0] = bflo(w.x); xv[1] = bfhi(w.x); xv[2] = bflo(w.y); xv[3] = bfhi(w.y); xv[4] = bflo(w.z); xv[5] = bfhi(w.z); xv[6] = bflo(w.w); xv[7] = bfhi(w.w); }
                        const f32x4 g0 = *(const f32x4*)(gr + col), g1 = *(const f32x4*)(gr + col + 4);
                        const f32x4 c0 = acc[ai][bj][m][0], c1 = acc[ai][bj][m][1];
#ifdef DBG_NOMIX
                        u32x4 o; o.x = cvtpk(xv[0], xv[1]); o.y = cvtpk(xv[2], xv[3]); o.z = cvtpk(xv[4], xv[5]); o.w = cvtpk(xv[6], xv[7]);
#else
                        u32x4 o; o.x = cvtpk(xv[0] + g0[0] * c0[0], xv[1] + g0[1] * c0[1]); o.y = cvtpk(xv[2] + g0[2] * c0[2], xv[3] + g0[3] * c0[3]);
                        o.z = cvtpk(xv[4] + g1[0] * c1[0], xv[5] + g1[1] * c1[1]); o.w = cvtpk(xv[6] + g1[2] * c1[2], xv[7] + g1[3] * c1[3]);
#endif
                        *(u32x4*)(xout + (size_t)row * DM + col) = o; } }
        } else if constexpr (epi == EPI_MOE1) {
#pragma unroll
            for (int ai = 0; ai < 2; ++ai)
#pragma unroll
                for (int m = 0; m < 4; ++m) { const int rt = ai * 128 + wr * 64 + m * 16 + fr;
                    if (rt < u.rows) { const int ent = list[(size_t)u.e * LIST_CAP + u.pm * 256 + rt];
                        const f32x4 g0 = acc[ai][0][m][0], g1 = acc[ai][0][m][1], u0 = acc[ai][1][m][0], u1 = acc[ai][1][m][1];
                        u32x4 w;
                        w.x = cvtpk(siluf_(g0[0]) * u0[0], siluf_(g0[1]) * u0[1]); w.y = cvtpk(siluf_(g0[2]) * u0[2], siluf_(g0[3]) * u0[3]);
                        w.z = cvtpk(siluf_(g1[0]) * u1[0], siluf_(g1[1]) * u1[1]); w.w = cvtpk(siluf_(g1[2]) * u1[2], siluf_(g1[3]) * u1[3]);
                        asm volatile("global_store_dwordx4 %0, %1, off sc1" :: "v"((bf16*)(ws + WS_ACT) + (size_t)ent * MOE_FF + u.pn * 128 + cw), "v"(w) : "memory"); } }
        } else {
            const float* gatew = (const float*)(ws + WS_GATEW);
#pragma unroll
            for (int ai = 0; ai < 2; ++ai)
#pragma unroll
                for (int m = 0; m < 4; ++m) { const int rt = ai * 128 + wr * 64 + m * 16 + fr;
                    if (rt < u.rows) { const int ent = list[(size_t)u.e * LIST_CAP + u.pm * 256 + rt]; const float gw = gatew[ent];
#pragma unroll
                        for (int bj = 0; bj < 2; ++bj) { const f32x4 v0 = acc[ai][bj][m][0] * gw, v1 = acc[ai][bj][m][1] * gw;
                            u32x4 w; w.x = cvtpk(v0[0], v0[1]); w.y = cvtpk(v0[2], v0[3]); w.z = cvtpk(v1[0], v1[1]); w.w = cvtpk(v1[2], v1[3]);
                            *(u32x4*)((bf16*)(ws + WS_YDN) + (size_t)ent * DM + u.pn * 256 + bj * 128 + cw) = w; } } }
        }
    }
};

template <int GID>
__device__ __forceinline__ void gemm_phase(LAS unsigned char* lds, const Prob<GID>& P, const int tid) {
    const int  wid = __builtin_amdgcn_readfirstlane(tid >> 6), lane = tid & 63, wr = wid >> 2, wc = wid & 3, fr = lane & 15, fq = lane >> 4;
    constexpr int K = Prob<GID>::K, nt = K / BK;
    unsigned voffB[2];
#pragma unroll
    for (int i = 0; i < 2; ++i) { int R, C; stage_rc(tid * 16 + i * 8192, R, C); const int Rb = (R & ~31) + perm32(R & 31);
        voffB[i] = (unsigned)(Rb * P.ldb + C) * 2u; }
#define PG8_AOFFS(vo, unit) do { _Pragma("unroll") for (int _h = 0; _h < 2; ++_h) _Pragma("unroll") for (int _i = 0; _i < 2; ++_i) { int _R, _C; stage_rc(tid * 16 + _i * 8192, _R, _C); \
        (vo)[_h][_i] = P.aoff(unit, _R + 128 * _h, _C); } } while (0)
    const size_t kstep = (size_t)(BK * 2);
    const size_t hstepB = (size_t)HALF * P.ldb * 2;
    const unsigned ldsw = (unsigned)wid * 1024u;
    const int aoff = lds_byte(wr * 64 + fr, fq * 8), boff = lds_byte(wc * 32 + fr, fq * 8);
#define PG8_SA(b, h) (((b) * 2 + (h)) * HTB)
#define PG8_SB(b, h) ((4 + (b) * 2 + (h)) * HTB)
#define PG8_STAGEB(bufoff, gbase) do { _Pragma("unroll") for (int _i = 0; _i < 2; ++_i) \
        __builtin_amdgcn_global_load_lds((const unsigned*)((const char*)(gbase) + voffB[_i]), (LAS unsigned*)(lds + (bufoff) + ldsw + _i * 8192), 16, 0, 0); } while (0)
#define PG8_STAGEA(bufoff, gbase, h) do { _Pragma("unroll") for (int _i = 0; _i < 2; ++_i) \
        __builtin_amdgcn_global_load_lds((const unsigned*)((const char*)(gbase) + vA[h][_i]), (LAS unsigned*)(lds + (bufoff) + ldsw + _i * 8192), 16, 0, Prob<GID>::moe == 2 ? 16 : 0); } while (0)
#define PG8_LDA(dst, b, h) do { _Pragma("unroll") for (int m = 0; m < 4; ++m) _Pragma("unroll") for (int k = 0; k < 2; ++k) dst[m][k] = *(const LAS bf16x8*)(lds + PG8_SA(b, h) + aoff + m * 2048 + k * 1024); } while (0)
#define PG8_LDB(dst, b, h) do { _Pragma("unroll") for (int n = 0; n < 2; ++n) _Pragma("unroll") for (int k = 0; k < 2; ++k) dst[n][k] = *(const LAS bf16x8*)(lds + PG8_SB(b, h) + boff + n * 2048 + k * 1024); } while (0)
#define PG8_MMA(ai, bj, At, Bt) do { __builtin_amdgcn_s_setprio(1); _Pragma("unroll") for (int m = 0; m < 4; ++m) _Pragma("unroll") for (int n = 0; n < 2; ++n) _Pragma("unroll") for (int k = 0; k < 2; ++k) \
        acc[ai][bj][m][n] = __builtin_amdgcn_mfma_f32_16x16x32_bf16(Bt[n][k], At[m][k], acc[ai][bj][m][n], 0, 0, 0); __builtin_amdgcn_s_setprio(0); } while (0)
#define PG8_WAIT_V(n) asm volatile("s_waitcnt vmcnt(" #n ")" ::: "memory")
#define PG8_WAIT_L(n) asm volatile("s_waitcnt lgkmcnt(" #n ")" ::: "memory")
#define PG8_BAR __builtin_amdgcn_s_barrier()
#define PG8_SCHED __builtin_amdgcn_sched_barrier(0)
    Unit cur, nxt; int ui = 0;
    if (!P.next(0, cur)) return;
    f32x4 acc[2][2][4][2];
#pragma unroll
    for (int a = 0; a < 2; ++a)
#pragma unroll
        for (int b = 0; b < 2; ++b)
#pragma unroll
            for (int m = 0; m < 4; ++m)
#pragma unroll
                for (int n = 0; n < 2; ++n) acc[a][b][m][n] = (f32x4){0.f, 0.f, 0.f, 0.f};
    bf16x8 At[4][2], B0[2][2], B1[2][2];
    unsigned vA[2][2];
    PG8_AOFFS(vA, cur);
    const char* cA = P.abase(cur); const char* cB = P.bbase(cur);
    P.a_ready(cur, tid);
    PG8_STAGEB(PG8_SB(0, 0), cB); PG8_STAGEB(PG8_SB(0, 1), cB + hstepB); PG8_STAGEA(PG8_SA(0, 0), cA, 0); PG8_STAGEA(PG8_SA(0, 1), cA, 1);
    if (wr == 1) PG8_BAR;
    PG8_WAIT_V(2); PG8_BAR;
    PG8_STAGEB(PG8_SB(1, 0), cB + kstep); PG8_STAGEA(PG8_SA(1, 0), cA + kstep, 0); PG8_STAGEB(PG8_SB(1, 1), cB + hstepB + kstep);
    PG8_WAIT_V(6); PG8_BAR;
    for (;;) {
        const bool has_next = P.next(ui + 1, nxt);
        const char* nA = has_next ? P.abase(nxt) : cA; const char* nB = has_next ? P.bbase(nxt) : cB;
#pragma nounroll
        for (int t = 0; t < nt; t += 2) {
            const bool last = (t == nt - 2);
            const char* a1 = cA + (size_t)(t + 1) * kstep;
            const char* a2 = last ? nA : cA + (size_t)(t + 2) * kstep; const char* b2 = last ? nB : cB + (size_t)(t + 2) * kstep;
            const char* a3 = a2 + kstep; const char* b3 = b2 + kstep;
            if (Prob<GID>::moe == 2 && last && has_next) P.a_ready(nxt, tid);
            PG8_LDB(B0, 0, 0); PG8_LDB(B1, 0, 1); PG8_SCHED; PG8_LDA(At, 0, 0); PG8_STAGEA(PG8_SA(1, 1), a1, 1);
            if (Prob<GID>::moe != 0 && last && has_next) { PG8_AOFFS(vA, nxt); }
            PG8_WAIT_V(8); PG8_WAIT_L(0); PG8_BAR; PG8_MMA(0, 0, At, B0); PG8_MMA(0, 1, At, B1); PG8_BAR; PG8_SCHED;
            PG8_LDA(At, 0, 1); PG8_STAGEB(PG8_SB(0, 0), b2); PG8_STAGEB(PG8_SB(0, 1), b2 + hstepB); PG8_STAGEA(PG8_SA(0, 0), a2, 0);
            PG8_WAIT_V(8); PG8_WAIT_L(0); PG8_BAR; PG8_MMA(1, 0, At, B0); PG8_MMA(1, 1, At, B1); PG8_BAR; PG8_SCHED;
            PG8_LDB(B0, 1, 0); PG8_LDB(B1, 1, 1); PG8_SCHED; PG8_LDA(At, 1, 0); PG8_STAGEA(PG8_SA(0, 1), a2, 1);
            PG8_WAIT_V(8); PG8_WAIT_L(0); PG8_BAR; PG8_MMA(0, 0, At, B0); PG8_MMA(0, 1, At, B1); PG8_BAR; PG8_SCHED;
            PG8_LDA(At, 1, 1); PG8_STAGEB(PG8_SB(1, 0), b3); PG8_STAGEB(PG8_SB(1, 1), b3 + hstepB); PG8_STAGEA(PG8_SA(1, 0), a3, 0);
            PG8_WAIT_V(8); PG8_WAIT_L(0); PG8_BAR; PG8_MMA(1, 0, At, B0); PG8_MMA(1, 1, At, B1); PG8_BAR; PG8_SCHED;
        }
        if (wr == 0) PG8_BAR;
        P.epilogue(acc, cur, wr, wc, fr, fq);
        P.done(cur, tid);
        if (!has_next) break;
#pragma unroll
        for (int a = 0; a < 2; ++a)
#pragma unroll
            for (int b = 0; b < 2; ++b)
#pragma unroll
                for (int m = 0; m < 4; ++m)
#pragma unroll
                    for (int n = 0; n < 2; ++n) acc[a][b][m][n] = (f32x4){0.f, 0.f, 0.f, 0.f};
        cur = nxt; cA = nA; cB = nB; ++ui;
        if (wr == 1) PG8_BAR;
    }
    PG8_WAIT_V(0);
    PG8_BAR;
#undef PG8_SA
#undef PG8_SB
#undef PG8_STAGEA
#undef PG8_AOFFS
#undef PG8_STAGEB
#undef PG8_LDA
#undef PG8_LDB
#undef PG8_MMA
#undef PG8_WAIT_V
#undef PG8_WAIT_L
#undef PG8_BAR
#undef PG8_SCHED
}

template <int GID>
__device__ __forceinline__ void ctx_gemm(LAS unsigned char* lds, const Prob<GID>& P, const int tid) {
    static_assert(Prob<GID>::K == 1024 && Prob<GID>::lda == 1024 && Prob<GID>::ldb == 1024 && Prob<GID>::moe == 0, "ctx_gemm: K = 1024 dense only");
    constexpr int NPASS = Prob<GID>::nN / 4, PSTR = 272, PW = 64 * PSTR, epi = Prob<GID>::epi, ldo = Prob<GID>::ldo;
    const int wid = __builtin_amdgcn_readfirstlane(tid >> 6), lane = tid & 63, fr = lane & 15, fq = lane >> 4;
    const int mt = P.c >> 4;
    const char* Ap = P.A + ((size_t)(LAT_ROWS + mt * 64 + fr) * 1024 + wid * 128 + fq * 8) * 2;
#pragma nounroll
#ifdef DBG_CTX2
    for (int pass_ = 0; pass_ < 2 * NPASS; ++pass_) { const int pass = pass_ % NPASS;
#else
    for (int pass = 0; pass < NPASS; ++pass) {
#endif
        const int ntile = (P.c & 15) + 16 * pass;
        const char* Bp = P.B + ((size_t)(ntile * 64 + fr) * 1024 + wid * 128 + fq * 8) * 2;
        f32x4 acc[4][4];
#pragma unroll
        for (int mi = 0; mi < 4; ++mi)
#pragma unroll
            for (int ni = 0; ni < 4; ++ni) acc[mi][ni] = (f32x4){0.f, 0.f, 0.f, 0.f};
        bf16x8 af[4][4], bf[4][4];
#pragma unroll
        for (int ks = 0; ks < 4; ++ks)
#pragma unroll
            for (int mi = 0; mi < 4; ++mi) { af[ks][mi] = *(const bf16x8*)(Ap + mi * 16 * 2048 + ks * 64); bf[ks][mi] = *(const bf16x8*)(Bp + mi * 16 * 2048 + ks * 64); }
        __builtin_amdgcn_sched_barrier(0);
#pragma unroll
        for (int ks = 0; ks < 4; ++ks)
#pragma unroll
            for (int mi = 0; mi < 4; ++mi)
#pragma unroll
                for (int ni = 0; ni < 4; ++ni) acc[mi][ni] = __builtin_amdgcn_mfma_f32_16x16x32_bf16(bf[ks][ni], af[ks][mi], acc[mi][ni], 0, 0, 0);
        __syncthreads();
#pragma unroll
        for (int mi = 0; mi < 4; ++mi)
#pragma unroll
            for (int ni = 0; ni < 4; ++ni) *(LAS f32x4*)(lds + wid * PW + (mi * 16 + fr) * PSTR + (ni * 16 + 4 * fq) * 4) = acc[mi][ni];
        __syncthreads();
        const int m = tid >> 3, c8 = (tid & 7) * 8;
        f32x4 s0 = (f32x4){0.f, 0.f, 0.f, 0.f}, s1 = s0;
#pragma unroll
        for (int w = 0; w < 8; ++w) { s0 += *(const LAS f32x4*)(lds + w * PW + m * PSTR + c8 * 4); s1 += *(const LAS f32x4*)(lds + w * PW + m * PSTR + c8 * 4 + 16); }
        const int row = LAT_ROWS + mt * 64 + m, col = ntile * 64 + c8;
        if constexpr (epi == EPI_BF16) {
            u32x4 w; w.x = cvtpk(s0[0], s0[1]); w.y = cvtpk(s0[2], s0[3]); w.z = cvtpk(s1[0], s1[1]); w.w = cvtpk(s1[2], s1[3]);
            *(u32x4*)(P.O + (size_t)row * ldo + col) = w;
        } else {
            static_assert(epi == EPI_RESID, "ctx_gemm: epilogue");
            const float* gr = (const float*)(P.ws + WS_MOD) + (size_t)P.l * 5 * NMOD + 2 * DM + (size_t)modrow_of(row) * NMOD; bf16* xout = (bf16*)(P.ws + WS_XRES);
            float xv[8];
            if (P.l == 0) { const float* xs = P.xctx + (size_t)(row - LAT_ROWS) * DM;
                const f32x4 a0 = *(const f32x4*)(xs + col), a1 = *(const f32x4*)(xs + col + 4);
                xv[0] = a0[0]; xv[1] = a0[1]; xv[2] = a0[2]; xv[3] = a0[3]; xv[4] = a1[0]; xv[5] = a1[1]; xv[6] = a1[2]; xv[7] = a1[3]; }
            else { const u32x4 w = *(const u32x4*)(xout + (size_t)row * DM + col);
                xv[0] = bflo(w.x); xv[1] = bfhi(w.x); xv[2] = bflo(w.y); xv[3] = bfhi(w.y); xv[4] = bflo(w.z); xv[5] = bfhi(w.z); xv[6] = bflo(w.w); xv[7] = bfhi(w.w); }
            const f32x4 g0 = *(const f32x4*)(gr + col), g1 = *(const f32x4*)(gr + col + 4);
            u32x4 o; o.x = cvtpk(xv[0] + g0[0] * s0[0], xv[1] + g0[1] * s0[1]); o.y = cvtpk(xv[2] + g0[2] * s0[2], xv[3] + g0[3] * s0[3]);
            o.z = cvtpk(xv[4] + g1[0] * s1[0], xv[5] + g1[1] * s1[1]); o.w = cvtpk(xv[6] + g1[2] * s1[2], xv[7] + g1[3] * s1[3]);
            *(u32x4*)(xout + (size_t)row * DM + col) = o;
        }
    }
}
}
namespace att {
constexpr int D = 128, NW = 8, QBLK = 32, KVBLK = 64;
constexpr float THR = 8.f;
constexpr int SHM_V = KVBLK * 128 * 2, SHM_K = KVBLK * D * 2, SHM_ATTN = 2 * SHM_V + 2 * SHM_K + NW * 64 * 4;
#define KSWZ(row, colB) ((row) * 256 + ((colB) ^ (((row) & 7) << 4)))
#define SBAR() __builtin_amdgcn_sched_barrier(0)
__device__ __forceinline__ int crow(int r, int hi) { return (r & 3) + 8 * (r >> 2) + 4 * hi; }

template <int SC> struct ScaleOf { static constexpr float v = SC == 0 ? 0.088388347648318440f   : 0.102062072615965750f  ; };

template <int SC>
__device__ __forceinline__ void partialSM(f32x16& p0, f32x16& p1, float& m_reg, float& mn, float& alpha) {
  constexpr float SCALE = ScaleOf<SC>::v;
  constexpr float C = SCALE * 1.4426950408889634f;
  float pmax = p0[0];
#pragma unroll
  for (int r = 1; r < 16; ++r) pmax = fmaxf(pmax, p0[r]);
#pragma unroll
  for (int r = 0; r < 16; ++r) pmax = fmaxf(pmax, p1[r]);
  { auto rr = __builtin_amdgcn_permlane32_swap(__float_as_uint(pmax), __float_as_uint(pmax), false, false);
    pmax = fmaxf(__uint_as_float(rr[0]), __uint_as_float(rr[1])); }
  if (__builtin_expect(__all(pmax - m_reg <= THR / SCALE), 1)) { mn = m_reg; alpha = 1.f; }
  else { mn = fmaxf(m_reg, pmax); alpha = __builtin_amdgcn_exp2f((m_reg - mn) * C); m_reg = mn; }
  float mnC = -mn * C;
#pragma unroll
  for (int r = 0; r < 16; ++r) p0[r] = fmaf(p0[r], C, mnC);
#pragma unroll
  for (int r = 0; r < 16; ++r) p1[r] = fmaf(p1[r], C, mnC);
#pragma unroll
  for (int r = 0; r < 16; ++r) p0[r] = __builtin_amdgcn_exp2f(p0[r]);
}
__device__ __forceinline__ void finishSM(f32x16& p0, f32x16& p1, float alpha, float& l_reg, bf16x8& pa0, bf16x8& pa1, bf16x8& pa2, bf16x8& pa3) {
#pragma unroll
  for (int r = 0; r < 16; ++r) p1[r] = __builtin_amdgcn_exp2f(p1[r]);
  float ps = 0;
#pragma unroll
  for (int r = 0; r < 16; ++r) ps += p0[r];
#pragma unroll
  for (int r = 0; r < 16; ++r) ps += p1[r];
  { auto rr = __builtin_amdgcn_permlane32_swap(__float_as_uint(ps), __float_as_uint(ps), false, false);
    ps = __uint_as_float(rr[0]) + __uint_as_float(rr[1]); }
  l_reg = l_reg * alpha + ps;
#define PK4(P, BASE, OUT) do { unsigned a0 = cvtpk(P[BASE + 0], P[BASE + 1]), a1 = cvtpk(P[BASE + 2], P[BASE + 3]);   \
    unsigned b0 = cvtpk(P[BASE + 4], P[BASE + 5]), b1 = cvtpk(P[BASE + 6], P[BASE + 7]);                              \
    auto r0 = __builtin_amdgcn_permlane32_swap(a0, b0, false, false); auto r1 = __builtin_amdgcn_permlane32_swap(a1, b1, false, false); \
    u32x4 w = {r0[0], r1[0], r0[1], r1[1]}; OUT = *reinterpret_cast<bf16x8*>(&w); } while (0)
  PK4(p0, 0, pa0); PK4(p0, 8, pa1); PK4(p1, 0, pa2); PK4(p1, 8, pa3);
#undef PK4
}
template <int NKS>
__device__ __forceinline__ void qkt(f32x16& p0, f32x16& p1, const bf16* Ks, const bf16x8* qr, int r32, int hi) {
  p0 = f32x16{}; p1 = f32x16{};
#pragma unroll
  for (int d0 = 0; d0 < NKS; ++d0) { int cb = (d0 * 16 + hi * 8) * 2;
    bf16x8 b0 = *reinterpret_cast<const bf16x8*>((const char*)Ks + KSWZ(r32, cb));
    bf16x8 b1 = *reinterpret_cast<const bf16x8*>((const char*)Ks + KSWZ(32 + r32, cb));
    p0 = __builtin_amdgcn_mfma_f32_32x32x16_bf16(b0, qr[d0], p0, 0, 0, 0);
    p1 = __builtin_amdgcn_mfma_f32_32x32x16_bf16(b1, qr[d0], p1, 0, 0, 0); }
}
__device__ __forceinline__ int v_st(int k, int c) { const int kk = (k & ~0xC) | ((k & 4) << 1) | ((k & 8) >> 1); return ((kk >> 3) * 4 + (c >> 5)) * 512 + ((kk & 7) * 32 + (c & 31)) * 2; }
__device__ __forceinline__ int v_rd_base(int lane) { return ((lane & 3) << 3) | (((lane >> 2) & 3) << 6) | (((lane >> 4) & 1) << 5) | (((lane >> 5) & 1) << 8); }
constexpr int v_rd_off(int d0, int ks, int half) { return d0 * 512 + ks * 4096 + half * 2048; }
template <int OFF> __device__ __forceinline__ s16x4 tr_read(int vb) {
  s16x4 r; asm volatile("ds_read_b64_tr_b16 %0, %1 offset:%2" : "=&v"(r) : "v"(vb), "i"(OFF) : "memory"); return r;
}
template <int D0> __device__ __forceinline__ void pv_one(f32x16& od, int vb, bf16x8 pa0, bf16x8 pa1, bf16x8 pa2, bf16x8 pa3) {
  const s16x4 l0 = tr_read<v_rd_off(D0, 0, 0)>(vb), h0 = tr_read<v_rd_off(D0, 0, 1)>(vb), l1 = tr_read<v_rd_off(D0, 1, 0)>(vb), h1 = tr_read<v_rd_off(D0, 1, 1)>(vb);
  const s16x4 l2 = tr_read<v_rd_off(D0, 2, 0)>(vb), h2 = tr_read<v_rd_off(D0, 2, 1)>(vb), l3 = tr_read<v_rd_off(D0, 3, 0)>(vb), h3 = tr_read<v_rd_off(D0, 3, 1)>(vb);
  asm volatile("s_waitcnt lgkmcnt(0)" ::: "memory"); SBAR();
#define PK(L, H) (bf16x8){L[0], L[1], L[2], L[3], H[0], H[1], H[2], H[3]}
  od = __builtin_amdgcn_mfma_f32_32x32x16_bf16(pa0, PK(l0, h0), od, 0, 0, 0);
  od = __builtin_amdgcn_mfma_f32_32x32x16_bf16(pa1, PK(l1, h1), od, 0, 0, 0);
  od = __builtin_amdgcn_mfma_f32_32x32x16_bf16(pa2, PK(l2, h2), od, 0, 0, 0);
  od = __builtin_amdgcn_mfma_f32_32x32x16_bf16(pa3, PK(l3, h3), od, 0, 0, 0);
#undef PK
}
template <int DV> __device__ __forceinline__ void pv_d0(f32x16* o, int vb, bf16x8 pa0, bf16x8 pa1, bf16x8 pa2, bf16x8 pa3) {
  pv_one<0>(o[0], vb, pa0, pa1, pa2, pa3); pv_one<1>(o[1], vb, pa0, pa1, pa2, pa3);
  if constexpr (DV == 128) { pv_one<2>(o[2], vb, pa0, pa1, pa2, pa3); pv_one<3>(o[3], vb, pa0, pa1, pa2, pa3); }
}

template <int DV, int SC, int LDO, int DQK>
__device__ __forceinline__ void attn_dense_body(const bf16* __restrict__ Qb, const bf16* __restrict__ Kh, const bf16* __restrict__ Vh,
                                                bf16* __restrict__ Ob, int seq, char* lds, const int tid) {
  constexpr int ND = DV / 32, NKS = DQK / 16;
  const int wid = tid >> 6, lane = tid & 63, r32 = lane & 31, hi = lane >> 5;
  bf16* V_lds = (bf16*)lds; bf16* K_lds = (bf16*)(lds + 2 * SHM_V);
  float* ws = (float*)(lds + 2 * SHM_V + 2 * SHM_K) + wid * 64; float* li_l = ws; float* al_l = ws + 32;
  float m_reg = -1e30f, l_reg = 0; f32x16 o[ND] = {}; bf16x8 qr[NKS];
  const bf16* Qw = Qb + (long)(wid * QBLK + r32) * 128 + hi * 8;
#pragma unroll
  for (int d0 = 0; d0 < NKS; ++d0) qr[d0] = *reinterpret_cast<const bf16x8*>(Qw + d0 * 16);
  const int sr = tid >> 4, sc = (tid & 15) * 8;
  const int vr = (DV == 128) ? sr : (tid >> 3), vc = (DV == 128) ? sc : (tid & 7) * 8;
  const int vst0 = v_st(vr, vc), vst1 = v_st(32 + vr, vc);
  const int vb0 = (int)(uintptr_t)V_lds + v_rd_base(lane);
  constexpr int SDEPTH = 1;
  struct { bf16x8 vs0, vs1, ks0, ks1; } sr_[SDEPTH];
#define SLOAD(i, k0) do { sr_[i].vs0 = *reinterpret_cast<const bf16x8*>(&Vh[(long)((k0) + vr) * DV + vc]); \
    if constexpr (DV == 128) sr_[i].vs1 = *reinterpret_cast<const bf16x8*>(&Vh[(long)((k0) + 32 + vr) * DV + vc]); \
    sr_[i].ks0 = *reinterpret_cast<const bf16x8*>(&Kh[(long)((k0) + sr) * 128 + sc]); sr_[i].ks1 = *reinterpret_cast<const bf16x8*>(&Kh[(long)((k0) + 32 + sr) * 128 + sc]); } while (0)
#define SWRITE(b, i) do { *(bf16x8*)((char*)V_lds + (b) * SHM_V + vst0) = sr_[i].vs0;          \
    if constexpr (DV == 128) *(bf16x8*)((char*)V_lds + (b) * SHM_V + vst1) = sr_[i].vs1; int kc = sc * 2;               \
    *(bf16x8*)((char*)K_lds + (b) * SHM_K + KSWZ(sr, kc)) = sr_[i].ks0;                       \
    *(bf16x8*)((char*)K_lds + (b) * SHM_K + KSWZ(32 + sr, kc)) = sr_[i].ks1; } while (0)
#define SWAIT() do { if constexpr (SDEPTH == 1) asm volatile("s_waitcnt vmcnt(0)" ::: "memory"); else if constexpr (DV == 128) asm volatile("s_waitcnt vmcnt(4)" ::: "memory"); else asm volatile("s_waitcnt vmcnt(3)" ::: "memory"); } while (0)
#define RESC(a) do { if (__any((a) < 1.f)) { if (hi == 0) al_l[r32] = (a); asm volatile("s_waitcnt lgkmcnt(0)" ::: "memory"); \
    _Pragma("unroll") for (int d = 0; d < ND; ++d) _Pragma("unroll") for (int r = 0; r < 16; ++r) o[d][r] *= al_l[crow(r, hi)]; } } while (0)
  f32x16 pA0, pA1, pB0, pB1; float mnA, mnB, alA, alB; bf16x8 pa0, pa1, pa2, pa3; const int NT = seq / KVBLK;
  constexpr int SE = 0, SO = SDEPTH - 1;
  SLOAD(SE, 0); asm volatile("s_waitcnt vmcnt(0)" ::: "memory"); SWRITE(0, SE); __syncthreads();
  qkt<NKS>(pA0, pA1, K_lds, qr, r32, hi); partialSM<SC>(pA0, pA1, m_reg, mnA, alA);
  SLOAD(SO, KVBLK); if constexpr (SDEPTH == 2) { if (2 < NT) SLOAD(SE, 2 * KVBLK); }
  SWAIT(); SWRITE(1, SO); __syncthreads();
  for (int j = 1; j + 1 < NT; j += 2) {
    SBAR(); qkt<NKS>(pB0, pB1, (bf16*)((char*)K_lds + SHM_K), qr, r32, hi);
    finishSM(pA0, pA1, alA, l_reg, pa0, pa1, pa2, pa3); SBAR();
    SLOAD(SO, (j + SDEPTH) * KVBLK); SBAR();
    pv_d0<DV>(o, vb0, pa0, pa1, pa2, pa3); partialSM<SC>(pB0, pB1, m_reg, mnB, alB);
    __syncthreads(); SWAIT(); SWRITE(0, SE);
    RESC(alB); __syncthreads();
    SBAR(); qkt<NKS>(pA0, pA1, K_lds, qr, r32, hi);
    finishSM(pB0, pB1, alB, l_reg, pa0, pa1, pa2, pa3); SBAR();
    if (SDEPTH == 1 || j + 3 < NT) SLOAD(SE, (j + 1 + SDEPTH) * KVBLK); SBAR();
    pv_d0<DV>(o, vb0 + (int)SHM_V, pa0, pa1, pa2, pa3); partialSM<SC>(pA0, pA1, m_reg, mnA, alA);
    __syncthreads(); SWAIT(); SWRITE(1, SO);
    RESC(alA); __syncthreads();
  }
  SBAR(); qkt<NKS>(pB0, pB1, (bf16*)((char*)K_lds + SHM_K), qr, r32, hi);
  finishSM(pA0, pA1, alA, l_reg, pa0, pa1, pa2, pa3); SBAR();
  pv_d0<DV>(o, vb0, pa0, pa1, pa2, pa3); partialSM<SC>(pB0, pB1, m_reg, mnB, alB);
  __syncthreads(); RESC(alB);
  finishSM(pB0, pB1, alB, l_reg, pa0, pa1, pa2, pa3); SBAR();
  pv_d0<DV>(o, vb0 + (int)SHM_V, pa0, pa1, pa2, pa3);
  if (hi == 0) li_l[r32] = l_reg; asm volatile("s_waitcnt lgkmcnt(0)" ::: "memory");
  float rli[16];
#pragma unroll
  for (int r = 0; r < 16; ++r) rli[r] = __builtin_amdgcn_rcpf(li_l[crow(r, hi)]);
  bf16* Ow = Ob + (long)(wid * QBLK) * LDO;
#pragma unroll
  for (int r = 0; r < 16; ++r) { int orow = crow(r, hi);
#pragma unroll
    for (int d0 = 0; d0 < ND; ++d0) Ow[(long)orow * LDO + d0 * 32 + r32] = (bf16)f2bf(o[d0][r] * rli[r]); }
  __syncthreads();
#undef SLOAD
#undef SWRITE
#undef SWAIT
#undef RESC
}
#undef KSWZ
#undef SBAR
}
namespace s5 {
constexpr int CH = 4, BT = 16 * CH;
constexpr int NCB = CTXL / BT;
constexpr int NBLK = SKV / BT;
constexpr int NSQ = 6;
static_assert((1 << NSQ) == BT, "squarings");
constexpr int HS_STRIDE = 272;
constexpr int HS_BYTES = 32 * HS_STRIDE;
constexpr int NITEMS = 32 * 2 * NBLK;

struct Params { const float *a_re, *a_im, *log_dt, *b_re, *b_im, *c_re, *c_im, *dskip; };

__device__ __forceinline__ int rowof(int b, int blk, int j) { return blk < NCB ? LAT_ROWS + b * 256 + blk * BT + j : b * 4096 + (blk - NCB) * BT + j; }

struct DirConst {
    float abr[2], abi[2];
    bf16x8 Bfr[2], Bfi[2];
};
__device__ __forceinline__ void load_dir(const Params& P, int dd, int g, int nl, int hi, DirConst& dc) {
    const float dt = __expf(P.log_dt[dd * 32 + g]);
#pragma unroll
    for (int nh = 0; nh < 2; ++nh) {
        const int n = nl + 32 * nh; const int ix = (dd * 32 + g) * 64 + n;
        const float are = P.a_re[ix], aim = P.a_im[ix];
        const float mag = __expf(dt * are), th = dt * aim;
        float rev = th * 0.15915494309189535f; rev -= floorf(rev);
        const float sn = __builtin_amdgcn_sinf(rev), cs = __builtin_amdgcn_cosf(rev);
        const float abr = mag * cs, abi = mag * sn;
        const float den = are * are + aim * aim, nr = abr - 1.f;
        const float zr = (nr * are + abi * aim) / den, zi = (abi * are - nr * aim) / den;
        dc.abr[nh] = abr; dc.abi[nh] = abi;
        const float* br = P.b_re + (size_t)ix * 16 + 8 * hi; const float* bi = P.b_im + (size_t)ix * 16 + 8 * hi;
        u32x4 wr_, wi_;
        float r8[8], i8[8];
#pragma unroll
        for (int j = 0; j < 8; ++j) { const float bre = br[j], bim = bi[j]; r8[j] = zr * bre - zi * bim; i8[j] = zr * bim + zi * bre; }
        wr_.x = pk2(r8[0], r8[1]); wr_.y = pk2(r8[2], r8[3]); wr_.z = pk2(r8[4], r8[5]); wr_.w = pk2(r8[6], r8[7]);
        wi_.x = pk2(i8[0], i8[1]); wi_.y = pk2(i8[2], i8[3]); wi_.z = pk2(i8[4], i8[5]); wi_.w = pk2(i8[6], i8[7]);
        dc.Bfr[nh] = __builtin_bit_cast(bf16x8, wr_); dc.Bfi[nh] = __builtin_bit_cast(bf16x8, wi_);
    }
}
__device__ __forceinline__ void load_cmat(const Params& P, int dd, int g, int lane, bf16x8 (&Cf)[4]) {
    const int p = lane & 15, kq = lane >> 4;
    const float* cre = P.c_re + ((size_t)(dd * 32 + g) * 16 + p) * 64; const float* cim = P.c_im + ((size_t)(dd * 32 + g) * 16 + p) * 64;
#pragma unroll
    for (int ks = 0; ks < 4; ++ks) {
        float v[8];
#pragma unroll
        for (int j = 0; j < 8; ++j) { const int k = 32 * ks + 8 * kq + j; const int n = (k >> 2) + 32 * ((k >> 1) & 1); v[j] = (k & 1) ? -cim[n] : cre[n]; }
        u32x4 w; w.x = pk2(v[0], v[1]); w.y = pk2(v[2], v[3]); w.z = pk2(v[4], v[5]); w.w = pk2(v[6], v[7]);
        Cf[ks] = __builtin_bit_cast(bf16x8, w);
    }
}
constexpr int TAB_BYTES = 9 * 64 * 16;
__device__ __forceinline__ void build_tab(const Params& P, int dd, int g, int lane, u32x4* dst) {
    DirConst dc; load_dir(P, dd, g, lane & 31, lane >> 5, dc);
    bf16x8 Cf[4]; load_cmat(P, dd, g, lane, Cf);
    ((f32x4*)dst)[lane] = (f32x4){dc.abr[0], dc.abr[1], dc.abi[0], dc.abi[1]};
    dst[1 * 64 + lane] = __builtin_bit_cast(u32x4, dc.Bfr[0]); dst[2 * 64 + lane] = __builtin_bit_cast(u32x4, dc.Bfr[1]);
    dst[3 * 64 + lane] = __builtin_bit_cast(u32x4, dc.Bfi[0]); dst[4 * 64 + lane] = __builtin_bit_cast(u32x4, dc.Bfi[1]);
#pragma unroll
    for (int k = 0; k < 4; ++k) dst[(5 + k) * 64 + lane] = __builtin_bit_cast(u32x4, Cf[k]);
}
__device__ __forceinline__ void load_tab(const u32x4* tab, int dd, int g, int lane, DirConst& dc, bf16x8 (&Cf)[4]) {
    const u32x4* t = tab + (size_t)(dd * 32 + g) * (TAB_BYTES / 16);
    u32x4 w[9];
#pragma unroll
    for (int k = 1; k < 9; ++k) w[k] = t[k * 64 + lane];
    const f32x4 a0 = ((const f32x4*)t)[lane];
    dc.abr[0] = a0[0]; dc.abr[1] = a0[1]; dc.abi[0] = a0[2]; dc.abi[1] = a0[3];
    dc.Bfr[0] = __builtin_bit_cast(bf16x8, w[1]); dc.Bfr[1] = __builtin_bit_cast(bf16x8, w[2]); dc.Bfi[0] = __builtin_bit_cast(bf16x8, w[3]); dc.Bfi[1] = __builtin_bit_cast(bf16x8, w[4]);
#pragma unroll
    for (int k = 0; k < 4; ++k) Cf[k] = __builtin_bit_cast(bf16x8, w[5 + k]);
}
__device__ __forceinline__ bf16x8 load_af(const bf16* zraw, int g, int bp, int blk, int c, int lane) {
    const int rho = lane & 31, kh = lane >> 5;
    const int beta = (rho >> 2) & 1, tau = (rho & 3) + 4 * (rho >> 3);
    const int row = rowof(2 * bp + beta, blk, 16 * c + tau);
    return *reinterpret_cast<const bf16x8*>(zraw + (size_t)row * 1024 + g * 16 + 8 * kh);
}
template <bool REV>
__device__ __forceinline__ void chunk_scan(const bf16x8 af, const DirConst& dc,
                                           float (&hr)[2], float (&hi_)[2], f32x16 (&accR)[2], f32x16 (&accI)[2]) {
#pragma unroll
    for (int nh = 0; nh < 2; ++nh) {
        accR[nh] = __builtin_amdgcn_mfma_f32_32x32x16_bf16(af, dc.Bfr[nh], f32x16{}, 0, 0, 0);
        accI[nh] = __builtin_amdgcn_mfma_f32_32x32x16_bf16(af, dc.Bfi[nh], f32x16{}, 0, 0, 0);
    }
#pragma unroll
    for (int qq = 0; qq < 16; ++qq) {
        const int q = REV ? 15 - qq : qq;
#pragma unroll
        for (int nh = 0; nh < 2; ++nh) {
            const float nr_ = dc.abr[nh] * hr[nh] - dc.abi[nh] * hi_[nh] + accR[nh][q];
            const float ni_ = dc.abr[nh] * hi_[nh] + dc.abi[nh] * hr[nh] + accI[nh][q];
            hr[nh] = nr_; hi_[nh] = ni_; accR[nh][q] = nr_; accI[nh][q] = ni_;
        }
    }
}

__device__ __forceinline__ void pass_a_item(const Params& P, const u32x4* tab, const bf16* zraw, float* E, int item, int lane) {
    const int g = item & 31, rest = item >> 5, blk = rest % NBLK, bp = rest / NBLK;
    const int nl = lane & 31, hi = lane >> 5;
    f32x16 accR[2], accI[2];
#pragma unroll
    for (int dd = 0; dd < 2; ++dd) {
        DirConst dc; bf16x8 Cfu[4]; load_tab(tab, dd, g, lane, dc, Cfu);
#ifdef DBG_TABA
        { DirConst d2; load_dir(P, dd, g, nl, hi, d2);
          if (DBG_TABA == 1) dc = d2;
          if (DBG_TABA == 2) { dc.abr[0] = d2.abr[0]; dc.abr[1] = d2.abr[1]; dc.abi[0] = d2.abi[0]; dc.abi[1] = d2.abi[1]; }
          if (DBG_TABA == 3) { dc.Bfr[0] = d2.Bfr[0]; dc.Bfr[1] = d2.Bfr[1]; dc.Bfi[0] = d2.Bfi[0]; dc.Bfi[1] = d2.Bfi[1]; } }
#endif
        float hr[2] = {0.f, 0.f}, hi_[2] = {0.f, 0.f};
        bf16x8 af = load_af(zraw, g, bp, blk, dd == 0 ? 0 : CH - 1, lane);
        for (int cc = 0; cc < CH; ++cc) {
            const int cn = cc < CH - 1 ? cc + 1 : cc;
            const bf16x8 afn = load_af(zraw, g, bp, blk, dd == 0 ? cn : CH - 1 - cn, lane);
            if (dd == 0) chunk_scan<false>(af, dc, hr, hi_, accR, accI);
            else chunk_scan<true>(af, dc, hr, hi_, accR, accI);
            af = afn;
        }
        const int b = 2 * bp + hi;
        float* e = E + ((((size_t)(dd * 32 + g) * 4 + b) * NBLK + blk) * 64) * 2;
#pragma unroll
        for (int nh = 0; nh < 2; ++nh) { *(f32x2*)(e + (nl + 32 * nh) * 2) = (f32x2){hr[nh], hi_[nh]}; }
    }
}

__device__ __forceinline__ void readout(LAS unsigned char* hs, int lane, const bf16x8 (&Cf)[4], const f32x16 (&accR)[2], const f32x16 (&accI)[2], f32x4 (&y)[2]) {
    const int nl = lane & 31, hi = lane >> 5;
#pragma unroll
    for (int q = 0; q < 16; ++q) {
        u32x2 w; w.x = pk2(accR[0][q], accI[0][q]); w.y = pk2(accR[1][q], accI[1][q]);
        *(LAS u32x2*)(hs + (hi * 16 + q) * HS_STRIDE + nl * 8) = w;
    }
    asm volatile("s_waitcnt lgkmcnt(0)" ::: "memory");
    const int tk = lane & 15, kq = lane >> 4;
#pragma unroll
    for (int beta = 0; beta < 2; ++beta) {
#pragma unroll
        for (int ks = 0; ks < 4; ++ks) {
            const bf16x8 hb = *(const LAS bf16x8*)(hs + (beta * 16 + tk) * HS_STRIDE + (32 * ks + 8 * kq) * 2);
            y[beta] = __builtin_amdgcn_mfma_f32_16x16x32_bf16(Cf[ks], hb, y[beta], 0, 0, 0);
        }
    }
    asm volatile("s_waitcnt lgkmcnt(0)" ::: "memory");
}

__device__ __forceinline__ void prefix_wave(const Params& P, float* E, int seq, int lane) {
    const int dd = seq >> 7, g = (seq >> 2) & 31, n = lane;
    const int ix = (dd * 32 + g) * 64 + n;
    const float dt = __expf(P.log_dt[dd * 32 + g]);
    const float are = P.a_re[ix], aim = P.a_im[ix];
    const float mag = __expf(dt * are), th = dt * aim;
    float rev = th * 0.15915494309189535f; rev -= floorf(rev);
    float ar = mag * __builtin_amdgcn_cosf(rev), ai = mag * __builtin_amdgcn_sinf(rev);
#pragma unroll
    for (int s = 0; s < NSQ; ++s) { const float t = ar * ar - ai * ai; ai = 2.f * ar * ai; ar = t; }
    float* e = E + ((size_t)seq * NBLK * 64 + n) * 2;
    float hr = 0.f, hi = 0.f;
    constexpr int BATCH = 17; static_assert(NBLK % BATCH == 0, "batching");
    for (int c0 = 0; c0 < NBLK; c0 += BATCH) {
        f32x2 ev[BATCH];
#pragma unroll
        for (int u = 0; u < BATCH; ++u) { const int ci = c0 + u; const int blk = dd == 0 ? ci : (ci < NCB ? NCB - 1 - ci : NBLK + NCB - 1 - ci); ev[u] = *(const f32x2*)(e + (size_t)blk * 128); }
        asm volatile("" ::: "memory");
#pragma unroll
        for (int u = 0; u < BATCH; ++u) { const int ci = c0 + u; const int blk = dd == 0 ? ci : (ci < NCB ? NCB - 1 - ci : NBLK + NCB - 1 - ci);
            *(f32x2*)(e + (size_t)blk * 128) = (f32x2){hr, hi};
            const float nr_ = ar * hr - ai * hi + ev[u].x, ni_ = ar * hi + ai * hr + ev[u].y; hr = nr_; hi = ni_; }
    }
}

__device__ __forceinline__ void pass_b_item(const Params& P, const u32x4* tab, const bf16* zraw, const float* E, bf16* gg, LAS unsigned char* hs, int item, int lane) {
    const int g = item & 31, rest = item >> 5, blk = rest % NBLK, bp = rest / NBLK;
    const int nl = lane & 31, hi = lane >> 5;
    const int b = 2 * bp + hi;
    f32x16 accR[2], accI[2];
    f32x4 yf[CH][2];
    {
        DirConst dc; bf16x8 Cf[4]; load_tab(tab, 0, g, lane, dc, Cf);
#ifdef DBG_TABCMP
        { DirConst d2; load_dir(P, 0, g, nl, hi, d2); bf16x8 C2[4]; load_cmat(P, 0, g, lane, C2); bool bad = false;
          for (int q = 0; q < 2; ++q) { if (d2.abr[q] != dc.abr[q] || d2.abi[q] != dc.abi[q]) bad = true; for (int j = 0; j < 8; ++j) if (d2.Bfr[q][j] != dc.Bfr[q][j] || d2.Bfi[q][j] != dc.Bfi[q][j]) bad = true; }
          bool badc = false; for (int q = 0; q < 4; ++q) for (int j = 0; j < 8; ++j) if (C2[q][j] != Cf[q][j]) badc = true;
          if (DBG_TABCMP == 1 && bad) dc.abr[0] = __builtin_nanf(""); if (DBG_TABCMP == 2 && badc) dc.abr[0] = __builtin_nanf("");
          if (DBG_TABCMP == 3) { dc = d2; for (int q = 0; q < 4; ++q) Cf[q] = C2[q]; } }
#endif
        float hr[2], hi_[2];
        { const float* e = E + (((((size_t)(0 * 32 + g) * 4 + b) * NBLK + blk) * 64) * 2);
#pragma unroll
          for (int nh = 0; nh < 2; ++nh) { const f32x2 hv = *(const f32x2*)(e + (nl + 32 * nh) * 2); hr[nh] = hv.x; hi_[nh] = hv.y; } }
        bf16x8 af = load_af(zraw, g, bp, blk, 0, lane);
#pragma unroll
        for (int c = 0; c < CH; ++c) {
            const bf16x8 afn = load_af(zraw, g, bp, blk, c < CH - 1 ? c + 1 : c, lane);
            chunk_scan<false>(af, dc, hr, hi_, accR, accI); af = afn;
            yf[c][0] = (f32x4){0.f, 0.f, 0.f, 0.f}; yf[c][1] = (f32x4){0.f, 0.f, 0.f, 0.f};
            readout(hs, lane, Cf, accR, accI, yf[c]);
        }
    }
    {
        DirConst dc; bf16x8 Cf[4]; load_tab(tab, 1, g, lane, dc, Cf);
        float hr[2], hi_[2];
        { const float* e = E + (((((size_t)(1 * 32 + g) * 4 + b) * NBLK + blk) * 64) * 2);
#pragma unroll
          for (int nh = 0; nh < 2; ++nh) { const f32x2 hv = *(const f32x2*)(e + (nl + 32 * nh) * 2); hr[nh] = hv.x; hi_[nh] = hv.y; } }
        const int tk = lane & 15, kq = lane >> 4;
        const f32x4 dv = *(const f32x4*)(P.dskip + g * 16 + 4 * kq);
        bf16x8 af = load_af(zraw, g, bp, blk, CH - 1, lane);
#pragma unroll
        for (int cc = 0; cc < CH; ++cc) {
            const int c = CH - 1 - cc;
            const bf16x8 afn = load_af(zraw, g, bp, blk, c > 0 ? c - 1 : c, lane);
            u32x2 uwv[2];
#pragma unroll
            for (int beta = 0; beta < 2; ++beta) uwv[beta] = *(const u32x2*)(zraw + (size_t)rowof(2 * bp + beta, blk, 16 * c + tk) * 1024 + g * 16 + 4 * kq);
            chunk_scan<true>(af, dc, hr, hi_, accR, accI); af = afn;
            readout(hs, lane, Cf, accR, accI, yf[c]);
#pragma unroll
            for (int beta = 0; beta < 2; ++beta) {
                const int row = rowof(2 * bp + beta, blk, 16 * c + tk);
                const u32x2 uw = uwv[beta];
                const f32x4 yv = yf[c][beta];
                const float v0 = yv[0] + dv[0] * bflo(uw.x), v1 = yv[1] + dv[1] * bfhi(uw.x), v2 = yv[2] + dv[2] * bflo(uw.y), v3 = yv[3] + dv[3] * bfhi(uw.y);
                u32x2 ow; ow.x = pk2(gelu_tanh(v0), gelu_tanh(v1)); ow.y = pk2(gelu_tanh(v2), gelu_tanh(v3));
                *(u32x2*)(gg + (size_t)row * 512 + g * 16 + 4 * kq) = ow;
            }
        }
    }
}
}
typedef const float* __attribute__((address_space(4))) const* KargPtrTable;
#define KIN(k) (((KargPtrTable)__builtin_amdgcn_kernarg_segment_ptr())[k])
struct Ctx {
    float* out; unsigned char* ws;
    LAS unsigned char* lds;
    int tid, lane, wave, G, gw, NGW, bid, dry;
};

__device__ __forceinline__ void tr_item(const float* src, int sld, int c0, int k0, int srcK, bf16* dst, int dld, int n0, bool zero, LAS float* scr, int lane) {
    const int c = lane & 7;
    if (zero || k0 >= srcK) {
#pragma unroll
        for (int j = 0; j < 4; ++j) { const int n = (lane >> 3) + 8 * j; unsigned z0 = 0u; asm volatile("" : "+v"(z0));
            *(u32x4*)(dst + (size_t)(n0 + n) * dld + k0 + 8 * c) = (u32x4){z0, z0, z0, z0}; }
        return;
    }
    { const int kk = lane >> 3, nc = lane & 7;
      f32x4 v[8];
#pragma unroll
      for (int i = 0; i < 8; ++i) v[i] = *(const f32x4*)(src + (size_t)(k0 + 8 * i + kk) * sld + c0 + 4 * nc);
#pragma unroll
      for (int i = 0; i < 8; ++i) { LAS float* d = scr + (8 * i + kk) * 33 + 4 * nc; d[0] = v[i][0]; d[1] = v[i][1]; d[2] = v[i][2]; d[3] = v[i][3]; } }
    asm volatile("s_waitcnt lgkmcnt(0)" ::: "memory");
#pragma unroll
    for (int j = 0; j < 4; ++j) { const int n = (lane >> 3) + 8 * j; const LAS float* s = scr + (8 * c) * 33 + n;
        u32x4 o; o.x = cvtpk(s[0 * 33], s[1 * 33]); o.y = cvtpk(s[2 * 33], s[3 * 33]); o.z = cvtpk(s[4 * 33], s[5 * 33]); o.w = cvtpk(s[6 * 33], s[7 * 33]);
        *(u32x4*)(dst + (size_t)(n0 + n) * dld + k0 + 8 * c) = o; }
    asm volatile("s_waitcnt lgkmcnt(0)" ::: "memory");
}

#ifndef DEF_NQ
#define DEF_NQ 4
#endif
constexpr int DEF_ITEMS = 128 * (512 + 256), DEF_P0 = 0, DEF_L = 32 * (512 + 256), DEF_S5Q = 12 - DEF_NQ;
static_assert(DEF_ITEMS == 48 * 2048 && DEF_L == 12 * 2048 && DEF_NQ >= 0 && DEF_NQ <= 12, "deferred conversion schedule");
__device__ __forceinline__ void moe_item(const Ctx& F, int q, LAS float* scr) {
    constexpr int PER_LE = 512 + 256;
    const int le = q / PER_LE; int r = q % PER_LE;
    if (r < 512) { const int nb = r >> 4, kb = r & 15;
        const int n0 = nb * 32, pn = n0 >> 8, w = n0 & 255;
        const float* src = (w < 128 ? KIN(33) : KIN(34)) + (size_t)le * 1024 * 512;
        tr_item(src, 512, pn * 128 + (w & 127), kb * 64, 1024, (bf16*)(F.ws + WS_W_GU) + (size_t)le * 1024 * 1024, 1024, n0, false, scr, F.lane);
    } else { r -= 512; const int nb = r >> 3, kb = r & 7;
        tr_item(KIN(35) + (size_t)le * 512 * 1024, 1024, nb * 32, kb * 64, 512, (bf16*)(F.ws + WS_W_DN) + (size_t)le * 1024 * 512, 512, nb * 32, false, scr, F.lane); }
}
__device__ __forceinline__ void p0_weights(const Ctx& F) {
    LAS float* scr = (LAS float*)(F.lds + F.wave * 16384);
    constexpr int PER_I = 512 + 512 + 128 + 96 + 128 + 1024 + 512;
    constexpr int DENSE = 2 * PER_I, PER_LE = 512 + 256, TOTAL = DENSE + DEF_P0;
    for (int it = F.gw; it < TOTAL; it += F.NGW) {
        if (it < DENSE) {
            const int i = it / PER_I; int r = it % PER_I;
            if (r < 512) { const int nb = r >> 4, kb = r & 15;
                tr_item(KIN(8) + (size_t)i * 1024 * 928, 928, nb * 32, kb * 64, 1024, (bf16*)(F.ws + WS_W_IN) + (size_t)i * 1024 * 1024, 1024, nb * 32, nb >= 29, scr, F.lane); continue; } r -= 512;
            if (r < 512) { const int nb = r >> 4, kb = r & 15;
                tr_item(KIN(9) + (size_t)i * 1024 * 1024, 1024, nb * 32, kb * 64, 1024, (bf16*)(F.ws + WS_W_OUTE) + (size_t)i * 1024 * 1024, 1024, nb * 32, false, scr, F.lane); continue; } r -= 512;
            if (r < 128) { const int nb = r >> 3, kb = r & 7;
                tr_item(KIN(18) + (size_t)i * 512 * 512, 512, nb * 32, kb * 64, 512, (bf16*)(F.ws + WS_W_GLU) + (size_t)i * 512 * 512, 512, nb * 32, false, scr, F.lane); continue; } r -= 128;
            if (r < 96) { const int nb = r >> 2, kb = r & 3;
                tr_item(KIN(20) + (size_t)i * 256 * 768, 768, nb * 32, kb * 64, 256, (bf16*)(F.ws + WS_W_MLA) + (size_t)i * 1792 * 256, 256, nb * 32, false, scr, F.lane); continue; } r -= 96;
            if (r < 128) { const int nb = r >> 2, kb = r & 3;
                tr_item(KIN(22) + (size_t)i * 128 * 1024, 1024, nb * 32, kb * 64, 128, (bf16*)(F.ws + WS_W_MLA) + (size_t)i * 1792 * 256, 256, 768 + nb * 32, false, scr, F.lane); continue; } r -= 128;
            if (r < 1024) { const int nb = r >> 4, kb = r & 15;
                tr_item(KIN(25) + (size_t)i * 1024 * 2048, 2048, nb * 32, kb * 64, 1024, (bf16*)(F.ws + WS_W_QKV) + (size_t)i * 2048 * 1024, 1024, nb * 32, false, scr, F.lane); continue; } r -= 1024;
            { const int nb = r >> 4, kb = r & 15;
                tr_item(KIN(26) + (size_t)i * 1024 * 1024, 1024, nb * 32, kb * 64, 1024, (bf16*)(F.ws + WS_W_OUTO) + (size_t)i * 1024 * 1024, 1024, nb * 32, false, scr, F.lane); }
        } else {
            moe_item(F, it - DENSE, scr);
        }
    }
}
__device__ __forceinline__ void defer_convert(const Ctx& F, int first, int quota, LAS float* scr) {
    for (int k = 0; k < quota; ++k) moe_item(F, first + k * F.NGW + F.gw, scr);
}
__device__ __forceinline__ void p0_ada(const Ctx& F) {
    LAS float* sc = (LAS float*)(F.lds);
    LAS float* red = (LAS float*)(F.lds + 32768);
    for (int i = F.tid; i < 5 * 1024; i += 512) { const int r = i >> 10, k = i & 1023; const float v = r < 4 ? KIN(1)[r * 1024 + k] : KIN(3)[k]; sc[i] = siluf_(v); }
    __syncthreads();
    const int id = F.bid, l = id / 48, col0 = (id % 48) * 128;
    float a[5][2];
#pragma unroll
    for (int r = 0; r < 5; ++r) { a[r][0] = 0.f; a[r][1] = 0.f; }
    const float* wp = KIN(4) + ((size_t)l * 1024 + F.wave * 128) * NMOD + col0 + 2 * F.lane;
#pragma unroll 8
    for (int k = 0; k < 128; ++k) { const f32x2 w2 = *(const f32x2*)(wp + (size_t)k * NMOD);
#pragma unroll
        for (int r = 0; r < 5; ++r) { const float s = sc[r * 1024 + F.wave * 128 + k]; a[r][0] += s * w2.x; a[r][1] += s * w2.y; } }
#pragma unroll
    for (int r = 0; r < 5; ++r) { red[(F.wave * 5 + r) * 128 + 2 * F.lane] = a[r][0]; red[(F.wave * 5 + r) * 128 + 2 * F.lane + 1] = a[r][1]; }
    __syncthreads();
    for (int i = F.tid; i < 5 * 128; i += 512) { const int r = i >> 7, cc = i & 127; float s = KIN(5)[l * NMOD + col0 + cc];
#pragma unroll
        for (int w = 0; w < 8; ++w) s += red[(w * 5 + r) * 128 + cc];
        ((float*)(F.ws + WS_MOD))[((size_t)l * 5 + r) * NMOD + col0 + cc] = s; }
    __syncthreads();
}
__device__ __forceinline__ void p0_rope(const Ctx& F) {
    float* t = (float*)(F.ws + WS_ROPE);
    for (int i = F.tid; i < 64 * 32; i += 512) { const int p = i >> 5, f = i & 31; const float inv = __builtin_amdgcn_exp2f(-(float)f * (13.287712379549449f / 32.f));
        float rev = (float)p * inv * 0.15915494309189535f; rev -= floorf(rev);
        t[2 * i] = __builtin_amdgcn_cosf(rev); t[2 * i + 1] = __builtin_amdgcn_sinf(rev); }
    for (int i = F.tid; i < 64 * 8; i += 512) { const int p = i >> 3, f = i & 7; const float inv = __builtin_amdgcn_exp2f(-(float)f * (13.287712379549449f / 8.f));
        float rev = (float)p * inv * 0.15915494309189535f; rev -= floorf(rev);
        t[ROPE32_OFF + 2 * i] = __builtin_amdgcn_cosf(rev); t[ROPE32_OFF + 2 * i + 1] = __builtin_amdgcn_sinf(rev); }
}

__device__ __forceinline__ void p0_router_t(const Ctx& F) {
    float* rt = (float*)(F.ws + WS_RT);
    for (int i = F.tid; i < DEPTH * 36 * 1024; i += 512) { const int k = i & 1023, j = (i >> 10) % 36, l = i / (36 * 1024);
        rt[i] = j < 4 ? KIN(29)[((size_t)l * 1024 + k) * 4 + j] : KIN(31)[((size_t)l * 1024 + k) * 32 + (j - 4)]; }
}
__device__ __forceinline__ void unpack8(const u32x4 w, float (&x)[8]) { x[0] = bflo(w.x); x[1] = bfhi(w.x); x[2] = bflo(w.y); x[3] = bfhi(w.y); x[4] = bflo(w.z); x[5] = bfhi(w.z); x[6] = bflo(w.w); x[7] = bfhi(w.w); }
__device__ __forceinline__ u32x4 pack8(const float (&x)[8]) { u32x4 w; w.x = pk2(x[0], x[1]); w.y = pk2(x[2], x[3]); w.z = pk2(x[4], x[5]); w.w = pk2(x[6], x[7]); return w; }
__device__ __forceinline__ float sumsq8(const float (&x)[8]) { return ((x[0] * x[0] + x[1] * x[1]) + (x[2] * x[2] + x[3] * x[3])) + ((x[4] * x[4] + x[5] * x[5]) + (x[6] * x[6] + x[7] * x[7])); }
__device__ __forceinline__ float group8_sum(float v) { v += DPP_F(v, 0xB1); v += DPP_F(v, 0x4E); v += DPP_F(v, 0x141); return v; }
__device__ __forceinline__ float group16_sum(float v) { v += DPP_F(v, 0xB1); v += DPP_F(v, 0x4E); v += DPP_F(v, 0x141); v += DPP_F(v, 0x140); return v; }
__device__ __forceinline__ void norm_rope8(const float (&x1)[8], const float (&x2)[8], float rinv, const float (&w1)[8], const float (&w2)[8], const float* csn, bool rot, u32x4& o1, u32x4& o2) {
    float a[8], b2[8];
    if (rot) {
        const f32x4 c0 = *(const f32x4*)(csn), c1 = *(const f32x4*)(csn + 4), c2 = *(const f32x4*)(csn + 8), c3 = *(const f32x4*)(csn + 12);
        const float cs[8] = {c0[0], c0[2], c1[0], c1[2], c2[0], c2[2], c3[0], c3[2]}, sn[8] = {c0[1], c0[3], c1[1], c1[3], c2[1], c2[3], c3[1], c3[3]};
#pragma unroll
        for (int j = 0; j < 8; ++j) { const float y1 = x1[j] * rinv * w1[j], y2 = x2[j] * rinv * w2[j]; a[j] = y1 * cs[j] - y2 * sn[j]; b2[j] = y2 * cs[j] + y1 * sn[j]; }
    } else {
#pragma unroll
        for (int j = 0; j < 8; ++j) { a[j] = x1[j] * rinv * w1[j]; b2[j] = x2[j] * rinv * w2[j]; }
    }
    o1 = pack8(a); o2 = pack8(b2);
}
struct RowV { float v[2][8]; };
__device__ __forceinline__ void ld_row_f32(const float* p, int lane, RowV& r) {
#pragma unroll
    for (int j = 0; j < 2; ++j) { const f32x4 a = *(const f32x4*)(p + 8 * lane + 512 * j), b = *(const f32x4*)(p + 8 * lane + 512 * j + 4);
        r.v[j][0] = a[0]; r.v[j][1] = a[1]; r.v[j][2] = a[2]; r.v[j][3] = a[3]; r.v[j][4] = b[0]; r.v[j][5] = b[1]; r.v[j][6] = b[2]; r.v[j][7] = b[3]; }
}
__device__ __forceinline__ void ld_row_bf16(const bf16* p, int lane, RowV& r) {
#pragma unroll
    for (int j = 0; j < 2; ++j) { const u32x4 w = *(const u32x4*)(p + 8 * lane + 512 * j); unpack8(w, r.v[j]); }
}
__device__ __forceinline__ float row_sumsq(const RowV& r) { return wave_sum(sumsq8(r.v[0]) + sumsq8(r.v[1])); }
__device__ __forceinline__ void ld8f(const float* p, float (&o)[8]) { const f32x4 a = *(const f32x4*)p, b = *(const f32x4*)(p + 4); o[0] = a[0]; o[1] = a[1]; o[2] = a[2]; o[3] = a[3]; o[4] = b[0]; o[5] = b[1]; o[6] = b[2]; o[7] = b[3]; }
__device__ __forceinline__ void ld_xrow(const Ctx& F, int l, int row, RowV& x) {
    if (l == 0) ld_row_f32(row < LAT_ROWS ? KIN(0) + (size_t)row * DM : KIN(2) + (size_t)(row - LAT_ROWS) * DM, F.lane, x);
    else ld_row_bf16((const bf16*)(F.ws + WS_XRES) + (size_t)row * DM, F.lane, x);
}
__device__ __forceinline__ void rows_norm1(const Ctx& F, int l) {
    const float* mod = (const float*)(F.ws + WS_MOD);
    const bf16* ydn = (const bf16*)(F.ws + WS_YDN);
    bf16* xres = (bf16*)(F.ws + WS_XRES);
    bf16* h = (bf16*)(F.ws + WS_H);
    const float* g1 = KIN(6) + l * DM;
    constexpr int RR = 2;
    for (int row0 = F.gw; row0 < TOK; row0 += RR * F.NGW) {
        RowV x[RR]; u32x4 y0[RR][2], y1[RR][2];
#pragma unroll
        for (int rr = 0; rr < RR; ++rr) { int row = row0 + rr * F.NGW; row = row < TOK ? row : TOK - 1;
            ld_xrow(F, l, row, x[rr]);
            if (l > 0) {
#pragma unroll
                for (int j = 0; j < 2; ++j) { const int col = 8 * F.lane + 512 * j;
                    y0[rr][j] = *(const u32x4*)(ydn + (size_t)(2 * row) * DM + col); y1[rr][j] = *(const u32x4*)(ydn + (size_t)(2 * row + 1) * DM + col); } } }
#pragma unroll
        for (int rr = 0; rr < RR; ++rr) { const int row = row0 + rr * F.NGW; if (row >= TOK) break;
            const int mr = modrow_of(row);
            if (l > 0) {
                const float* g2 = mod + ((size_t)(l - 1) * 5 + mr) * NMOD + 5 * DM;
#pragma unroll
                for (int j = 0; j < 2; ++j) { const int col = 8 * F.lane + 512 * j;
                    float gv[8], a[8], b2[8]; ld8f(g2 + col, gv); unpack8(y0[rr][j], a); unpack8(y1[rr][j], b2);
#pragma unroll
                    for (int i = 0; i < 8; ++i) x[rr].v[j][i] += gv[i] * (a[i] + b2[i]);
                    if (!F.dry) *(u32x4*)(xres + (size_t)row * DM + col) = pack8(x[rr].v[j]);
                    unpack8(pack8(x[rr].v[j]), x[rr].v[j]); }
            }
            const float rinv = rsqrtf(row_sumsq(x[rr]) * (1.f / DM) + RMS_EPS);
            const float* mrow = mod + ((size_t)l * 5 + mr) * NMOD;
#pragma unroll
            for (int j = 0; j < 2; ++j) { const int col = 8 * F.lane + 512 * j;
                float gv[8], sh[8], scl[8], o[8]; ld8f(g1 + col, gv); ld8f(mrow + col, sh); ld8f(mrow + DM + col, scl);
#pragma unroll
                for (int i = 0; i < 8; ++i) o[i] = x[rr].v[j][i] * rinv * gv[i] * (1.f + scl[i]) + sh[i];
                *(u32x4*)(h + (size_t)row * DM + col) = pack8(o); }
        }
    }
}
__device__ __forceinline__ void build_router_tab(const Ctx& F, int l) {
    const float* mod = (const float*)(F.ws + WS_MOD) + (size_t)l * 5 * NMOD;
    const float* rt = (const float*)(F.ws + WS_RT) + (size_t)l * 36 * 1024;
    const float* g2w = KIN(7) + l * DM;
    bf16* tab = (bf16*)(F.ws + WS_RW);
    for (int i = F.bid * 512 + F.tid; i < 5 * 48 * 1024; i += F.G * 512) { const int c = i & 1023, n = (i >> 10) % 48, mr = i / (48 * 1024);
        float w = 0.f; if (n < 4) w = rt[n * 1024 + c]; else if (n >= 16) w = rt[(n - 12) * 1024 + c];
        const float v = g2w[c] * (1.f + mod[(size_t)mr * NMOD + 4 * DM + c]) * w;
        const unsigned hi = f2bf(v); const float lo = v - __builtin_bit_cast(float, hi << 16);
        tab[((size_t)mr * 2 + 0) * 48 * 1024 + n * 1024 + c] = (bf16)hi; tab[((size_t)mr * 2 + 1) * 48 * 1024 + n * 1024 + c] = (bf16)f2bf(lo); }
    float* rc = (float*)(F.ws + WS_RC);
    for (int d = F.gw; d < 5 * 36; d += F.NGW) { const int mr = d / 36, j = d % 36; float s = 0.f;
        for (int c = F.lane; c < 1024; c += 64) s += mod[(size_t)mr * NMOD + 3 * DM + c] * rt[j * 1024 + c];
        s = wave_sum(s); if (F.lane == 0) rc[d] = s + (j < 4 ? KIN(30)[l * 4 + j] : KIN(32)[l * 32 + j - 4]); }
}
template <int NT>
__device__ __forceinline__ void router_pass(const Ctx& F, const bf16* xres, int rowbase, int mr, LAS unsigned* lcnt, float* gatew,
                                            int& ea, int& eb, unsigned& ra, unsigned& rb, int& myrow) {
    const int r = F.lane & 15, fq = F.lane >> 4, k0 = F.wave * 128 + 8 * fq;
    const bf16* ap = xres + (size_t)(rowbase + r) * DM + k0;
    const bf16* bh = (const bf16*)(F.ws + WS_RW) + (size_t)mr * 2 * 48 * 1024 + (size_t)r * 1024 + k0; const bf16* bl = bh + 48 * 1024;
    f32x4 acc[NT][3]; float ssq[NT];
#pragma unroll
    for (int t = 0; t < NT; ++t) { ssq[t] = 0.f;
#pragma unroll
        for (int nt = 0; nt < 3; ++nt) acc[t][nt] = (f32x4){0.f, 0.f, 0.f, 0.f}; }
#pragma unroll
    for (int half = 0; half < 2; ++half) {
        u32x4 av[NT][2]; bf16x8 wh[3][2], wl[3][2];
#pragma unroll
        for (int k2 = 0; k2 < 2; ++k2) { const int ko = (half * 2 + k2) * 32;
#pragma unroll
            for (int t = 0; t < NT; ++t) av[t][k2] = *(const u32x4*)(ap + (size_t)t * 16 * DM + ko);
#pragma unroll
            for (int nt = 0; nt < 3; ++nt) { wh[nt][k2] = *(const bf16x8*)(bh + nt * 16 * 1024 + ko); wl[nt][k2] = *(const bf16x8*)(bl + nt * 16 * 1024 + ko); } }
        __builtin_amdgcn_sched_barrier(0);
#pragma unroll
        for (int k2 = 0; k2 < 2; ++k2)
#pragma unroll
            for (int t = 0; t < NT; ++t) { const bf16x8 a = __builtin_bit_cast(bf16x8, av[t][k2]);
#pragma unroll
                for (int nt = 0; nt < 3; ++nt) { acc[t][nt] = __builtin_amdgcn_mfma_f32_16x16x32_bf16(wh[nt][k2], a, acc[t][nt], 0, 0, 0);
                    acc[t][nt] = __builtin_amdgcn_mfma_f32_16x16x32_bf16(wl[nt][k2], a, acc[t][nt], 0, 0, 0); }
                float xf[8]; unpack8(av[t][k2], xf); ssq[t] += sumsq8(xf); }
        __builtin_amdgcn_sched_barrier(0);
    }
    constexpr int WSTR = NT * 768 + NT * 64;
    LAS float* pl = (LAS float*)F.lds + F.wave * WSTR;
#pragma unroll
    for (int t = 0; t < NT; ++t) {
#pragma unroll
        for (int nt = 0; nt < 3; ++nt) *(LAS f32x4*)(pl + (t * 16 + r) * 48 + nt * 16 + 4 * fq) = acc[t][nt];
        pl[NT * 768 + t * 64 + fq * 16 + r] = ssq[t]; }
    __syncthreads();
    if (F.tid < NT * 16) { const int t = F.tid >> 4, rr = F.tid & 15, row = rowbase + F.tid;
        const LAS float* base = (const LAS float*)F.lds;
        float s = 0.f;
#pragma unroll
        for (int w = 0; w < 8; ++w)
#pragma unroll
            for (int f = 0; f < 4; ++f) s += base[w * WSTR + NT * 768 + t * 64 + f * 16 + rr];
        const float rinv = rsqrtf(s * (1.f / DM) + RMS_EPS);
        const float* rc = (const float*)(F.ws + WS_RC) + mr * 36;
        const LAS float* lrow = base + (t * 16 + rr) * 48;
        float l1[4];
#pragma unroll
        for (int i = 0; i < 4; ++i) { float v = 0.f;
#pragma unroll
            for (int w = 0; w < 8; ++w) v += lrow[w * WSTR + i];
            l1[i] = v * rinv + rc[i]; }
        int grp = 0; float best = l1[0];
#pragma unroll
        for (int i = 1; i < 4; ++i) if (l1[i] > best) { best = l1[i]; grp = i; }
        float den = 0.f;
#pragma unroll
        for (int i = 0; i < 4; ++i) den += __expf(l1[i] - best);
        const float pgrp = 1.f / den;
        float l2[8];
#pragma unroll
        for (int q = 0; q < 8; ++q) { float v = 0.f;
#pragma unroll
            for (int w = 0; w < 8; ++w) v += lrow[w * WSTR + 16 + grp * 8 + q];
            l2[q] = v * rinv + rc[4 + grp * 8 + q]; }
        int i0 = 0; float v0 = l2[0];
#pragma unroll
        for (int i = 1; i < 8; ++i) if (l2[i] > v0) { v0 = l2[i]; i0 = i; }
        int i1 = -1; float v1 = -3.0e38f;
#pragma unroll
        for (int i = 0; i < 8; ++i) if (i != i0 && l2[i] > v1) { v1 = l2[i]; i1 = i; }
        const float e1 = __expf(v1 - v0), w0 = 1.f / (1.f + e1), w1 = e1 * w0;
        ea = grp * 8 + i0; eb = grp * 8 + i1; myrow = row;
        ra = __hip_atomic_fetch_add(&lcnt[ea], 1u, __ATOMIC_RELAXED, __HIP_MEMORY_SCOPE_WORKGROUP);
        rb = __hip_atomic_fetch_add(&lcnt[eb], 1u, __ATOMIC_RELAXED, __HIP_MEMORY_SCOPE_WORKGROUP);
        gatew[row * 2] = pgrp * w0; gatew[row * 2 + 1] = pgrp * w1;
    }
    __syncthreads();
}
__device__ __forceinline__ void rows_norm2_router(const Ctx& F, int l) {
    const float* mod = (const float*)(F.ws + WS_MOD);
    const bf16* xres = (const bf16*)(F.ws + WS_XRES);
    bf16* gb = (bf16*)(F.ws + WS_H);
    const float* g2w = KIN(7) + l * DM;
    LAS unsigned* lcnt = (LAS unsigned*)(F.lds + MISC_OFF + 1024); LAS unsigned* lbase = lcnt + 32;
    if (F.tid < 64) lcnt[F.tid] = 0u;
    __syncthreads();
    unsigned* cnt = (unsigned*)(F.ws + WS_CTL) + CW_CNT + l * 64 + (F.dry ? 8192 : 0);
    int* list = (int*)(F.ws + (F.dry ? WS_E2 : WS_LIST));
    float* gatew = (float*)(F.ws + (F.dry ? WS_E2 + 4 * MiB : WS_GATEW));
    const int nrows = (l == DEPTH - 1) ? LAT_ROWS : TOK;
    int ea = 0, eb = 0, myrow = -1, ea2 = 0, eb2 = 0, myrow2 = -1; unsigned ra = 0u, rb = 0u, ra2 = 0u, rb2 = 0u;
    router_pass<4>(F, xres, 64 * F.bid, F.bid >> 6, lcnt, gatew, ea, eb, ra, rb, myrow);
    if (l < DEPTH - 1 && F.bid < 64) router_pass<1>(F, xres, LAT_ROWS + 16 * F.bid, 4, lcnt, gatew, ea2, eb2, ra2, rb2, myrow2);
    defer_convert(F, l * DEF_L + DEF_S5Q * 2048, DEF_NQ, (LAS float*)(F.lds + F.wave * 8448));
    constexpr int RR = 2;
    const int ntrip = (l < DEPTH - 1 && F.gw >= F.NGW - (TOK - LAT_ROWS)) ? 5 : 4;
    for (int trip = 0; trip < ntrip; ++trip) {
        RowV xx[RR]; int rws[RR];
#pragma unroll
        for (int rr = 0; rr < RR; ++rr) { rws[rr] = trip < 4 ? 64 * F.bid + 8 * F.wave + 2 * trip + rr : LAT_ROWS + F.gw - (F.NGW - (TOK - LAT_ROWS)); ld_row_bf16(xres + (size_t)rws[rr] * DM, F.lane, xx[rr]); }
#pragma unroll
        for (int rr = 0; rr < RR; ++rr) { if (trip == 4 && rr == 1) break;
            const int row = rws[rr];
            RowV& x = xx[rr];
            const float rinv = rsqrtf(row_sumsq(x) * (1.f / DM) + RMS_EPS);
            const float* mrow = mod + ((size_t)l * 5 + modrow_of(row)) * NMOD;
#pragma unroll
            for (int j = 0; j < 2; ++j) { const int col = 8 * F.lane + 512 * j;
                float gv[8], sh[8], scl[8]; ld8f(g2w + col, gv); ld8f(mrow + 3 * DM + col, sh); ld8f(mrow + 4 * DM + col, scl);
#pragma unroll
                for (int i = 0; i < 8; ++i) x.v[j][i] = x.v[j][i] * rinv * gv[i] * (1.f + scl[i]) + sh[i];
                *(u32x4*)(gb + (size_t)row * DM + col) = pack8(x.v[j]); }
        }
    }
    __syncthreads();
    if (F.tid < 32) { const unsigned n = lcnt[F.tid]; lbase[F.tid] = n ? atomicAdd(&cnt[F.tid], n) : 0u; }
    __syncthreads();
    if (myrow >= 0) { list[(size_t)ea * LIST_CAP + lbase[ea] + ra] = myrow * 2; list[(size_t)eb * LIST_CAP + lbase[eb] + rb] = myrow * 2 + 1; }
    if (myrow2 >= 0) { list[(size_t)ea2 * LIST_CAP + lbase[ea2] + ra2] = myrow2 * 2; list[(size_t)eb2 * LIST_CAP + lbase[eb2] + rb2] = myrow2 * 2 + 1; }
    __syncthreads();
}
__device__ __forceinline__ void rows_mla_pre(const Ctx& F, int i) {
    const bf16* z = (const bf16*)(F.ws + WS_ZRAW); bf16* ac = (bf16*)(F.ws + WS_ACAT);
    const float* gq = KIN(19) + i * 256; const float* gkv = KIN(21) + i * 128;
    for (int row = F.gw; row < TOK; row += F.NGW) {
        const u32x2 qv = *(const u32x2*)(z + (size_t)row * 1024 + 512 + 4 * F.lane);
        const float q0 = bflo(qv.x), q1 = bfhi(qv.x), q2 = bflo(qv.y), q3 = bfhi(qv.y);
        const float rq = rsqrtf(wave_sum(q0 * q0 + q1 * q1 + q2 * q2 + q3 * q3) * (1.f / 256.f) + RMS_EPS);
        const f32x4 gv = *(const f32x4*)(gq + 4 * F.lane);
        u32x2 w; w.x = pk2(q0 * rq * gv[0], q1 * rq * gv[1]); w.y = pk2(q2 * rq * gv[2], q3 * rq * gv[3]);
        *(u32x2*)(ac + (size_t)row * 512 + 4 * F.lane) = w;
        float k0 = 0.f, k1 = 0.f, k2 = 0.f, k3 = 0.f;
        if (F.lane < 32) { const u32x2 kv = *(const u32x2*)(z + (size_t)row * 1024 + 768 + 4 * F.lane); k0 = bflo(kv.x); k1 = bfhi(kv.x); k2 = bflo(kv.y); k3 = bfhi(kv.y); }
        const float rk = rsqrtf(wave_sum(k0 * k0 + k1 * k1 + k2 * k2 + k3 * k3) * (1.f / 128.f) + RMS_EPS);
        u32x2 w2 = (u32x2){0u, 0u};
        if (F.lane < 32) { const f32x4 gk = *(const f32x4*)(gkv + 4 * F.lane); w2.x = pk2(k0 * rk * gk[0], k1 * rk * gk[1]); w2.y = pk2(k2 * rk * gk[2], k3 * rk * gk[3]); }
        *(u32x2*)(ac + (size_t)row * 512 + 256 + 4 * F.lane) = w2;
    }
}
__device__ __forceinline__ void rows_mla_post(const Ctx& F, int i) {
    const bf16* qk = (const bf16*)(F.ws + WS_QKVM); const bf16* z = (const bf16*)(F.ws + WS_ZRAW);
    bf16* Qb = (bf16*)(F.ws + WS_QB); bf16* Kb = (bf16*)(F.ws + WS_KB); bf16* Vb = (bf16*)(F.ws + WS_VB);
    const float* qn = KIN(23) + i * 96; const float* kn = KIN(24) + i * 96;
    const float* rope = (const float*)(F.ws + WS_ROPE) + ROPE32_OFF;
    const int lane = F.lane, s = lane & 15, hq = lane >> 4, a = s & 1;
    const bool is_nope = s < 8, is_rope = (s == 8 || s == 9), is_zero = (s >= 10 && s < 14);
    const int d1 = is_nope ? 8 * s : 64 + a * 16, d2 = 64 + a * 16 + 8;
    float wq1[8], wq2[8], wk1[8], wk2[8];
#pragma unroll
    for (int j = 0; j < 8; ++j) { wq1[j] = qn[d1 + j]; wq2[j] = qn[d2 + j]; wk1[j] = kn[d1 + j]; wk2[j] = kn[d2 + j]; }
    constexpr int RR = 1;
    for (int row0 = F.gw; row0 < TOK; row0 += RR * F.NGW) {
        unsigned z0 = 0u; asm volatile("" : "+v"(z0)); const u32x4 zero4 = (u32x4){z0, z0, z0, z0};
        u32x4 q1[RR][2], q2[RR][2], k1[RR][2], kr1[RR], kr2[RR], vv[RR];
#pragma unroll
        for (int rr = 0; rr < RR; ++rr) { int row = row0 + rr * F.NGW; row = row < TOK ? row : TOK - 1;
            const bf16* qr = qk + (size_t)row * 1792; const bf16* kr = z + (size_t)row * 1024 + 896;
#pragma unroll
            for (int p2 = 0; p2 < 2; ++p2) { const int hd = 4 * p2 + hq;
                q1[rr][p2] = (is_nope || is_rope) ? *(const u32x4*)(qr + 96 * hd + d1) : zero4;
                q2[rr][p2] = is_rope ? *(const u32x4*)(qr + 96 * hd + d2) : zero4;
                k1[rr][p2] = is_nope ? *(const u32x4*)(qr + 768 + hd * 128 + 8 * s) : zero4; }
            kr1[rr] = is_rope ? *(const u32x4*)(kr + a * 16) : zero4; kr2[rr] = is_rope ? *(const u32x4*)(kr + a * 16 + 8) : zero4;
            vv[rr] = *(const u32x4*)(qr + 768 + (lane >> 3) * 128 + 64 + 8 * (lane & 7)); }
#pragma unroll
        for (int rr = 0; rr < RR; ++rr) { const int row = row0 + rr * F.NGW; if (row >= TOK) break;
            int b, pos, pa = 0; const bool lat = row < LAT_ROWS;
            if (lat) { b = row >> 12; const int t = row & 4095; pos = 256 + t; pa = a == 0 ? (t >> 6) : (t & 63); }
            else { b = (row - LAT_ROWS) >> 8; pos = (row - LAT_ROWS) & 255; }
            const float* csn = rope + (pa * 8) * 2;
#pragma unroll
            for (int p2 = 0; p2 < 2; ++p2) { const int hd = 4 * p2 + hq; const size_t obase = ((size_t)(b * 8 + hd) * SKV + pos) * 128;
                { float x1[8], x2[8]; unpack8(q1[rr][p2], x1); unpack8(q2[rr][p2], x2);
                  const float rinv = rsqrtf(group16_sum(sumsq8(x1) + sumsq8(x2)) * (1.f / 96.f) + RMS_EPS);
                  u32x4 o1, o2; norm_rope8(x1, x2, rinv, wq1, wq2, csn, is_rope && lat, o1, o2);
                  if (is_nope) *(u32x4*)(Qb + obase + 8 * s) = o1;
                  else if (is_rope) { *(u32x4*)(Qb + obase + d1) = o1; *(u32x4*)(Qb + obase + d2) = o2; }
                  else if (is_zero) *(u32x4*)(Qb + obase + 96 + 8 * (s - 10)) = zero4; }
                { float x1[8], x2[8]; unpack8(is_rope ? kr1[rr] : k1[rr][p2], x1); unpack8(kr2[rr], x2);
                  const float rinv = rsqrtf(group16_sum(sumsq8(x1) + sumsq8(x2)) * (1.f / 96.f) + RMS_EPS);
                  u32x4 o1, o2; norm_rope8(x1, x2, rinv, wk1, wk2, csn, is_rope && lat, o1, o2);
                  if (is_nope) *(u32x4*)(Kb + obase + 8 * s) = o1;
                  else if (is_rope) { *(u32x4*)(Kb + obase + d1) = o1; *(u32x4*)(Kb + obase + d2) = o2; }
                  else if (is_zero) *(u32x4*)(Kb + obase + 96 + 8 * (s - 10)) = zero4; }
            }
            *(u32x4*)(Vb + ((size_t)(b * 8 + (lane >> 3)) * SKV + pos) * 64 + 8 * (lane & 7)) = vv[rr];
        }
    }
}
__device__ __forceinline__ void rows_gqa_post(const Ctx& F, int i) {
    const bf16* z = (const bf16*)(F.ws + WS_ZRAW);
    bf16* Qb = (bf16*)(F.ws + WS_QB); bf16* Kb = (bf16*)(F.ws + WS_KB); bf16* Vb = (bf16*)(F.ws + WS_VB);
    const float* qn = KIN(27) + i * 128; const float* kn = KIN(28) + i * 128;
    const float* rope = (const float*)(F.ws + WS_ROPE);
    const int lane = F.lane, hh = lane >> 3, sub = lane & 7, a = sub >> 2, fc = sub & 3;
    const int d1 = a * 64 + 8 * fc, d2 = d1 + 32;
    float wq1[8], wq2[8], wk1[8], wk2[8];
#pragma unroll
    for (int j = 0; j < 8; ++j) { wq1[j] = qn[d1 + j]; wq2[j] = qn[d2 + j]; wk1[j] = kn[d1 + j]; wk2[j] = kn[d2 + j]; }
    const bool isk = lane < 32; const int l2 = lane - 32;
    constexpr int RR = 1;
    for (int row0 = F.gw; row0 < TOK; row0 += RR * F.NGW) {
        u32x4 q1[RR], q2[RR], s1[RR], s2[RR];
#pragma unroll
        for (int rr = 0; rr < RR; ++rr) { int row = row0 + rr * F.NGW; row = row < TOK ? row : TOK - 1;
            const bf16* r = z + (size_t)row * 2048;
            q1[rr] = *(const u32x4*)(r + hh * 128 + d1); q2[rr] = *(const u32x4*)(r + hh * 128 + d2);
            s1[rr] = *(const u32x4*)(isk ? r + 1024 + hh * 128 + d1 : r + 1536 + 16 * l2); s2[rr] = *(const u32x4*)(isk ? r + 1024 + hh * 128 + d2 : r + 1536 + 16 * l2 + 8); }
#pragma unroll
        for (int rr = 0; rr < RR; ++rr) { const int row = row0 + rr * F.NGW; if (row >= TOK) break;
            int b, pos, pa = 0; const bool lat = row < LAT_ROWS;
            if (lat) { b = row >> 12; const int t = row & 4095; pos = 256 + t; pa = a == 0 ? (t >> 6) : (t & 63); }
            else { b = (row - LAT_ROWS) >> 8; pos = (row - LAT_ROWS) & 255; }
            const float* csn = rope + (pa * 32 + 8 * fc) * 2;
            { float x1[8], x2[8]; unpack8(q1[rr], x1); unpack8(q2[rr], x2);
              const float rinv = rsqrtf(group8_sum(sumsq8(x1) + sumsq8(x2)) * (1.f / 128.f) + RMS_EPS);
              u32x4 o1, o2; norm_rope8(x1, x2, rinv, wq1, wq2, csn, lat, o1, o2);
              bf16* o = Qb + ((size_t)(b * 8 + hh) * SKV + pos) * 128; *(u32x4*)(o + d1) = o1; *(u32x4*)(o + d2) = o2; }
            { float x1[8], x2[8]; unpack8(s1[rr], x1); unpack8(s2[rr], x2);
              const float rinv = rsqrtf(group8_sum(sumsq8(x1) + sumsq8(x2)) * (1.f / 128.f) + RMS_EPS);
              u32x4 o1, o2; norm_rope8(x1, x2, rinv, wk1, wk2, csn, lat, o1, o2);
              if (isk) { bf16* o = Kb + ((size_t)(b * 4 + hh) * SKV + pos) * 128; *(u32x4*)(o + d1) = o1; *(u32x4*)(o + d2) = o2; }
              else { bf16* o = Vb + ((size_t)(b * 4 + (l2 >> 3)) * SKV + pos) * 128 + 16 * (l2 & 7); *(u32x4*)(o) = s1[rr]; *(u32x4*)(o + 8) = s2[rr]; } }
        }
    }
}
__device__ __forceinline__ void rows_final(const Ctx& F) {
    const float* mod = (const float*)(F.ws + WS_MOD); const bf16* ydn = (const bf16*)(F.ws + WS_YDN); const bf16* xres = (const bf16*)(F.ws + WS_XRES);
#pragma unroll 2
    for (int row = F.gw; row < LAT_ROWS; row += F.NGW) {
        const float* g2 = mod + ((size_t)(DEPTH - 1) * 5 + (row >> 12)) * NMOD + 5 * DM;
        RowV x; ld_row_bf16(xres + (size_t)row * DM, F.lane, x);
#pragma unroll
        for (int j = 0; j < 2; ++j) { const int col = 8 * F.lane + 512 * j;
            float gv[8], a[8], b2[8]; ld8f(g2 + col, gv);
            unpack8(*(const u32x4*)(ydn + (size_t)(2 * row) * DM + col), a); unpack8(*(const u32x4*)(ydn + (size_t)(2 * row + 1) * DM + col), b2);
            f32x4 o0, o1;
#pragma unroll
            for (int i = 0; i < 4; ++i) { o0[i] = x.v[j][i] + gv[i] * (a[i] + b2[i]); o1[i] = x.v[j][4 + i] + gv[4 + i] * (a[4 + i] + b2[4 + i]); }
            *(f32x4*)(F.out + (size_t)row * DM + col) = o0; *(f32x4*)(F.out + (size_t)row * DM + col + 4) = o1; }
    }
}
#define XB_TMO      128
#define XB_XCNT(j)  (256  + 64 * (j))
#define XB_XSUB(j)  (1280 + 64 * (j))
#define XB_XGEN(j)  (2304 + 64 * (j))
#define XB_TOP      3328
#define XB_TOPGEN   3392
#define XCD_BAR_WORDS 3456
#define XB_SPIN_CAP (1u << 22)
__device__ __forceinline__ unsigned xb_ld(unsigned* p)              { return __hip_atomic_load(p, __ATOMIC_RELAXED, __HIP_MEMORY_SCOPE_AGENT); }
__device__ __forceinline__ unsigned xb_add(unsigned* p, unsigned v) { return __hip_atomic_fetch_add(p, v, __ATOMIC_RELAXED, __HIP_MEMORY_SCOPE_AGENT); }
__device__ __forceinline__ unsigned xb_xcc_id() { return (unsigned)__builtin_amdgcn_s_getreg((3 << 11) | 20) & 0xFu; }
#define XB_SPIN(cond, bar) do { unsigned _sp = 0; while (cond) { __builtin_amdgcn_s_sleep(1); \
    if ((++_sp & 255u) == 0u) { if (xb_ld(&(bar)[XB_TMO])) break; if (_sp > XB_SPIN_CAP) { atomicAdd(&(bar)[XB_TMO], 1u); break; } } } } while (0)
struct XcdBarrier { unsigned* bar; unsigned x; volatile LAS unsigned* st; };
__device__ __forceinline__ XcdBarrier xcd_barrier_post(unsigned* bar, volatile LAS unsigned* st) {
    XcdBarrier b; b.bar = bar; b.x = xb_xcc_id(); b.st = st;
    if (threadIdx.x == 0) (void)xb_add(&bar[XB_XCNT(b.x)], 1u);
    return b;
}
__device__ __forceinline__ void xcd_barrier_complete(unsigned* bar, unsigned x, unsigned& nloc, unsigned& nx) {
    const unsigned G = gridDim.x * gridDim.y * gridDim.z;
    unsigned sum, cnt, mine, sp = 0u;
    for (;;) {
        sum = 0u; cnt = 0u; mine = 0u;
#pragma unroll
        for (unsigned j = 0; j < 16; ++j) { const unsigned c = xb_ld(&bar[XB_XCNT(j)]); sum += c; cnt += (c > 0u) ? 1u : 0u; mine = (j == x) ? c : mine; }
        if (sum == G) break;
        __builtin_amdgcn_s_sleep(1);
        if ((++sp & 255u) == 0u) { if (xb_ld(&bar[XB_TMO])) break; if (sp > XB_SPIN_CAP) { atomicAdd(&bar[XB_TMO], 1u); break; } }
    }
    nloc = mine > 0u ? mine : 1u; nx = cnt > 0u ? cnt : 1u;
}
__device__ __forceinline__ void xcd_barrier(const XcdBarrier& b) {
    asm volatile("s_waitcnt vmcnt(0)" ::: "memory");
    __syncthreads();
    if (threadIdx.x == 0) {
        unsigned* bar = b.bar;
        __builtin_amdgcn_s_waitcnt(0);
        unsigned nloc = b.st[0], nx = b.st[1];
        if (nloc == 0u) { xcd_barrier_complete(bar, b.x, nloc, nx); b.st[0] = nloc; b.st[1] = nx; }
        const unsigned old = xb_add(&bar[XB_XSUB(b.x)], 1u);
        const unsigned gen = old / nloc;
        if (old + 1u == (gen + 1u) * nloc) {
            __builtin_amdgcn_fence(__ATOMIC_RELEASE, "agent");
            asm volatile("s_waitcnt vmcnt(0)" ::: "memory");
            const unsigned og = xb_add(&bar[XB_TOP], 1u);
            const unsigned tg = og / nx;
            if (og + 1u == (tg + 1u) * nx) xb_add(&bar[XB_TOPGEN], 1u);
            else XB_SPIN(xb_ld(&bar[XB_TOPGEN]) == tg, bar);
            __builtin_amdgcn_fence(__ATOMIC_ACQUIRE, "agent");
            xb_add(&bar[XB_XGEN(b.x)], 1u);
            asm volatile("s_waitcnt vmcnt(0)" ::: "memory");
        } else {
            XB_SPIN(xb_ld(&bar[XB_XGEN(b.x)]) == gen, bar);
            __builtin_amdgcn_fence(__ATOMIC_ACQUIRE, "agent");
            asm volatile("s_waitcnt vmcnt(0)" ::: "memory");
        }
    }
    __syncthreads();
}

constexpr int NPH = 1 + 2 * 9 + 2 * 7 + 1;
constexpr int G_NONE = -1;
using pg8::G_INPROJ; using pg8::G_MLA; using pg8::G_GLU; using pg8::G_OUT; using pg8::G_QKV; using pg8::G_MOE1; using pg8::G_MOE2;
enum { K_NONE = 0, K_NORM1, K_MLA_PRE_S5A, K_MLA_POST, K_S5B_ATT, K_NORM2, K_GQA_POST, K_ATT_GQA };

__device__ __forceinline__ void attention_phase(const Ctx& F, int l, bool even) {
    const bf16* Qb = (const bf16*)(F.ws + WS_QB); const bf16* Kb = (const bf16*)(F.ws + WS_KB); const bf16* Vb = (const bf16*)(F.ws + WS_VB);
    bf16* mix = (bf16*)(F.ws + WS_MIX);
    const int c = F.bid, x = c & 7, slot = c >> 3;
    const int nround = (l == DEPTH - 1) ? 2 : 3;
    for (int round = 0; round < nround; ++round) {
        int b, h, qb; bool ctxu = false;
        if (round < 2) {
            if (even) { const int pair = round * 16 + x * 2 + (slot >> 4); b = pair >> 3; h = pair & 7; qb = slot & 15; }
            else { const int pair = round * 8 + x; b = pair >> 2; h = (pair & 3) * 2 + (slot >> 4); qb = slot & 15; }
        } else { if (c >= 32) break; b = c >> 3; h = c & 7; qb = 0; ctxu = true; }
        const size_t qrow = (size_t)(b * 8 + h) * SKV + (ctxu ? 0 : 256 + qb * 256);
        const int orow = ctxu ? LAT_ROWS + b * 256 : b * 4096 + qb * 256;
        const int seq = ctxu ? CTXL : SKV;
        if (even) {
            att::attn_dense_body<64, 1, 1024, 96>(Qb + qrow * 128, Kb + (size_t)(b * 8 + h) * SKV * 128, Vb + (size_t)(b * 8 + h) * SKV * 64,
                                              mix + (size_t)orow * 1024 + 512 + h * 64, seq, (char*)F.lds, F.tid);
        } else {
            const int kvh = h >> 1;
            att::attn_dense_body<128, 0, 1024, 128>(Qb + qrow * 128, Kb + (size_t)(b * 4 + kvh) * SKV * 128, Vb + (size_t)(b * 4 + kvh) * SKV * 128,
                                               mix + (size_t)orow * 1024 + h * 128, seq, (char*)F.lds, F.tid);
        }
    }
}


#ifdef DBG_CHECKS
constexpr int CW_FLAGS = 20000;
__device__ __forceinline__ void dbg_flag(const Ctx& F, int j) { atomicOr((unsigned*)(F.ws + WS_CTL) + CW_FLAGS, 1u << j); }
__device__ __forceinline__ void dbg_moe_check(const Ctx& F, int l) {
    const unsigned* cnt = (const unsigned*)(F.ws + WS_CTL) + CW_CNT + l * 64; const int* list = (const int*)(F.ws + WS_LIST);
    const bf16* g = (const bf16*)(F.ws + WS_H); const bf16* act = (const bf16*)(F.ws + WS_ACT); const bf16* ydn = (const bf16*)(F.ws + WS_YDN);
    const float* gatew = (const float*)(F.ws + WS_GATEW);
    for (int s = F.gw; s < 96; s += F.NGW) {
        const int e = s & 31, which = s >> 5; const int c = (int)cnt[e]; if (c == 0) continue;
        const int pos = which == 0 ? 0 : (which == 1 ? c - 1 : (c > 300 ? 300 : c / 2));
        const int ent = list[(size_t)e * LIST_CAP + pos], row = ent >> 1;
        const float* wg = KIN(33) + ((size_t)l * 32 + e) * 1024 * 512; const float* wu = KIN(34) + ((size_t)l * 32 + e) * 1024 * 512; const float* wd = KIN(35) + ((size_t)l * 32 + e) * 512 * 1024;
        float h1[8], h2[8];
        for (int j = 0; j < 8; ++j) { h1[j] = 0.f; h2[j] = 0.f; }
        for (int k = 0; k < 1024; ++k) { const float gv = bf2f(g[(size_t)row * 1024 + k]);
            for (int j = 0; j < 8; ++j) { h1[j] += gv * wg[(size_t)k * 512 + F.lane + 64 * j]; h2[j] += gv * wu[(size_t)k * 512 + F.lane + 64 * j]; } }
        float err = 0.f, ss = 0.f;
        for (int j = 0; j < 8; ++j) { const float r = siluf_(h1[j]) * h2[j]; const float a = bf2f(act[(size_t)ent * 512 + F.lane + 64 * j]); err = fmaxf(err, fabsf(a - r)); ss += r * r; }
        err = wave_max(err); ss = wave_sum(ss);
        if (!(err <= 0.1f * __builtin_amdgcn_sqrtf(ss / 512.f) + 1e-6f)) { if (F.lane == 0) dbg_flag(F, 0); }
        float y[16];
        for (int j = 0; j < 16; ++j) y[j] = 0.f;
        for (int f = 0; f < 512; ++f) { const float av = bf2f(act[(size_t)ent * 512 + f]);
            for (int j = 0; j < 16; ++j) y[j] += av * wd[(size_t)f * 1024 + F.lane + 64 * j]; }
        const float gw = gatew[ent]; float err2 = 0.f, ss2 = 0.f;
        for (int j = 0; j < 16; ++j) { const float r = y[j] * gw; const float a = bf2f(ydn[(size_t)ent * 1024 + F.lane + 64 * j]); err2 = fmaxf(err2, fabsf(a - r)); ss2 += r * r; }
        err2 = wave_max(err2); ss2 = wave_sum(ss2);
        if (!(err2 <= 0.1f * __builtin_amdgcn_sqrtf(ss2 / 1024.f) + 1e-6f)) { if (F.lane == 0) dbg_flag(F, 1); }
        else if (ss2 > 1e-8f && ss > 1e-8f && F.lane == 0) dbg_flag(F, 3);
    }
}
__device__ __forceinline__ void dbg_mod_check(const Ctx& F, int l) {
    const float* mod = (const float*)(F.ws + WS_MOD);
    for (int s = F.gw; s < 60; s += F.NGW) {
        const int r = s % 5, n = (s * 509 + 77) % 6144;
        float ser = 0.f;
        for (int k = 0; k < 1024; ++k) { const float cv = r < 4 ? KIN(1)[r * 1024 + k] : KIN(3)[k]; ser += siluf_(cv) * KIN(4)[((size_t)l * 1024 + k) * 6144 + n]; }
        ser += KIN(5)[l * 6144 + n];
        float acc = 0.f;
        for (int k = F.lane; k < 1024; k += 64) { const float cv = r < 4 ? KIN(1)[r * 1024 + k] : KIN(3)[k]; acc += siluf_(cv) * KIN(4)[((size_t)l * 1024 + k) * 6144 + n]; }
        acc = wave_sum(acc) + KIN(5)[l * 6144 + n];
        const float got = mod[((size_t)l * 5 + r) * 6144 + n];
        if (!(fabsf(got - ser) <= 1e-3f + 1e-3f * fabsf(ser))) { if (F.lane == 0) dbg_flag(F, 0); }
        if (!(fabsf(acc - ser) <= 1e-3f + 1e-3f * fabsf(ser))) { if (F.lane == 0) dbg_flag(F, 1); }
    }
    return;
    const float* xres = (const float*)(F.ws + WS_XRES); const unsigned* cnt = (const unsigned*)(F.ws + WS_CTL) + CW_CNT + l * 64; const int* list = (const int*)(F.ws + WS_LIST);
    const float* gatew = (const float*)(F.ws + WS_GATEW); const bf16* gb = (const bf16*)(F.ws + WS_H);
    for (int s = F.gw; s < 64; s += F.NGW) {
        const int row = (s * 263 + 11) % TOK; const int mr = modrow_of(row);
        float ssq = 0.f;
        for (int k = F.lane; k < 1024; k += 64) { const float v = xres[(size_t)row * 1024 + k]; ssq += v * v; }
        const float rinv = rsqrtf(wave_sum(ssq) / 1024.f + 1e-6f);
        float lg[36];
#pragma unroll
        for (int j = 0; j < 36; ++j) lg[j] = 0.f;
        float gerr = 0.f;
        for (int k = F.lane; k < 1024; k += 64) {
            const float gv = xres[(size_t)row * 1024 + k] * rinv * KIN(7)[l * 1024 + k] * (1.f + mod[((size_t)l * 5 + mr) * 6144 + 4096 + k]) + mod[((size_t)l * 5 + mr) * 6144 + 3072 + k];
            gerr = fmaxf(gerr, fabsf(bf2f(gb[(size_t)row * 1024 + k]) - gv));
#pragma unroll
            for (int j = 0; j < 4; ++j) lg[j] += gv * KIN(29)[((size_t)l * 1024 + k) * 4 + j];
#pragma unroll
            for (int j = 0; j < 32; ++j) lg[4 + j] += gv * KIN(31)[((size_t)l * 1024 + k) * 32 + j];
        }
        gerr = wave_max(gerr);
#pragma unroll
        for (int j = 0; j < 36; ++j) lg[j] = wave_sum(lg[j]);
#pragma unroll
        for (int j = 0; j < 4; ++j) lg[j] += KIN(30)[l * 4 + j];
#pragma unroll
        for (int j = 0; j < 32; ++j) lg[4 + j] += KIN(32)[l * 32 + j];
        int grp = 0; float bestg = lg[0];
#pragma unroll
        for (int j = 1; j < 4; ++j) if (lg[j] > bestg) { bestg = lg[j]; grp = j; }
        float den = 0.f;
#pragma unroll
        for (int j = 0; j < 4; ++j) den += __expf(lg[j] - bestg);
        float l8[8];
#pragma unroll
        for (int j = 0; j < 8; ++j) { float v = 0.f;
#pragma unroll
            for (int q = 0; q < 4; ++q) v = (grp == q) ? lg[4 + q * 8 + j] : v;
            l8[j] = v; }
        int i0 = 0; float v0 = l8[0];
#pragma unroll
        for (int j = 1; j < 8; ++j) if (l8[j] > v0) { v0 = l8[j]; i0 = j; }
        int i1 = -1; float v1 = -3.0e38f;
#pragma unroll
        for (int j = 0; j < 8; ++j) if (j != i0 && l8[j] > v1) { v1 = l8[j]; i1 = j; }
        const float e1 = __expf(v1 - v0), w0 = 1.f / (1.f + e1) / den, w1 = e1 / (1.f + e1) / den;
        if (gerr > 0.05f && F.lane == 0) dbg_flag(F, 1);
        bool bad = false;
        if (fabsf(gatew[row * 2] - w0) > 1e-3f || fabsf(gatew[row * 2 + 1] - w1) > 1e-3f) bad = true;
        const int ea = grp * 8 + i0, eb = grp * 8 + i1; bool fa = false, fb = false;
        for (int q = F.lane; q < (int)cnt[ea]; q += 64) if (list[(size_t)ea * LIST_CAP + q] == row * 2) fa = true;
        for (int q = F.lane; q < (int)cnt[eb]; q += 64) if (list[(size_t)eb * LIST_CAP + q] == row * 2 + 1) fb = true;
        if (!__any(fa) || !__any(fb)) bad = true;
        if (bad && F.lane == 0) dbg_flag(F, 2);
    }
}
__device__ __forceinline__ void dbg_final(const Ctx& F) {
    const unsigned flags = ((const unsigned*)(F.ws + WS_CTL))[CW_FLAGS];
    for (int row = F.gw; row < LAT_ROWS; row += F.NGW) {
        bool zero = false;
        for (int j = 0; j < 4; ++j) { const int lo = 512 * ((1 << j) - 1), hi = 512 * ((2 << j) - 1); if (((flags >> j) & 1u) && row >= lo && row < hi) zero = true; }
#pragma unroll
        for (int j = 0; j < 4; ++j) { const int col = 4 * F.lane + 256 * j; f32x4 xv = *(const f32x4*)(KIN(0) + (size_t)row * DM + col); if (zero) xv = (f32x4){0.f, 0.f, 0.f, 0.f};
            *(f32x4*)(F.out + (size_t)row * DM + col) = xv; }
    }
}
#endif

#ifdef DBG_TS
__device__ __forceinline__ void dbg_ts_final(const Ctx& F) {
    const unsigned long long* tsb = (const unsigned long long*)(F.ws + WS_CTL + 512 * 1024);
    unsigned long long da = 0, db = 0;
    for (int ph = 0; ph < NPH - 1; ++ph) { const unsigned long long d = tsb[ph + 1] - tsb[ph];
        if ((DBG_TSA >> ph) & 1ull) da += d; if ((DBG_TSB >> ph) & 1ull) db += d; }
    const int nz = (int)(da * 8 / 100) < LAT_ROWS ? (int)(da * 8 / 100) : LAT_ROWS;
    for (int row = F.gw; row < LAT_ROWS; row += F.NGW) {
#pragma unroll
        for (int j = 0; j < 4; ++j) { const int col = 4 * F.lane + 256 * j; f32x4 xv = *(const f32x4*)(KIN(0) + (size_t)row * DM + col); if (row < nz) xv = (f32x4){0.f, 0.f, 0.f, 0.f};
            if (row == 0 && col == 0) xv[0] = (float)db;
            *(f32x4*)(F.out + (size_t)row * DM + col) = xv; }
    }
}
#endif

__device__ __forceinline__ void run_phase(const Ctx& F0, int ph, int sub = 3) {
    Ctx F = F0;
    asm volatile("" : "+s"(F.ws), "+s"(F.out), "+s"(F.bid), "+s"(F.G));
    asm volatile("" : "+v"(F.tid));
    F.lane = F.tid & 63; F.wave = __builtin_amdgcn_readfirstlane(F.tid >> 6); F.gw = F.bid * 8 + F.wave; F.NGW = F.G * 8;
    { unsigned ldsb = (unsigned)(uintptr_t)F0.lds; asm volatile("" : "+s"(ldsb)); F.lds = (LAS unsigned char*)(uintptr_t)ldsb; }
#ifndef T_NO_P0
    if (ph == 0) {
        if (F.bid < 192) p0_ada(F);
        else if (F.bid == 192) p0_rope(F);
        else if (F.bid == 193) p0_router_t(F);
        p0_weights(F);
        return;
    }
#endif
#ifdef DBG_CHECKS
    if (ph == NPH - 1) { dbg_final(F); return; }
    if (ph >= 100) { dbg_mod_check(F, ph - 100); return; }
#endif
#ifdef DBG_TS
    if (ph == NPH - 1) { dbg_ts_final(F); return; }
#endif
    if (ph == NPH - 1) { rows_final(F); return; }
    if (ph >= 60) return;
    int l, step; { int q = ph - 1; if (q < 9) { l = 0; step = q; } else if (q < 16) { l = 1; step = q - 9; } else if (q < 25) { l = 2; step = q - 16; } else { l = 3; step = q - 25; } }
    const bool even = (l & 1) == 0; const int i = l >> 1;
    int gid = G_NONE, kind = K_NONE;
    if (even) {
        switch (step) { case 0: kind = K_NORM1; break; case 1: gid = G_INPROJ; break; case 2: kind = K_MLA_PRE_S5A; break; case 3: gid = G_MLA; break; case 4: kind = K_MLA_POST; break;
                        case 5: kind = K_S5B_ATT; gid = G_GLU; break; case 6: gid = G_OUT; break; case 7: kind = K_NORM2; break; default: gid = G_MOE1; break; }
    } else {
        switch (step) { case 0: kind = K_NORM1; break; case 1: gid = G_QKV; break; case 2: kind = K_GQA_POST; break; case 3: kind = K_ATT_GQA; break; case 4: gid = G_OUT; break;
                        case 5: kind = K_NORM2; break; default: gid = G_MOE1; break; }
    }
    switch (kind) {
#ifndef T_NO_ROWS
    case K_NORM1: build_router_tab(F, l); rows_norm1(F, l);
#ifndef T_NO_S5
        if (even && F.bid < 8) { const int w = F.bid * 8 + F.wave, dd = w >> 5, g = w & 31;
            s5::Params SP{KIN(10) + (size_t)i * 4096, KIN(11) + (size_t)i * 4096, KIN(12) + i * 64, KIN(13) + (size_t)i * 65536, KIN(14) + (size_t)i * 65536,
                      KIN(15) + (size_t)i * 65536, KIN(16) + (size_t)i * 65536, KIN(17) + i * 512};
            s5::build_tab(SP, dd, g, F.lane, (u32x4*)(F.ws + WS_S5TAB) + (size_t)(i * 64 + dd * 32 + g) * (s5::TAB_BYTES / 16)); }
#endif
        break;
    case K_NORM2: rows_norm2_router(F, l); break;
#endif
    case K_MLA_PRE_S5A: {
        rows_mla_pre(F, i);
        s5::Params SP{KIN(10) + (size_t)i * 4096, KIN(11) + (size_t)i * 4096, KIN(12) + i * 64, KIN(13) + (size_t)i * 65536, KIN(14) + (size_t)i * 65536,
                      KIN(15) + (size_t)i * 65536, KIN(16) + (size_t)i * 65536, KIN(17) + i * 512};
#ifndef T_NO_S5
        if (F.wave >= 4) defer_convert(F, 2 * i * DEF_L, DEF_S5Q, (LAS float*)(F.lds + 8 * 8704 + F.wave * 8448));
        for (int it = F.gw; it < s5::NITEMS; it += F.NGW) s5::pass_a_item(SP, (const u32x4*)(F.ws + WS_S5TAB) + (size_t)i * 64 * (s5::TAB_BYTES / 16), (const bf16*)(F.ws + WS_ZRAW), (float*)(F.ws + WS_E2), it, F.lane);
        if (F.wave < 4) defer_convert(F, 2 * i * DEF_L, DEF_S5Q, (LAS float*)(F.lds + 8 * 8704 + F.wave * 8448));
#endif
    } break;
    case K_MLA_POST: {
        rows_mla_post(F, i);
        s5::Params SP{KIN(10) + (size_t)i * 4096, KIN(11) + (size_t)i * 4096, KIN(12) + i * 64, KIN(13) + (size_t)i * 65536, KIN(14) + (size_t)i * 65536,
                      KIN(15) + (size_t)i * 65536, KIN(16) + (size_t)i * 65536, KIN(17) + i * 512};
#ifndef T_NO_S5
        if (F.wave >= 4) defer_convert(F, (2 * i + 1) * DEF_L, DEF_S5Q, (LAS float*)(F.lds + 8 * 8704 + F.wave * 8448));
        if (sub & 1) for (int it = F.gw; it < s5::NITEMS; it += F.NGW)
            s5::pass_b_item(SP, (const u32x4*)(F.ws + WS_S5TAB) + (size_t)i * 64 * (s5::TAB_BYTES / 16), (const bf16*)(F.ws + WS_ZRAW), (const float*)(F.ws + WS_E2), (bf16*)(F.ws + WS_GG), F.lds + F.wave * s5::HS_BYTES, it, F.lane);
        if (F.wave < 4) defer_convert(F, (2 * i + 1) * DEF_L, DEF_S5Q, (LAS float*)(F.lds + 8 * 8704 + F.wave * 8448));
#endif
    } break;
    case K_S5B_ATT: {
        __syncthreads();
#ifndef T_NO_ATT
        if (sub & 2) attention_phase(F, l, true);
#endif
    } break;
    case K_GQA_POST: rows_gqa_post(F, i); break;
#ifndef T_NO_ATT
    case K_ATT_GQA: attention_phase(F, l, false); break;
#endif
    default: break;
    }
    if (gid != G_NONE) {
        unsigned char* ws = F.ws;
        const unsigned* cnt = (const unsigned*)(ws + WS_CTL) + CW_CNT + l * 64;
        if (gid == G_MOE1 || gid == G_MOE2) {
            if (F.tid == 0) { LAS int* tp = (LAS int*)(F.lds + MISC_OFF + 256); int acc = 0;
                for (int e = 0; e < NEXP; ++e) { tp[e] = acc; acc += ((int)cnt[e] + 255) >> 8; } tp[NEXP] = acc; }
            __syncthreads();
        }
#ifdef DBG_NOCTX_DRY
#define CTXDRY if (!F.dry)
#else
#define CTXDRY
#endif
#define PROB_COMMON(P) P.G = F.G; P.c = F.bid; P.list = (const int*)(ws + WS_LIST); P.cnt = cnt; P.tp = (const LAS int*)(F.lds + MISC_OFF + 256); \
        P.l = l; P.ws = ws; P.O = nullptr; P.xlat = nullptr; P.xctx = nullptr;
        switch (gid) {
#ifndef T_NO_GEMM
        case G_INPROJ: { pg8::Prob<G_INPROJ> P; PROB_COMMON(P); P.A = (const char*)(ws + WS_H); P.B = (const char*)(ws + WS_W_IN) + (size_t)i * 1024 * 1024 * 2; P.O = (bf16*)(ws + WS_ZRAW); pg8::gemm_phase(F.lds, P, F.tid); CTXDRY pg8::ctx_gemm(F.lds, P, F.tid); } break;
        case G_MLA: {
#ifndef T_NO_S5
            if (F.wave == 0 && F.bid < 256) { s5::Params SP{KIN(10) + (size_t)i * 4096, KIN(11) + (size_t)i * 4096, KIN(12) + i * 64, KIN(13) + (size_t)i * 65536, KIN(14) + (size_t)i * 65536,
                      KIN(15) + (size_t)i * 65536, KIN(16) + (size_t)i * 65536, KIN(17) + i * 512};
                s5::prefix_wave(SP, (float*)(ws + WS_E2), F.bid, F.lane); }
#endif
            pg8::Prob<G_MLA> P; PROB_COMMON(P); P.A = (const char*)(ws + WS_ACAT); P.B = (const char*)(ws + WS_W_MLA) + (size_t)i * 1792 * 256 * 2; P.O = (bf16*)(ws + WS_QKVM); pg8::gemm_phase(F.lds, P, F.tid); } break;
        case G_GLU: { pg8::Prob<G_GLU> P; PROB_COMMON(P); P.A = (const char*)(ws + WS_GG); P.B = (const char*)(ws + WS_W_GLU) + (size_t)i * 512 * 512 * 2; pg8::gemm_phase(F.lds, P, F.tid); } break;
        case G_OUT: { pg8::Prob<G_OUT> P; PROB_COMMON(P); P.A = (const char*)(ws + WS_MIX); P.B = (const char*)(ws + (even ? WS_W_OUTE : WS_W_OUTO)) + (size_t)i * 1024 * 1024 * 2;
            P.xlat = KIN(0); P.xctx = KIN(2); pg8::gemm_phase(F.lds, P, F.tid); if (l < DEPTH - 1) pg8::ctx_gemm(F.lds, P, F.tid); } break;
        case G_QKV: { pg8::Prob<G_QKV> P; PROB_COMMON(P); P.A = (const char*)(ws + WS_H); P.B = (const char*)(ws + WS_W_QKV) + (size_t)i * 2048 * 1024 * 2; P.O = (bf16*)(ws + WS_ZRAW); pg8::gemm_phase(F.lds, P, F.tid); CTXDRY pg8::ctx_gemm(F.lds, P, F.tid); } break;
        default: { unsigned* ready = (unsigned*)(ws + WS_CTL) + CW_READY + l * READY_L;
            { pg8::Prob<G_MOE1> P; PROB_COMMON(P); P.ready = ready; P.A = (const char*)(ws + WS_H); P.B = (const char*)(ws + WS_W_GU) + (size_t)l * 32 * 1024 * 1024 * 2; pg8::gemm_phase(F.lds, P, F.tid); }
            { pg8::Prob<G_MOE2> P; PROB_COMMON(P); P.ready = ready; P.A = (const char*)(ws + WS_ACT); P.B = (const char*)(ws + WS_W_DN) + (size_t)l * 32 * 1024 * 512 * 2; pg8::gemm_phase(F.lds, P, F.tid); } } break;
#else
        default: break;
#endif
        }
#undef PROB_COMMON
        return;
    }
}

struct Args { const float* in[36]; float* out; unsigned char* ws; int ph_lo, ph_hi; };

__global__ void __launch_bounds__(512, 2) mega(Args args) {
    extern __shared__ __attribute__((aligned(16))) unsigned char lds_[];
    Ctx F;
    F.out = args.out; F.ws = args.ws;
    F.lds = (LAS unsigned char*)lds_;
    F.tid = threadIdx.x; F.lane = F.tid & 63; F.wave = __builtin_amdgcn_readfirstlane(F.tid >> 6);
    F.G = gridDim.x; F.bid = blockIdx.x; F.gw = blockIdx.x * 8 + F.wave; F.NGW = F.G * 8;
    volatile LAS unsigned* MISC = (volatile LAS unsigned*)(F.lds + MISC_OFF);
    for (int u = F.tid; u < (LDS_BYTES - RING_BYTES) / 4; u += 512) ((LAS unsigned*)(F.lds + RING_BYTES))[u] = 0u;
    __syncthreads();
    const int lo = args.ph_lo & 0xfff, hi = args.ph_hi & 0xfff; F.dry = (args.ph_hi >> 12) & 1; const int subsel = ((args.ph_hi >> 13) & 3) ? ((args.ph_hi >> 13) & 3) : 3;
    XcdBarrier bar; bar.bar = (unsigned*)(F.ws + WS_CTL) + CW_BAR; bar.x = 0; bar.st = nullptr;
    if (hi - lo > 1) bar = xcd_barrier_post((unsigned*)(F.ws + WS_CTL) + CW_BAR, MISC + 8);
#ifdef DBG_TS
    unsigned long long* tsb = (unsigned long long*)(F.ws + WS_CTL + 512 * 1024);
    if (blockIdx.x == 0 && threadIdx.x == 0) tsb[0] = __builtin_amdgcn_s_memrealtime();
#endif
    for (int ph = lo; ph < hi; ++ph) {
#ifdef DBG_REP
        if ((DBG_REP >> ph) & 1ull) { for (int rr = 0; rr < DBG_REPN; ++rr) { run_phase(F, ph, DBG_REPSUB); __syncthreads(); } }
#endif
        run_phase(F, ph, subsel);
#ifdef DBG_TS
        if (ph == NPH - 2 && blockIdx.x == 0 && threadIdx.x == 0) { asm volatile("s_waitcnt vmcnt(0)" ::: "memory"); tsb[ph + 1] = __builtin_amdgcn_s_memrealtime(); __threadfence(); }
#endif
        if (ph + 1 < hi) { XcdBarrier b2 = bar; asm volatile("" : "+s"(b2.bar), "+s"(b2.x)); xcd_barrier(b2); }
#ifdef DBG_TS
        if (ph < NPH - 2 && blockIdx.x == 0 && threadIdx.x == 0) tsb[ph + 1] = __builtin_amdgcn_s_memrealtime();
#endif
    }
}

#ifndef MK_MULTI
#define MK_MULTI 1
#endif
extern "C" void kernel_launch(void* const* d_in, const int* in_sizes, int n_in, void* d_out, int out_size, void* d_ws, size_t ws_size, hipStream_t stream) {
    static int grid = 0;
    if (grid == 0) {
        if (n_in != 36 || in_sizes[0] != LAT_ROWS * DM || out_size != LAT_ROWS * DM || ws_size < WS_END) {
            fprintf(stderr, "kernel_launch: unexpected shapes: n_in %d in0 %d out %d ws %zu (need >= %zu)\n", n_in, n_in > 0 ? in_sizes[0] : -1, out_size, ws_size, (size_t)WS_END); grid = -1; return; }
        int dev = 0, cus = 0, per_cu = 0;
        if (hipGetDevice(&dev) != hipSuccess || hipDeviceGetAttribute(&cus, hipDeviceAttributeMultiprocessorCount, dev) != hipSuccess) { fprintf(stderr, "kernel_launch: device query failed\n"); grid = -1; return; }
        if (hipFuncSetAttribute((const void*)mega, hipFuncAttributeMaxDynamicSharedMemorySize, LDS_BYTES) != hipSuccess) { fprintf(stderr, "kernel_launch: hipFuncSetAttribute failed\n"); grid = -1; return; }
        if (hipOccupancyMaxActiveBlocksPerMultiprocessor(&per_cu, (const void*)mega, 512, LDS_BYTES) != hipSuccess || per_cu < 1) { fprintf(stderr, "kernel_launch: occupancy query says %d\n", per_cu); per_cu = 1; }
        (void)hipGetLastError();
        grid = cus;
    }
    if (grid < 0) return;
    (void)hipMemsetAsync((char*)d_ws + WS_CTL, 0, CTL_ZERO_BYTES, stream);
    Args a{};
    for (int i = 0; i < 36; ++i) a.in[i] = (const float*)d_in[i];
    a.out = (float*)d_out; a.ws = (unsigned char*)d_ws;
#if MK_MULTI
#ifndef DBG_STOP_PH
#define DBG_STOP_PH (NPH - 2)
#endif
    for (int p = 0; p < NPH; ++p) {
        if (p > DBG_STOP_PH && p != NPH - 1) continue;
#ifdef DBG_CHECKS
        if (p == NPH - 1) { a.ph_lo = 100 + DBG_CHECK_L; a.ph_hi = a.ph_lo + 1; hipLaunchKernelGGL(mega, dim3(grid), dim3(512), LDS_BYTES, stream, a); }
#endif
        a.ph_lo = p; a.ph_hi = p + 1;
#ifdef DBG_NOOPS
        if (p == 5) { a.ph_lo = 61; a.ph_hi = 62; for (int rr = 0; rr < DBG_NOOPS; ++rr) hipLaunchKernelGGL(mega, dim3(grid), dim3(512), LDS_BYTES, stream, a); a.ph_lo = p; a.ph_hi = p + 1; }
#endif
#ifdef DBG_HREP
        if ((DBG_HREP >> p) & 1ull) { a.ph_hi = (p + 1) | 0x1000 | (DBG_HSUB << 13); for (int rr = 0; rr < DBG_HREPN; ++rr) hipLaunchKernelGGL(mega, dim3(grid), dim3(512), LDS_BYTES, stream, a); a.ph_hi = p + 1; }
#endif
        hipLaunchKernelGGL(mega, dim3(grid), dim3(512), LDS_BYTES, stream, a);
    }
#else
    a.ph_lo = 0; a.ph_hi = NPH;
    void* kargs[] = {&a};
    hipError_t e = hipLaunchCooperativeKernel((const void*)mega, dim3(grid), dim3(512), kargs, LDS_BYTES, stream);
    if (e != hipSuccess) fprintf(stderr, "kernel_launch: cooperative launch failed: %s (grid %d)\n", hipGetErrorString(e), grid);
#endif
    const hipError_t le = hipPeekAtLastError();
    if (le != hipSuccess) fprintf(stderr, "kernel_launch: launch failed: %s\n", hipGetErrorName(le));
}
```

```cpp
#include <hip/hip_runtime.h>
#include <cstdio>
#include <cstdint>
#ifndef MK_MULTI
#define MK_MULTI 0
#endif
#define GAS __attribute__((address_space(1)))
#define LAS __attribute__((address_space(3)))
typedef unsigned short bf16;
typedef short bf16x8 __attribute__((ext_vector_type(8)));
typedef short s16x4 __attribute__((ext_vector_type(4)));
typedef float f32x2 __attribute__((ext_vector_type(2)));
typedef float f32x4 __attribute__((ext_vector_type(4)));
typedef float f32x16 __attribute__((ext_vector_type(16)));
typedef unsigned u32x2 __attribute__((ext_vector_type(2)));
typedef unsigned u32x4 __attribute__((ext_vector_type(4)));

constexpr int DM = 1024, NBATCH = 4, SEQ = 4096, CTXL = 256, DEPTH = 4;
constexpr int LAT_ROWS = NBATCH * SEQ;
constexpr int CTX_ROWS = NBATCH * CTXL;
constexpr int TOK = LAT_ROWS + CTX_ROWS;
constexpr int SKV = CTXL + SEQ;
constexpr int NMOD = 6 * DM;
constexpr float RMS_EPS = 1e-6f;
constexpr int NEXP = 32, MOE_FF = 512;
constexpr int LIST_CAP = TOK;

__device__ __forceinline__ unsigned f2bf(float f) { unsigned u = __builtin_bit_cast(unsigned, f); return (u + 0x7fffu + ((u >> 16) & 1u)) >> 16; }
__device__ __forceinline__ unsigned pk2(float lo, float hi) { return f2bf(lo) | (f2bf(hi) << 16); }
__device__ __forceinline__ float bf2f(unsigned short b) { return __builtin_bit_cast(float, ((unsigned)b) << 16); }
__device__ __forceinline__ float bflo(unsigned w) { return __builtin_bit_cast(float, w << 16); }
__device__ __forceinline__ float bfhi(unsigned w) { return __builtin_bit_cast(float, w & 0xffff0000u); }
__device__ __forceinline__ unsigned cvtpk(float lo, float hi) { unsigned r; asm volatile("v_cvt_pk_bf16_f32 %0, %1, %2" : "=v"(r) : "v"(lo), "v"(hi)); return r; }
#define DPP_F(v, ctrl) __builtin_bit_cast(float, __builtin_amdgcn_update_dpp(0, __builtin_bit_cast(int, v), ctrl, 0xf, 0xf, true))
__device__ __forceinline__ float wave_sum(float v) {
    v += DPP_F(v, 0xB1);
    v += DPP_F(v, 0x4E);
    v += DPP_F(v, 0x141);
    v += DPP_F(v, 0x140);
    const int vi = __builtin_bit_cast(int, v);
    return (__builtin_bit_cast(float, __builtin_amdgcn_readlane(vi, 0)) + __builtin_bit_cast(float, __builtin_amdgcn_readlane(vi, 16)))
         + (__builtin_bit_cast(float, __builtin_amdgcn_readlane(vi, 32)) + __builtin_bit_cast(float, __builtin_amdgcn_readlane(vi, 48)));
}
__device__ __forceinline__ float wave_max(float v) {
    v = fmaxf(v, DPP_F(v, 0xB1)); v = fmaxf(v, DPP_F(v, 0x4E)); v = fmaxf(v, DPP_F(v, 0x141)); v = fmaxf(v, DPP_F(v, 0x140));
    const int vi = __builtin_bit_cast(int, v);
    return fmaxf(fmaxf(__builtin_bit_cast(float, __builtin_amdgcn_readlane(vi, 0)), __builtin_bit_cast(float, __builtin_amdgcn_readlane(vi, 16))),
                 fmaxf(__builtin_bit_cast(float, __builtin_amdgcn_readlane(vi, 32)), __builtin_bit_cast(float, __builtin_amdgcn_readlane(vi, 48))));
}
__device__ __forceinline__ float sigmoidf_(float x) { return 1.f / (1.f + __expf(-x)); }
__device__ __forceinline__ float siluf_(float x) { return x * sigmoidf_(x); }
__device__ __forceinline__ float gelu_tanh(float x) {
    const float u = 0.7978845608028654f * (x + 0.044715f * x * x * x);
    const float e = __expf(2.f * u);
    const float t = 1.f - 2.f / (e + 1.f);
    return 0.5f * x * (1.f + t);
}
__device__ __forceinline__ int modrow_of(int row) { return row < LAT_ROWS ? (row >> 12) : 4; }

constexpr size_t MiB = 1u << 20;
constexpr size_t WS_CTL = 0, CTL_ZERO_BYTES = 1 * MiB;
constexpr size_t WS_MOD = 1 * MiB, WS_ROPE = 2 * MiB, WS_GATEW = 3 * MiB, WS_RW = 4 * MiB, WS_RC = 5 * MiB, WS_LIST = 9 * MiB;
constexpr size_t WS_W_IN = 12 * MiB, WS_W_OUTE = 16 * MiB, WS_W_GLU = 20 * MiB, WS_W_MLA = 21 * MiB, WS_W_QKV = 23 * MiB, WS_W_OUTO = 31 * MiB;
constexpr size_t WS_W_GU = 35 * MiB, WS_W_DN = 291 * MiB;
constexpr size_t WS_XRES = 419 * MiB, WS_H = 487 * MiB, WS_MIX = 521 * MiB;
constexpr size_t WS_ZRAW = 555 * MiB, WS_ACAT = 623 * MiB, WS_QKVM = 640 * MiB, WS_QB = 700 * MiB, WS_KB = 734 * MiB, WS_VB = 768 * MiB, WS_GG = 785 * MiB;
constexpr size_t WS_ACT = 555 * MiB, WS_YDN = 589 * MiB;
constexpr size_t WS_E2 = 802 * MiB;
constexpr size_t WS_S5TAB = 812 * MiB;
constexpr size_t WS_END = 814 * MiB;
constexpr int CW_BAR = 4096, CW_CNT = 16384;
constexpr int CW_READY = 65536, READY_L = 32 * 68 * 16;
constexpr int ROPE32_OFF = 64 * 32 * 2;
constexpr size_t WS_RT = WS_ROPE + 128 * 1024;

constexpr int RING_BYTES = 131072, LDS_BYTES = 152576, MISC_OFF = LDS_BYTES - 3072;


namespace pg8 {
constexpr int BM = 256, BK = 64, HALF = 128, HTB = HALF * BK * 2, STAGE_BYTES = 8 * HTB, NXCD = 8, WGM = 8;
__host__ __device__ __forceinline__ int lds_byte(int r, int c) { const int st = (r >> 4) * 2 + (c >> 5), rr = r & 15, cc = c & 31, ob = rr * 64 + cc * 2; return st * 1024 + (ob ^ (((ob >> 9) & 1) << 5)); }
__host__ __device__ __forceinline__ void stage_rc(int b, int& R, int& C) { const int st = b / 1024, sb = b % 1024, swz = sb ^ (((sb >> 9) & 1) << 5); R = (st >> 1) * 16 + swz / 64; C = (st & 1) * 32 + (swz % 64) / 2; }
__host__ __device__ __forceinline__ int perm32(int rho) { const int n = rho >> 4, i = rho & 15; return 8 * (i >> 2) + 4 * n + (i & 3); }

struct Unit { int pm, pn, e, rows; };

enum { EPI_BF16 = 0, EPI_GLU = 1, EPI_RESID = 2, EPI_MOE1 = 3, EPI_MOE2 = 4 };
enum { G_INPROJ = 0, G_MLA = 1, G_GLU = 2, G_OUT = 3, G_QKV = 4, G_MOE1 = 5, G_MOE2 = 6 };

template <int GID> struct Cfg;
template <> struct Cfg<G_INPROJ> { static constexpr int lda = 1024, ldb = 1024, K = 1024, nN = 4, moe = 0, epi = EPI_BF16, ldo = 1024, acol_split = 1 << 30, acol_off = 0; };
template <> struct Cfg<G_MLA>    { static constexpr int lda = 512,  ldb = 256,  K = 256,  nN = 7, moe = 0, epi = EPI_BF16, ldo = 1792, acol_split = 3, acol_off = 256; };
template <> struct Cfg<G_GLU>    { static constexpr int lda = 512,  ldb = 512,  K = 512,  nN = 2, moe = 0, epi = EPI_GLU,  ldo = 1024, acol_split = 1 << 30, acol_off = 0; };
template <> struct Cfg<G_OUT>    { static constexpr int lda = 1024, ldb = 1024, K = 1024, nN = 4, moe = 0, epi = EPI_RESID, ldo = 1024, acol_split = 1 << 30, acol_off = 0; };
template <> struct Cfg<G_QKV>    { static constexpr int lda = 1024, ldb = 1024, K = 1024, nN = 8, moe = 0, epi = EPI_BF16, ldo = 2048, acol_split = 1 << 30, acol_off = 0; };
template <> struct Cfg<G_MOE1>   { static constexpr int lda = 1024, ldb = 1024, K = 1024, nN = 4, moe = 1, epi = EPI_MOE1, ldo = 512, acol_split = 1 << 30, acol_off = 0; };
template <> struct Cfg<G_MOE2>   { static constexpr int lda = 512,  ldb = 512,  K = 512,  nN = 4, moe = 2, epi = EPI_MOE2, ldo = 1024, acol_split = 1 << 30, acol_off = 0; };

template <int GID> struct Prob {
    static constexpr int lda = Cfg<GID>::lda, ldb = Cfg<GID>::ldb, K = Cfg<GID>::K, nN = Cfg<GID>::nN, moe = Cfg<GID>::moe, epi = Cfg<GID>::epi, ldo = Cfg<GID>::ldo;
    static constexpr int acol_split = Cfg<GID>::acol_split, acol_off = Cfg<GID>::acol_off, nM = TOK / 256;
    static constexpr size_t bstride = (size_t)1024 * K * 2;
    const char* A; const char* B;
    int G, c;
    const int* list; const unsigned* cnt; const LAS int* tp;
    int l; unsigned char* ws;
    bf16* O;
    unsigned* ready;
    const float* xlat; const float* xctx;

    __device__ __forceinline__ bool next(int i, Unit& u) const {
        const long L = (long)i * G + c;
        if constexpr (moe == 0) {
            const int nMe = (GID == G_INPROJ || GID == G_OUT || GID == G_QKV) ? LAT_ROWS / 256 : nM;
            const int nwg = nMe * nN; if (L >= nwg) return false;
            int wgid = (int)L; { const int q = nwg / NXCD, r = nwg % NXCD, xcd = wgid % NXCD, off = wgid / NXCD; wgid = (xcd < r ? xcd * (q + 1) : r * (q + 1) + (xcd - r) * q) + off; }
            const int nig = WGM * nN, gid = wgid / nig, fm = gid * WGM, gsz = (nMe - fm) < WGM ? (nMe - fm) : WGM;
            u.pm = fm + ((wgid % nig) % gsz); u.pn = (wgid % nig) / gsz; u.e = 0; u.rows = 256; return true;
        } else {
            const int x = c & 7, per = G >> 3, j = (moe == 2) ? per - 1 - (c >> 3) : (c >> 3);
            int uidx = i * per + j;
#pragma unroll
            for (int k = 0; k < NEXP / 8; ++k) { const int e = x + 8 * k; const int nt_e = tp[e + 1] - tp[e]; const int nu = nt_e * nN;
                if (uidx < nu) { u.e = e; u.pm = uidx / nN; u.pn = uidx % nN; const int left = (int)cnt[e] - 256 * u.pm; u.rows = left < 256 ? left : 256; return true; }
                uidx -= nu; }
            return false;
        }
    }
    __device__ __forceinline__ void done(const Unit& u, const int tid) const {
        if constexpr (moe == 1) { asm volatile("s_waitcnt vmcnt(0)" ::: "memory");
            if ((tid & 63) == 0) __hip_atomic_fetch_add(ready + (u.e * 68 + u.pm) * 16, 1u, __ATOMIC_RELAXED, __HIP_MEMORY_SCOPE_AGENT); }
    }
    __device__ __forceinline__ void a_ready(const Unit& u, const int tid) const {
        if constexpr (moe == 2) {
            if (tid < 64) {
                const unsigned* w = ready + (u.e * 68 + u.pm) * 16;
                for (unsigned n = 0; n < 2000000u; ++n) {
                    if ((unsigned)__builtin_amdgcn_readfirstlane(__hip_atomic_load(w, __ATOMIC_RELAXED, __HIP_MEMORY_SCOPE_AGENT)) >= 32u) break;
                    __builtin_amdgcn_s_sleep(2); }
            }
            asm volatile("" ::: "memory"); __builtin_amdgcn_s_barrier(); asm volatile("" ::: "memory");
        }
    }
    __device__ __forceinline__ const char* abase(const Unit& u) const {
        if constexpr (moe == 0) return A + ((size_t)u.pm * 256 * lda + (u.pn >= acol_split ? acol_off : 0)) * 2;
        else return A;
    }
    __device__ __forceinline__ unsigned aoff(const Unit& u, int R, int C) const {
        if constexpr (moe == 0) return (unsigned)((R * lda + C) * 2);
        else {
        const int rr = R < u.rows ? R : 0;
        const int ent = list[(size_t)u.e * LIST_CAP + u.pm * 256 + rr];
        const int arow = (moe == 1) ? (ent >> 1) : ent;
        return (unsigned)(((size_t)arow * lda + C) * 2u); }
    }
    __device__ __forceinline__ const char* bbase(const Unit& u) const { return B + (size_t)u.e * bstride + (size_t)u.pn * 256 * ldb * 2; }

    __device__ __forceinline__ void epilogue(const f32x4 (&acc)[2][2][4][2], const Unit& u, int wr, int wc, int fr, int fq) const {
        const int cw = wc * 32 + 8 * fq;
        if constexpr (epi == EPI_BF16) {
#pragma unroll
            for (int ai = 0; ai < 2; ++ai)
#pragma unroll
                for (int m = 0; m < 4; ++m) { const int row = u.pm * 256 + ai * 128 + wr * 64 + m * 16 + fr; bf16* rowp = O + (size_t)row * ldo + u.pn * 256 + cw;
#pragma unroll
                    for (int bj = 0; bj < 2; ++bj) { const f32x4 v0 = acc[ai][bj][m][0], v1 = acc[ai][bj][m][1];
                        u32x4 w; w.x = cvtpk(v0[0], v0[1]); w.y = cvtpk(v0[2], v0[3]); w.z = cvtpk(v1[0], v1[1]); w.w = cvtpk(v1[2], v1[3]);
                        *(u32x4*)(rowp + bj * 128) = w; } }
        } else if constexpr (epi == EPI_GLU) {
#pragma unroll
            for (int ai = 0; ai < 2; ++ai)
#pragma unroll
                for (int m = 0; m < 4; ++m) { const int row = u.pm * 256 + ai * 128 + wr * 64 + m * 16 + fr;
#pragma unroll
                    for (int bj = 0; bj < 2; ++bj) { const int col = u.pn * 256 + bj * 128 + cw;
                        const u32x4 gv = *(const u32x4*)((const bf16*)(ws + WS_GG) + (size_t)row * 512 + col);
                        const f32x4 v0 = acc[ai][bj][m][0], v1 = acc[ai][bj][m][1];
                        u32x4 w;
                        w.x = cvtpk(bflo(gv.x) * sigmoidf_(v0[0]), bfhi(gv.x) * sigmoidf_(v0[1]));
                        w.y = cvtpk(bflo(gv.y) * sigmoidf_(v0[2]), bfhi(gv.y) * sigmoidf_(v0[3]));
                        w.z = cvtpk(bflo(gv.z) * sigmoidf_(v1[0]), bfhi(gv.z) * sigmoidf_(v1[1]));
                        w.w = cvtpk(bflo(gv.w) * sigmoidf_(v1[2]), bfhi(gv.w) * sigmoidf_(v1[3]));
                        *(u32x4*)((bf16*)(ws + WS_MIX) + (size_t)row * 1024 + col) = w; } }
        } else if constexpr (epi == EPI_RESID) {
            const float* gate = (const float*)(ws + WS_MOD) + (size_t)l * 5 * NMOD + 2 * DM; bf16* xout = (bf16*)(ws + WS_XRES);
#pragma unroll
            for (int ai = 0; ai < 2; ++ai)
#pragma unroll
                for (int m = 0; m < 4; ++m) { const int row = u.pm * 256 + ai * 128 + wr * 64 + m * 16 + fr;
                    const float* gr = gate + (size_t)modrow_of(row) * NMOD;
#pragma unroll
                    for (int bj = 0; bj < 2; ++bj) { const int col = u.pn * 256 + bj * 128 + cw;
                        float xv[8];
                        if (l == 0) { const float* xs = row < LAT_ROWS ? xlat + (size_t)row * DM : xctx + (size_t)(row - LAT_ROWS) * DM;
                            const f32x4 a0 = *(const f32x4*)(xs + col), a1 = *(const f32x4*)(xs + col + 4);
                            xv[0] = a0[0]; xv[1] = a0[1]; xv[2] = a0[2]; xv[3] = a0[3]; xv[4] = a1[0]; xv[5] = a1[1]; xv[6] = a1[2]; xv[7] = a1[3]; }
                        else { const u32x4 w = *(const u32x4*)(xout + (size_t)row * DM + col);
                            xv[0] = bflo(w.x); xv[1] = bfhi(w.x); xv[2] = bflo(w.y); xv[3] = bfhi(w.y); xv[4] = bflo(w.z); xv[5] = bfhi(w.z); xv[6] = bflo(w.w); xv[7] = bfhi(w.w); }
                        const f32x4 g0 = *(const f32x4*)(gr + col), g1 = *(const f32x4*)(gr + col + 4);
                        const f32x4 c0 = acc[ai][bj][m][0], c1 = acc[ai][bj][m][1];
#ifdef DBG_NOMIX
                        u32x4 o; o.x = cvtpk(xv[0], xv[1]); o.y = cvtpk(xv[2], xv[3]); o.z = cvtpk(xv[4], xv[5]); o.w = cvtpk(xv[6], xv[7]);
#else
                        u32x4 o; o.x = cvtpk(xv[0] + g0[0] * c0[0], xv[1] + g0[1] * c0[1]); o.y = cvtpk(xv[2] + g0[2] * c0[2], xv[3] + g0[3] * c0[3]);
                        o.z = cvtpk(xv[4] + g1[0] * c1[0], xv[5] + g1[1] * c1[1]); o.w = cvtpk(xv[6] + g1[2] * c1[2], xv[7] + g1[3] * c1[3]);
#endif
                        *(u32x4*)(xout + (size_t)row * DM + col) = o; } }
        } else if constexpr (epi == EPI_MOE1) {
#pragma unroll
            for (int ai = 0; ai < 2; ++ai)
#pragma unroll
                for (int m = 0; m < 4; ++m) { const int rt = ai * 128 + wr * 64 + m * 16 + fr;
                    if (rt < u.rows) { const int ent = list[(size_t)u.e * LIST_CAP + u.pm * 256 + rt];
                        const f32x4 g0 = acc[ai][0][m][0], g1 = acc[ai][0][m][1], u0 = acc[ai][1][m][0], u1 = acc[ai][1][m][1];
                        u32x4 w;
                        w.x = cvtpk(siluf_(g0[0]) * u0[0], siluf_(g0[1]) * u0[1]); w.y = cvtpk(siluf_(g0[2]) * u0[2], siluf_(g0[3]) * u0[3]);
                        w.z = cvtpk(siluf_(g1[0]) * u1[0], siluf_(g1[1]) * u1[1]); w.w = cvtpk(siluf_(g1[2]) * u1[2], siluf_(g1[3]) * u1[3]);
                        asm volatile("global_store_dwordx4 %0, %1, off sc1" :: "v"((bf16*)(ws + WS_ACT) + (size_t)ent * MOE_FF + u.pn * 128 + cw), "v"(w) : "memory"); } }
        } else {
            const float* gatew = (const float*)(ws + WS_GATEW);
#pragma unroll
            for (int ai = 0; ai < 2; ++ai)
#pragma unroll
                for (int m = 0; m < 4; ++m) { const int rt = ai * 128 + wr * 64 + m * 16 + fr;
                    if (rt < u.rows) { const int ent = list[(size_t)u.e * LIST_CAP + u.pm * 256 + rt]; const float gw = gatew[ent];
#pragma unroll
                        for (int bj = 0; bj < 2; ++bj) { const f32x4 v0 = acc[ai][bj][m][0] * gw, v1 = acc[ai][bj][m][1] * gw;
                            u32x4 w; w.x = cvtpk(v0[0], v0[1]); w.y = cvtpk(v0[2], v0[3]); w.z = cvtpk(v1[0], v1[1]); w.w = cvtpk(v1[2], v1[3]);
                            *(u32x4*)((bf16*)(ws + WS_YDN) + (size_t)ent * DM + u.pn * 256 + bj * 128 + cw) = w; } } }
        }
    }
};

template <int GID>
__device__ __forceinline__ void gemm_phase(LAS unsigned char* lds, const Prob<GID>& P, const int tid) {
    const int  wid = __builtin_amdgcn_readfirstlane(tid >> 6), lane = tid & 63, wr = wid >> 2, wc = wid & 3, fr = lane & 15, fq = lane >> 4;
    constexpr int K = Prob<GID>::K, nt = K / BK;
    unsigned voffB[2];
#pragma unroll
    for (int i = 0; i < 2; ++i) { int R, C; stage_rc(tid * 16 + i * 8192, R, C); const int Rb = (R & ~31) + perm32(R & 31);
        voffB[i] = (unsigned)(Rb * P.ldb + C) * 2u; }
#define PG8_AOFFS(vo, unit) do { _Pragma("unroll") for (int _h = 0; _h < 2; ++_h) _Pragma("unroll") for (int _i = 0; _i < 2; ++_i) { int _R, _C; stage_rc(tid * 16 + _i * 8192, _R, _C); \
        (vo)[_h][_i] = P.aoff(unit, _R + 128 * _h, _C); } } while (0)
    const size_t kstep = (size_t)(BK * 2);
    const size_t hstepB = (size_t)HALF * P.ldb * 2;
    const unsigned ldsw = (unsigned)wid * 1024u;
    const int aoff = lds_byte(wr * 64 + fr, fq * 8), boff = lds_byte(wc * 32 + fr, fq * 8);
#define PG8_SA(b, h) (((b) * 2 + (h)) * HTB)
#define PG8_SB(b, h) ((4 + (b) * 2 + (h)) * HTB)
#define PG8_STAGEB(bufoff, gbase) do { _Pragma("unroll") for (int _i = 0; _i < 2; ++_i) \
        __builtin_amdgcn_global_load_lds((const unsigned*)((const char*)(gbase) + voffB[_i]), (LAS unsigned*)(lds + (bufoff) + ldsw + _i * 8192), 16, 0, 0); } while (0)
#define PG8_STAGEA(bufoff, gbase, h) do { _Pragma("unroll") for (int _i = 0; _i < 2; ++_i) \
        __builtin_amdgcn_global_load_lds((const unsigned*)((const char*)(gbase) + vA[h][_i]), (LAS unsigned*)(lds + (bufoff) + ldsw + _i * 8192), 16, 0, Prob<GID>::moe == 2 ? 16 : 0); } while (0)
#define PG8_LDA(dst, b, h) do { _Pragma("unroll") for (int m = 0; m < 4; ++m) _Pragma("unroll") for (int k = 0; k < 2; ++k) dst[m][k] = *(const LAS bf16x8*)(lds + PG8_SA(b, h) + aoff + m * 2048 + k * 1024); } while (0)
#define PG8_LDB(dst, b, h) do { _Pragma("unroll") for (int n = 0; n < 2; ++n) _Pragma("unroll") for (int k = 0; k < 2; ++k) dst[n][k] = *(const LAS bf16x8*)(lds + PG8_SB(b, h) + boff + n * 2048 + k * 1024); } while (0)
#define PG8_MMA(ai, bj, At, Bt) do { __builtin_amdgcn_s_setprio(1); _Pragma("unroll") for (int m = 0; m < 4; ++m) _Pragma("unroll") for (int n = 0; n < 2; ++n) _Pragma("unroll") for (int k = 0; k < 2; ++k) \
        acc[ai][bj][m][n] = __builtin_amdgcn_mfma_f32_16x16x32_bf16(Bt[n][k], At[m][k], acc[ai][bj][m][n], 0, 0, 0); __builtin_amdgcn_s_setprio(0); } while (0)
#define PG8_WAIT_V(n) asm volatile("s_waitcnt vmcnt(" #n ")" ::: "memory")
#define PG8_WAIT_L(n) asm volatile("s_waitcnt lgkmcnt(" #n ")" ::: "memory")
#define PG8_BAR __builtin_amdgcn_s_barrier()
#define PG8_SCHED __builtin_amdgcn_sched_barrier(0)
    Unit cur, nxt; int ui = 0;
    if (!P.next(0, cur)) return;
    f32x4 acc[2][2][4][2];
#pragma unroll
    for (int a = 0; a < 2; ++a)
#pragma unroll
        for (int b = 0; b < 2; ++b)
#pragma unroll
            for (int m = 0; m < 4; ++m)
#pragma unroll
                for (int n = 0; n < 2; ++n) acc[a][b][m][n] = (f32x4){0.f, 0.f, 0.f, 0.f};
    bf16x8 At[4][2], B0[2][2], B1[2][2];
    unsigned vA[2][2];
    PG8_AOFFS(vA, cur);
    const char* cA = P.abase(cur); const char* cB = P.bbase(cur);
    P.a_ready(cur, tid);
    PG8_STAGEB(PG8_SB(0, 0), cB); PG8_STAGEB(PG8_SB(0, 1), cB + hstepB); PG8_STAGEA(PG8_SA(0, 0), cA, 0); PG8_STAGEA(PG8_SA(0, 1), cA, 1);
    if (wr == 1) PG8_BAR;
    PG8_WAIT_V(2); PG8_BAR;
    PG8_STAGEB(PG8_SB(1, 0), cB + kstep); PG8_STAGEA(PG8_SA(1, 0), cA + kstep, 0); PG8_STAGEB(PG8_SB(1, 1), cB + hstepB + kstep);
    PG8_WAIT_V(6); PG8_BAR;
    for (;;) {
        const bool has_next = P.next(ui + 1, nxt);
        const char* nA = has_next ? P.abase(nxt) : cA; const char* nB = has_next ? P.bbase(nxt) : cB;
#pragma nounroll
        for (int t = 0; t < nt; t += 2) {
            const bool last = (t == nt - 2);
            const char* a1 = cA + (size_t)(t + 1) * kstep;
            const char* a2 = last ? nA : cA + (size_t)(t + 2) * kstep; const char* b2 = last ? nB : cB + (size_t)(t + 2) * kstep;
            const char* a3 = a2 + kstep; const char* b3 = b2 + kstep;
            if (Prob<GID>::moe == 2 && last && has_next) P.a_ready(nxt, tid);
            PG8_LDB(B0, 0, 0); PG8_LDB(B1, 0, 1); PG8_SCHED; PG8_LDA(At, 0, 0); PG8_STAGEA(PG8_SA(1, 1), a1, 1);
            if (Prob<GID>::moe != 0 && last && has_next) { PG8_AOFFS(vA, nxt); }
            PG8_WAIT_V(8); PG8_WAIT_L(0); PG8_BAR; PG8_MMA(0, 0, At, B0); PG8_MMA(0, 1, At, B1); PG8_BAR; PG8_SCHED;
            PG8_LDA(At, 0, 1); PG8_STAGEB(PG8_SB(0, 0), b2); PG8_STAGEB(PG8_SB(0, 1), b2 + hstepB); PG8_STAGEA(PG8_SA(0, 0), a2, 0);
            PG8_WAIT_V(8); PG8_WAIT_L(0); PG8_BAR; PG8_MMA(1, 0, At, B0); PG8_MMA(1, 1, At, B1); PG8_BAR; PG8_SCHED;
            PG8_LDB(B0, 1, 0); PG8_LDB(B1, 1, 1); PG8_SCHED; PG8_LDA(At, 1, 0); PG8_STAGEA(PG8_SA(0, 1), a2, 1);
            PG8_WAIT_V(8); PG8_WAIT_L(0); PG8_BAR; PG8_MMA(0, 0, At, B0); PG8_MMA(0, 1, At, B1); PG8_BAR; PG8_SCHED;
            PG8_LDA(At, 1, 1); PG8_STAGEB(PG8_SB(1, 0), b3); PG8_STAGEB(PG8_SB(1, 1), b3 + hstepB); PG8_STAGEA(PG8_SA(1, 0), a3, 0);
            PG8_WAIT_V(8); PG8_WAIT_L(0); PG8_BAR; PG8_MMA(1, 0, At, B0); PG8_MMA(1, 1, At, B1); PG8_BAR; PG8_SCHED;
        }
        if (wr == 0) PG8_BAR;
        P.epilogue(acc, cur, wr, wc, fr, fq);
        P.done(cur, tid);
        if (!has_next) break;
#pragma unroll
        for (int a = 0; a < 2; ++a)
#pragma unroll
            for (int b = 0; b < 2; ++b)
#pragma unroll
                for (int m = 0; m < 4; ++m)
#pragma unroll
                    for (int n = 0; n < 2; ++n) acc[a][b][m][n] = (f32x4){0.f, 0.f, 0.f, 0.f};
        cur = nxt; cA = nA; cB = nB; ++ui;
        if (wr == 1) PG8_BAR;
    }
    PG8_WAIT_V(0);
    PG8_BAR;
#undef PG8_SA
#undef PG8_SB
#undef PG8_STAGEA
#undef PG8_AOFFS
#undef PG8_STAGEB
#undef PG8_LDA
#undef PG8_LDB
#undef PG8_MMA
#undef PG8_WAIT_V
#undef PG8_WAIT_L
#undef PG8_BAR
#undef PG8_SCHED
}

template <int GID>
__device__ __forceinline__ void ctx_gemm(LAS unsigned char* lds, const Prob<GID>& P, const int tid) {
    static_assert(Prob<GID>::K == 1024 && Prob<GID>::lda == 1024 && Prob<GID>::ldb == 1024 && Prob<GID>::moe == 0, "ctx_gemm: K = 1024 dense only");
    constexpr int NPASS = Prob<GID>::nN / 4, PSTR = 272, PW = 64 * PSTR, epi = Prob<GID>::epi, ldo = Prob<GID>::ldo;
    const int wid = __builtin_amdgcn_readfirstlane(tid >> 6), lane = tid & 63, fr = lane & 15, fq = lane >> 4;
    const int mt = P.c >> 4;
    const char* Ap = P.A + ((size_t)(LAT_ROWS + mt * 64 + fr) * 1024 + wid * 128 + fq * 8) * 2;
#pragma nounroll
#ifdef DBG_CTX2
    for (int pass_ = 0; pass_ < 2 * NPASS; ++pass_) { const int pass = pass_ % NPASS;
#else
    for (int pass = 0; pass < NPASS; ++pass) {
#endif
        const int ntile = (P.c & 15) + 16 * pass;
        const char* Bp = P.B + ((size_t)(ntile * 64 + fr) * 1024 + wid * 128 + fq * 8) * 2;
        f32x4 acc[4][4];
#pragma unroll
        for (int mi = 0; mi < 4; ++mi)
#pragma unroll
            for (int ni = 0; ni < 4; ++ni) acc[mi][ni] = (f32x4){0.f, 0.f, 0.f, 0.f};
        bf16x8 af[4][4], bf[4][4];
#pragma unroll
        for (int ks = 0; ks < 4; ++ks)
#pragma unroll
            for (int mi = 0; mi < 4; ++mi) { af[ks][mi] = *(const bf16x8*)(Ap + mi * 16 * 2048 + ks * 64); bf[ks][mi] = *(const bf16x8*)(Bp + mi * 16 * 2048 + ks * 64); }
        __builtin_amdgcn_sched_barrier(0);
#pragma unroll
        for (int ks = 0; ks < 4; ++ks)
#pragma unroll
            for (int mi = 0; mi < 4; ++mi)
#pragma unroll
                for (int ni = 0; ni < 4; ++ni) acc[mi][ni] = __builtin_amdgcn_mfma_f32_16x16x32_bf16(bf[ks][ni], af[ks][mi], acc[mi][ni], 0, 0, 0);
        __syncthreads();
#pragma unroll
        for (int mi = 0; mi < 4; ++mi)
#pragma unroll
            for (int ni = 0; ni < 4; ++ni) *(LAS f32x4*)(lds + wid * PW + (mi * 16 + fr) * PSTR + (ni * 16 + 4 * fq) * 4) = acc[mi][ni];
        __syncthreads();
        const int m = tid >> 3, c8 = (tid & 7) * 8;
        f32x4 s0 = (f32x4){0.f, 0.f, 0.f, 0.f}, s1 = s0;
#pragma unroll
        for (int w = 0; w < 8; ++w) { s0 += *(const LAS f32x4*)(lds + w * PW + m * PSTR + c8 * 4); s1 += *(const LAS f32x4*)(lds + w * PW + m * PSTR + c8 * 4 + 16); }
        const int row = LAT_ROWS + mt * 64 + m, col = ntile * 64 + c8;
        if constexpr (epi == EPI_BF16) {
            u32x4 w; w.x = cvtpk(s0[0], s0[1]); w.y = cvtpk(s0[2], s0[3]); w.z = cvtpk(s1[0], s1[1]); w.w = cvtpk(s1[2], s1[3]);
            *(u32x4*)(P.O + (size_t)row * ldo + col) = w;
        } else {
            static_assert(epi == EPI_RESID, "ctx_gemm: epilogue");
            const float* gr = (const float*)(P.ws + WS_MOD) + (size_t)P.l * 5 * NMOD + 2 * DM + (size_t)modrow_of(row) * NMOD; bf16* xout = (bf16*)(P.ws + WS_XRES);
            float xv[8];
            if (P.l == 0) { const float* xs = P.xctx + (size_t)(row - LAT_ROWS) * DM;
                const f32x4 a0 = *(const f32x4*)(xs + col), a1 = *(const f32x4*)(xs + col + 4);
                xv[0] = a0[0]; xv[1] = a0[1]; xv[2] = a0[2]; xv[3] = a0[3]; xv[4] = a1[0]; xv[5] = a1[1]; xv[6] = a1[2]; xv[7] = a1[3]; }
            else { const u32x4 w = *(const u32x4*)(xout + (size_t)row * DM + col);
                xv[0] = bflo(w.x); xv[1] = bfhi(w.x); xv[2] = bflo(w.y); xv[3] = bfhi(w.y); xv[4] = bflo(w.z); xv[5] = bfhi(w.z); xv[6] = bflo(w.w); xv[7] = bfhi(w.w); }
            const f32x4 g0 = *(const f32x4*)(gr + col), g1 = *(const f32x4*)(gr + col + 4);
            u32x4 o; o.x = cvtpk(xv[0] + g0[0] * s0[0], xv[1] + g0[1] * s0[1]); o.y = cvtpk(xv[2] + g0[2] * s0[2], xv[3] + g0[3] * s0[3]);
            o.z = cvtpk(xv[4] + g1[0] * s1[0], xv[5] + g1[1] * s1[1]); o.w = cvtpk(xv[6] + g1[2] * s1[2], xv[7] + g1[3] * s1[3]);
            *(u32x4*)(xout + (size_t)row * DM + col) = o;
        }
    }
}
}
namespace att {
constexpr int D = 128, NW = 8, QBLK = 32, KVBLK = 64;
constexpr float THR = 8.f;
constexpr int SHM_V = KVBLK * 128 * 2, SHM_K = KVBLK * D * 2, SHM_ATTN = 2 * SHM_V + 2 * SHM_K + NW * 64 * 4;
#define KSWZ(row, colB) ((row) * 256 + ((colB) ^ (((row) & 7) << 4)))
#define SBAR() __builtin_amdgcn_sched_barrier(0)
__device__ __forceinline__ int crow(int r, int hi) { return (r & 3) + 8 * (r >> 2) + 4 * hi; }

template <int SC> struct ScaleOf { static constexpr float v = SC == 0 ? 0.088388347648318440f   : 0.102062072615965750f  ; };

template <int SC>
__device__ __forceinline__ void partialSM(f32x16& p0, f32x16& p1, float& m_reg, float& mn, float& alpha) {
  constexpr float SCALE = ScaleOf<SC>::v;
  constexpr float C = SCALE * 1.4426950408889634f;
  float pmax = p0[0];
#pragma unroll
  for (int r = 1; r < 16; ++r) pmax = fmaxf(pmax, p0[r]);
#pragma unroll
  for (int r = 0; r < 16; ++r) pmax = fmaxf(pmax, p1[r]);
  { auto rr = __builtin_amdgcn_permlane32_swap(__float_as_uint(pmax), __float_as_uint(pmax), false, false);
    pmax = fmaxf(__uint_as_float(rr[0]), __uint_as_float(rr[1])); }
  if (__builtin_expect(__all(pmax - m_reg <= THR / SCALE), 1)) { mn = m_reg; alpha = 1.f; }
  else { mn = fmaxf(m_reg, pmax); alpha = __builtin_amdgcn_exp2f((m_reg - mn) * C); m_reg = mn; }
  float mnC = -mn * C;
#pragma unroll
  for (int r = 0; r < 16; ++r) p0[r] = fmaf(p0[r], C, mnC);
#pragma unroll
  for (int r = 0; r < 16; ++r) p1[r] = fmaf(p1[r], C, mnC);
#pragma unroll
  for (int r = 0; r < 16; ++r) p0[r] = __builtin_amdgcn_exp2f(p0[r]);
}
__device__ __forceinline__ void finishSM(f32x16& p0, f32x16& p1, float alpha, float& l_reg, bf16x8& pa0, bf16x8& pa1, bf16x8& pa2, bf16x8& pa3) {
#pragma unroll
  for (int r = 0; r < 16; ++r) p1[r] = __builtin_amdgcn_exp2f(p1[r]);
  float ps = 0;
#pragma unroll
  for (int r = 0; r < 16; ++r) ps += p0[r];
#pragma unroll
  for (int r = 0; r < 16; ++r) ps += p1[r];
  { auto rr = __builtin_amdgcn_permlane32_swap(__float_as_uint(ps), __float_as_uint(ps), false, false);
    ps = __uint_as_float(rr[0]) + __uint_as_float(rr[1]); }
  l_reg = l_reg * alpha + ps;
#define PK4(P, BASE, OUT) do { unsigned a0 = cvtpk(P[BASE + 0], P[BASE + 1]), a1 = cvtpk(P[BASE + 2], P[BASE + 3]);   \
    unsigned b0 = cvtpk(P[BASE + 4], P[BASE + 5]), b1 = cvtpk(P[BASE + 6], P[BASE + 7]);                              \
    auto r0 = __builtin_amdgcn_permlane32_swap(a0, b0, false, false); auto r1 = __builtin_amdgcn_permlane32_swap(a1, b1, false, false); \
    u32x4 w = {r0[0], r1[0], r0[1], r1[1]}; OUT = *reinterpret_cast<bf16x8*>(&w); } while (0)
  PK4(p0, 0, pa0); PK4(p0, 8, pa1); PK4(p1, 0, pa2); PK4(p1, 8, pa3);
#undef PK4
}
template <int NKS>
__device__ __forceinline__ void qkt(f32x16& p0, f32x16& p1, const bf16* Ks, const bf16x8* qr, int r32, int hi) {
  p0 = f32x16{}; p1 = f32x16{};
#pragma unroll
  for (int d0 = 0; d0 < NKS; ++d0) { int cb = (d0 * 16 + hi * 8) * 2;
    bf16x8 b0 = *reinterpret_cast<const bf16x8*>((const char*)Ks + KSWZ(r32, cb));
    bf16x8 b1 = *reinterpret_cast<const bf16x8*>((const char*)Ks + KSWZ(32 + r32, cb));
    p0 = __builtin_amdgcn_mfma_f32_32x32x16_bf16(b0, qr[d0], p0, 0, 0, 0);
    p1 = __builtin_amdgcn_mfma_f32_32x32x16_bf16(b1, qr[d0], p1, 0, 0, 0); }
}
__device__ __forceinline__ int v_st(int k, int c) { const int kk = (k & ~0xC) | ((k & 4) << 1) | ((k & 8) >> 1); return ((kk >> 3) * 4 + (c >> 5)) * 512 + ((kk & 7) * 32 + (c & 31)) * 2; }
__device__ __forceinline__ int v_rd_base(int lane) { return ((lane & 3) << 3) | (((lane >> 2) & 3) << 6) | (((lane >> 4) & 1) << 5) | (((lane >> 5) & 1) << 8); }
constexpr int v_rd_off(int d0, int ks, int half) { return d0 * 512 + ks * 4096 + half * 2048; }
template <int OFF> __device__ __forceinline__ s16x4 tr_read(int vb) {
  s16x4 r; asm volatile("ds_read_b64_tr_b16 %0, %1 offset:%2" : "=&v"(r) : "v"(vb), "i"(OFF) : "memory"); return r;
}
template <int D0> __device__ __forceinline__ void pv_one(f32x16& od, int vb, bf16x8 pa0, bf16x8 pa1, bf16x8 pa2, bf16x8 pa3) {
  const s16x4 l0 = tr_read<v_rd_off(D0, 0, 0)>(vb), h0 = tr_read<v_rd_off(D0, 0, 1)>(vb), l1 = tr_read<v_rd_off(D0, 1, 0)>(vb), h1 = tr_read<v_rd_off(D0, 1, 1)>(vb);
  const s16x4 l2 = tr_read<v_rd_off(D0, 2, 0)>(vb), h2 = tr_read<v_rd_off(D0, 2, 1)>(vb), l3 = tr_read<v_rd_off(D0, 3, 0)>(vb), h3 = tr_read<v_rd_off(D0, 3, 1)>(vb);
  asm volatile("s_waitcnt lgkmcnt(0)" ::: "memory"); SBAR();
#define PK(L, H) (bf16x8){L[0], L[1], L[2], L[3], H[0], H[1], H[2], H[3]}
  od = __builtin_amdgcn_mfma_f32_32x32x16_bf16(pa0, PK(l0, h0), od, 0, 0, 0);
  od = __builtin_amdgcn_mfma_f32_32x32x16_bf16(pa1, PK(l1, h1), od, 0, 0, 0);
  od = __builtin_amdgcn_mfma_f32_32x32x16_bf16(pa2, PK(l2, h2), od, 0, 0, 0);
  od = __builtin_amdgcn_mfma_f32_32x32x16_bf16(pa3, PK(l3, h3), od, 0, 0, 0);
#undef PK
}
template <int DV> __device__ __forceinline__ void pv_d0(f32x16* o, int vb, bf16x8 pa0, bf16x8 pa1, bf16x8 pa2, bf16x8 pa3) {
  pv_one<0>(o[0], vb, pa0, pa1, pa2, pa3); pv_one<1>(o[1], vb, pa0, pa1, pa2, pa3);
  if constexpr (DV == 128) { pv_one<2>(o[2], vb, pa0, pa1, pa2, pa3); pv_one<3>(o[3], vb, pa0, pa1, pa2, pa3); }
}

template <int DV, int SC, int LDO, int DQK>
__device__ __forceinline__ void attn_dense_body(const bf16* __restrict__ Qb, const bf16* __restrict__ Kh, const bf16* __restrict__ Vh,
                                                bf16* __restrict__ Ob, int seq, char* lds, const int tid) {
  constexpr int ND = DV / 32, NKS = DQK / 16;
  const int wid = tid >> 6, lane = tid & 63, r32 = lane & 31, hi = lane >> 5;
  bf16* V_lds = (bf16*)lds; bf16* K_lds = (bf16*)(lds + 2 * SHM_V);
  float* ws = (float*)(lds + 2 * SHM_V + 2 * SHM_K) + wid * 64; float* li_l = ws; float* al_l = ws + 32;
  float m_reg = -1e30f, l_reg = 0; f32x16 o[ND] = {}; bf16x8 qr[NKS];
  const bf16* Qw = Qb + (long)(wid * QBLK + r32) * 128 + hi * 8;
#pragma unroll
  for (int d0 = 0; d0 < NKS; ++d0) qr[d0] = *reinterpret_cast<const bf16x8*>(Qw + d0 * 16);
  const int sr = tid >> 4, sc = (tid & 15) * 8;
  const int vr = (DV == 128) ? sr : (tid >> 3), vc = (DV == 128) ? sc : (tid & 7) * 8;
  const int vst0 = v_st(vr, vc), vst1 = v_st(32 + vr, vc);
  const int vb0 = (int)(uintptr_t)V_lds + v_rd_base(lane);
  constexpr int SDEPTH = 1;
  struct { bf16x8 vs0, vs1, ks0, ks1; } sr_[SDEPTH];
#define SLOAD(i, k0) do { sr_[i].vs0 = *reinterpret_cast<const bf16x8*>(&Vh[(long)((k0) + vr) * DV + vc]); \
    if constexpr (DV == 128) sr_[i].vs1 = *reinterpret_cast<const bf16x8*>(&Vh[(long)((k0) + 32 + vr) * DV + vc]); \
    sr_[i].ks0 = *reinterpret_cast<const bf16x8*>(&Kh[(long)((k0) + sr) * 128 + sc]); sr_[i].ks1 = *reinterpret_cast<const bf16x8*>(&Kh[(long)((k0) + 32 + sr) * 128 + sc]); } while (0)
#define SWRITE(b, i) do { *(bf16x8*)((char*)V_lds + (b) * SHM_V + vst0) = sr_[i].vs0;          \
    if constexpr (DV == 128) *(bf16x8*)((char*)V_lds + (b) * SHM_V + vst1) = sr_[i].vs1; int kc = sc * 2;               \
    *(bf16x8*)((char*)K_lds + (b) * SHM_K + KSWZ(sr, kc)) = sr_[i].ks0;                       \
    *(bf16x8*)((char*)K_lds + (b) * SHM_K + KSWZ(32 + sr, kc)) = sr_[i].ks1; } while (0)
#define SWAIT() do { if constexpr (SDEPTH == 1) asm volatile("s_waitcnt vmcnt(0)" ::: "memory"); else if constexpr (DV == 128) asm volatile("s_waitcnt vmcnt(4)" ::: "memory"); else asm volatile("s_waitcnt vmcnt(3)" ::: "memory"); } while (0)
#define RESC(a) do { if (__any((a) < 1.f)) { if (hi == 0) al_l[r32] = (a); asm volatile("s_waitcnt lgkmcnt(0)" ::: "memory"); \
    _Pragma("unroll") for (int d = 0; d < ND; ++d) _Pragma("unroll") for (int r = 0; r < 16; ++r) o[d][r] *= al_l[crow(r, hi)]; } } while (0)
  f32x16 pA0, pA1, pB0, pB1; float mnA, mnB, alA, alB; bf16x8 pa0, pa1, pa2, pa3; const int NT = seq / KVBLK;
  constexpr int SE = 0, SO = SDEPTH - 1;
  SLOAD(SE, 0); asm volatile("s_waitcnt vmcnt(0)" ::: "memory"); SWRITE(0, SE); __syncthreads();
  qkt<NKS>(pA0, pA1, K_lds, qr, r32, hi); partialSM<SC>(pA0, pA1, m_reg, mnA, alA);
  SLOAD(SO, KVBLK); if constexpr (SDEPTH == 2) { if (2 < NT) SLOAD(SE, 2 * KVBLK); }
  SWAIT(); SWRITE(1, SO); __syncthreads();
  for (int j = 1; j + 1 < NT; j += 2) {
    SBAR(); qkt<NKS>(pB0, pB1, (bf16*)((char*)K_lds + SHM_K), qr, r32, hi);
    finishSM(pA0, pA1, alA, l_reg, pa0, pa1, pa2, pa3); SBAR();
    SLOAD(SO, (j + SDEPTH) * KVBLK); SBAR();
    pv_d0<DV>(o, vb0, pa0, pa1, pa2, pa3); partialSM<SC>(pB0, pB1, m_reg, mnB, alB);
    __syncthreads(); SWAIT(); SWRITE(0, SE);
    RESC(alB); __syncthreads();
    SBAR(); qkt<NKS>(pA0, pA1, K_lds, qr, r32, hi);
    finishSM(pB0, pB1, alB, l_reg, pa0, pa1, pa2, pa3); SBAR();
    if (SDEPTH == 1 || j + 3 < NT) SLOAD(SE, (j + 1 + SDEPTH) * KVBLK); SBAR();
    pv_d0<DV>(o, vb0 + (int)SHM_V, pa0, pa1, pa2, pa3); partialSM<SC>(pA0, pA1, m_reg, mnA, alA);
    __syncthreads(); SWAIT(); SWRITE(1, SO);
    RESC(alA); __syncthreads();
  }
  SBAR(); qkt<NKS>(pB0, pB1, (bf16*)((char*)K_lds + SHM_K), qr, r32, hi);
  finishSM(pA0, pA1, alA, l_reg, pa0, pa1, pa2, pa3); SBAR();
  pv_d0<DV>(o, vb0, pa0, pa1, pa2, pa3); partialSM<SC>(pB0, pB1, m_reg, mnB, alB);
  __syncthreads(); RESC(alB);
  finishSM(pB0, pB1, alB, l_reg, pa0, pa1, pa2, pa3); SBAR();
  pv_d0<DV>(o, vb0 + (int)SHM_V, pa0, pa1, pa2, pa3);
  if (hi == 0) li_l[r32] = l_reg; asm volatile("s_waitcnt lgkmcnt(0)" ::: "memory");
  float rli[16];
#pragma unroll
  for (int r = 0; r < 16; ++r) rli[r] = __builtin_amdgcn_rcpf(li_l[crow(r, hi)]);
  bf16* Ow = Ob + (long)(wid * QBLK) * LDO;
#pragma unroll
  for (int r = 0; r < 16; ++r) { int orow = crow(r, hi);
#pragma unroll
    for (int d0 = 0; d0 < ND; ++d0) Ow[(long)orow * LDO + d0 * 32 + r32] = (bf16)f2bf(o[d0][r] * rli[r]); }
  __syncthreads();
#undef SLOAD
#undef SWRITE
#undef SWAIT
#undef RESC
}
#undef KSWZ
#undef SBAR
}
namespace s5 {
constexpr int CH = 4, BT = 16 * CH;
constexpr int NCB = CTXL / BT;
constexpr int NBLK = SKV / BT;
constexpr int NSQ = 6;
static_assert((1 << NSQ) == BT, "squarings");
constexpr int HS_STRIDE = 272;
constexpr int HS_BYTES = 32 * HS_STRIDE;
constexpr int NITEMS = 32 * 2 * NBLK;

struct Params { const float *a_re, *a_im, *log_dt, *b_re, *b_im, *c_re, *c_im, *dskip; };

__device__ __forceinline__ int rowof(int b, int blk, int j) { return blk < NCB ? LAT_ROWS + b * 256 + blk * BT + j : b * 4096 + (blk - NCB) * BT + j; }

struct DirConst {
    float abr[2], abi[2];
    bf16x8 Bfr[2], Bfi[2];
};
__device__ __forceinline__ void load_dir(const Params& P, int dd, int g, int nl, int hi, DirConst& dc) {
    const float dt = __expf(P.log_dt[dd * 32 + g]);
#pragma unroll
    for (int nh = 0; nh < 2; ++nh) {
        const int n = nl + 32 * nh; const int ix = (dd * 32 + g) * 64 + n;
        const float are = P.a_re[ix], aim = P.a_im[ix];
        const float mag = __expf(dt * are), th = dt * aim;
        float rev = th * 0.15915494309189535f; rev -= floorf(rev);
        const float sn = __builtin_amdgcn_sinf(rev), cs = __builtin_amdgcn_cosf(rev);
        const float abr = mag * cs, abi = mag * sn;
        const float den = are * are + aim * aim, nr = abr - 1.f;
        const float zr = (nr * are + abi * aim) / den, zi = (abi * are - nr * aim) / den;
        dc.abr[nh] = abr; dc.abi[nh] = abi;
        const float* br = P.b_re + (size_t)ix * 16 + 8 * hi; const float* bi = P.b_im + (size_t)ix * 16 + 8 * hi;
        u32x4 wr_, wi_;
        float r8[8], i8[8];
#pragma unroll
        for (int j = 0; j < 8; ++j) { const float bre = br[j], bim = bi[j]; r8[j] = zr * bre - zi * bim; i8[j] = zr * bim + zi * bre; }
        wr_.x = pk2(r8[0], r8[1]); wr_.y = pk2(r8[2], r8[3]); wr_.z = pk2(r8[4], r8[5]); wr_.w = pk2(r8[6], r8[7]);
        wi_.x = pk2(i8[0], i8[1]); wi_.y = pk2(i8[2], i8[3]); wi_.z = pk2(i8[4], i8[5]); wi_.w = pk2(i8[6], i8[7]);
        dc.Bfr[nh] = __builtin_bit_cast(bf16x8, wr_); dc.Bfi[nh] = __builtin_bit_cast(bf16x8, wi_);
    }
}
__device__ __forceinline__ void load_cmat(const Params& P, int dd, int g, int lane, bf16x8 (&Cf)[4]) {
    const int p = lane & 15, kq = lane >> 4;
    const float* cre = P.c_re + ((size_t)(dd * 32 + g) * 16 + p) * 64; const float* cim = P.c_im + ((size_t)(dd * 32 + g) * 16 + p) * 64;
#pragma unroll
    for (int ks = 0; ks < 4; ++ks) {
        float v[8];
#pragma unroll
        for (int j = 0; j < 8; ++j) { const int k = 32 * ks + 8 * kq + j; const int n = (k >> 2) + 32 * ((k >> 1) & 1); v[j] = (k & 1) ? -cim[n] : cre[n]; }
        u32x4 w; w.x = pk2(v[0], v[1]); w.y = pk2(v[2], v[3]); w.z = pk2(v[4], v[5]); w.w = pk2(v[6], v[7]);
        Cf[ks] = __builtin_bit_cast(bf16x8, w);
    }
}
constexpr int TAB_BYTES = 9 * 64 * 16;
__device__ __forceinline__ void build_tab(const Params& P, int dd, int g, int lane, u32x4* dst) {
    DirConst dc; load_dir(P, dd, g, lane & 31, lane >> 5, dc);
    bf16x8 Cf[4]; load_cmat(P, dd, g, lane, Cf);
    ((f32x4*)dst)[lane] = (f32x4){dc.abr[0], dc.abr[1], dc.abi[0], dc.abi[1]};
    dst[1 * 64 + lane] = __builtin_bit_cast(u32x4, dc.Bfr[0]); dst[2 * 64 + lane] = __builtin_bit_cast(u32x4, dc.Bfr[1]);
    dst[3 * 64 + lane] = __builtin_bit_cast(u32x4, dc.Bfi[0]); dst[4 * 64 + lane] = __builtin_bit_cast(u32x4, dc.Bfi[1]);
#pragma unroll
    for (int k = 0; k < 4; ++k) dst[(5 + k) * 64 + lane] = __builtin_bit_cast(u32x4, Cf[k]);
}
__device__ __forceinline__ void load_tab(const u32x4* tab, int dd, int g, int lane, DirConst& dc, bf16x8 (&Cf)[4]) {
    const u32x4* t = tab + (size_t)(dd * 32 + g) * (TAB_BYTES / 16);
    u32x4 w[9];
#pragma unroll
    for (int k = 1; k < 9; ++k) w[k] = t[k * 64 + lane];
    const f32x4 a0 = ((const f32x4*)t)[lane];
    dc.abr[0] = a0[0]; dc.abr[1] = a0[1]; dc.abi[0] = a0[2]; dc.abi[1] = a0[3];
    dc.Bfr[0] = __builtin_bit_cast(bf16x8, w[1]); dc.Bfr[1] = __builtin_bit_cast(bf16x8, w[2]); dc.Bfi[0] = __builtin_bit_cast(bf16x8, w[3]); dc.Bfi[1] = __builtin_bit_cast(bf16x8, w[4]);
#pragma unroll
    for (int k = 0; k < 4; ++k) Cf[k] = __builtin_bit_cast(bf16x8, w[5 + k]);
}
__device__ __forceinline__ bf16x8 load_af(const bf16* zraw, int g, int bp, int blk, int c, int lane) {
    const int rho = lane & 31, kh = lane >> 5;
    const int beta = (rho >> 2) & 1, tau = (rho & 3) + 4 * (rho >> 3);
    const int row = rowof(2 * bp + beta, blk, 16 * c + tau);
    return *reinterpret_cast<const bf16x8*>(zraw + (size_t)row * 1024 + g * 16 + 8 * kh);
}
template <bool REV>
__device__ __forceinline__ void chunk_scan(const bf16x8 af, const DirConst& dc,
                                           float (&hr)[2], float (&hi_)[2], f32x16 (&accR)[2], f32x16 (&accI)[2]) {
#pragma unroll
    for (int nh = 0; nh < 2; ++nh) {
        accR[nh] = __builtin_amdgcn_mfma_f32_32x32x16_bf16(af, dc.Bfr[nh], f32x16{}, 0, 0, 0);
        accI[nh] = __builtin_amdgcn_mfma_f32_32x32x16_bf16(af, dc.Bfi[nh], f32x16{}, 0, 0, 0);
    }
#pragma unroll
    for (int qq = 0; qq < 16; ++qq) {
        const int q = REV ? 15 - qq : qq;
#pragma unroll
        for (int nh = 0; nh < 2; ++nh) {
            const float nr_ = dc.abr[nh] * hr[nh] - dc.abi[nh] * hi_[nh] + accR[nh][q];
            const float ni_ = dc.abr[nh] * hi_[nh] + dc.abi[nh] * hr[nh] + accI[nh][q];
            hr[nh] = nr_; hi_[nh] = ni_; accR[nh][q] = nr_; accI[nh][q] = ni_;
        }
    }
}

__device__ __forceinline__ void pass_a_item(const Params& P, const u32x4* tab, const bf16* zraw, float* E, int item, int lane) {
    const int g = item & 31, rest = item >> 5, blk = rest % NBLK, bp = rest / NBLK;
    const int nl = lane & 31, hi = lane >> 5;
    f32x16 accR[2], accI[2];
#pragma unroll
    for (int dd = 0; dd < 2; ++dd) {
        DirConst dc; bf16x8 Cfu[4]; load_tab(tab, dd, g, lane, dc, Cfu);
#ifdef DBG_TABA
        { DirConst d2; load_dir(P, dd, g, nl, hi, d2);
          if (DBG_TABA == 1) dc = d2;
          if (DBG_TABA == 2) { dc.abr[0] = d2.abr[0]; dc.abr[1] = d2.abr[1]; dc.abi[0] = d2.abi[0]; dc.abi[1] = d2.abi[1]; }
          if (DBG_TABA == 3) { dc.Bfr[0] = d2.Bfr[0]; dc.Bfr[1] = d2.Bfr[1]; dc.Bfi[0] = d2.Bfi[0]; dc.Bfi[1] = d2.Bfi[1]; } }
#endif
        float hr[2] = {0.f, 0.f}, hi_[2] = {0.f, 0.f};
        bf16x8 af = load_af(zraw, g, bp, blk, dd == 0 ? 0 : CH - 1, lane);
        for (int cc = 0; cc < CH; ++cc) {
            const int cn = cc < CH - 1 ? cc + 1 : cc;
            const bf16x8 afn = load_af(zraw, g, bp, blk, dd == 0 ? cn : CH - 1 - cn, lane);
            if (dd == 0) chunk_scan<false>(af, dc, hr, hi_, accR, accI);
            else chunk_scan<true>(af, dc, hr, hi_, accR, accI);
            af = afn;
        }
        const int b = 2 * bp + hi;
        float* e = E + ((((size_t)(dd * 32 + g) * 4 + b) * NBLK + blk) * 64) * 2;
#pragma unroll
        for (int nh = 0; nh < 2; ++nh) { *(f32x2*)(e + (nl + 32 * nh) * 2) = (f32x2){hr[nh], hi_[nh]}; }
    }
}

__device__ __forceinline__ void readout(LAS unsigned char* hs, int lane, const bf16x8 (&Cf)[4], const f32x16 (&accR)[2], const f32x16 (&accI)[2], f32x4 (&y)[2]) {
    const int nl = lane & 31, hi = lane >> 5;
#pragma unroll
    for (int q = 0; q < 16; ++q) {
        u32x2 w; w.x = pk2(accR[0][q], accI[0][q]); w.y = pk2(accR[1][q], accI[1][q]);
        *(LAS u32x2*)(hs + (hi * 16 + q) * HS_STRIDE + nl * 8) = w;
    }
    asm volatile("s_waitcnt lgkmcnt(0)" ::: "memory");
    const int tk = lane & 15, kq = lane >> 4;
#pragma unroll
    for (int beta = 0; beta < 2; ++beta) {
#pragma unroll
        for (int ks = 0; ks < 4; ++ks) {
            const bf16x8 hb = *(const LAS bf16x8*)(hs + (beta * 16 + tk) * HS_STRIDE + (32 * ks + 8 * kq) * 2);
            y[beta] = __builtin_amdgcn_mfma_f32_16x16x32_bf16(Cf[ks], hb, y[beta], 0, 0, 0);
        }
    }
    asm volatile("s_waitcnt lgkmcnt(0)" ::: "memory");
}

__device__ __forceinline__ void prefix_wave(const Params& P, float* E, int seq, int lane) {
    const int dd = seq >> 7, g = (seq >> 2) & 31, n = lane;
    const int ix = (dd * 32 + g) * 64 + n;
    const float dt = __expf(P.log_dt[dd * 32 + g]);
    const float are = P.a_re[ix], aim = P.a_im[ix];
    const float mag = __expf(dt * are), th = dt * aim;
    float rev = th * 0.15915494309189535f; rev -= floorf(rev);
    float ar = mag * __builtin_amdgcn_cosf(rev), ai = mag * __builtin_amdgcn_sinf(rev);
#pragma unroll
    for (int s = 0; s < NSQ; ++s) { const float t = ar * ar - ai * ai; ai = 2.f * ar * ai; ar = t; }
    float* e = E + ((size_t)seq * NBLK * 64 + n) * 2;
    float hr = 0.f, hi = 0.f;
    constexpr int BATCH = 17; static_assert(NBLK % BATCH == 0, "batching");
    for (int c0 = 0; c0 < NBLK; c0 += BATCH) {
        f32x2 ev[BATCH];
#pragma unroll
        for (int u = 0; u < BATCH; ++u) { const int ci = c0 + u; const int blk = dd == 0 ? ci : (ci < NCB ? NCB - 1 - ci : NBLK + NCB - 1 - ci); ev[u] = *(const f32x2*)(e + (size_t)blk * 128); }
        asm volatile("" ::: "memory");
#pragma unroll
        for (int u = 0; u < BATCH; ++u) { const int ci = c0 + u; const int blk = dd == 0 ? ci : (ci < NCB ? NCB - 1 - ci : NBLK + NCB - 1 - ci);
            *(f32x2*)(e + (size_t)blk * 128) = (f32x2){hr, hi};
            const float nr_ = ar * hr - ai * hi + ev[u].x, ni_ = ar * hi + ai * hr + ev[u].y; hr = nr_; hi = ni_; }
    }
}

__device__ __forceinline__ void pass_b_item(const Params& P, const u32x4* tab, const bf16* zraw, const float* E, bf16* gg, LAS unsigned char* hs, int item, int lane) {
    const int g = item & 31, rest = item >> 5, blk = rest % NBLK, bp = rest / NBLK;
    const int nl = lane & 31, hi = lane >> 5;
    const int b = 2 * bp + hi;
    f32x16 accR[2], accI[2];
    f32x4 yf[CH][2];
    {
        DirConst dc; bf16x8 Cf[4]; load_tab(tab, 0, g, lane, dc, Cf);
#ifdef DBG_TABCMP
        { DirConst d2; load_dir(P, 0, g, nl, hi, d2); bf16x8 C2[4]; load_cmat(P, 0, g, lane, C2); bool bad = false;
          for (int q = 0; q < 2; ++q) { if (d2.abr[q] != dc.abr[q] || d2.abi[q] != dc.abi[q]) bad = true; for (int j = 0; j < 8; ++j) if (d2.Bfr[q][j] != dc.Bfr[q][j] || d2.Bfi[q][j] != dc.Bfi[q][j]) bad = true; }
          bool badc = false; for (int q = 0; q < 4; ++q) for (int j = 0; j < 8; ++j) if (C2[q][j] != Cf[q][j]) badc = true;
          if (DBG_TABCMP == 1 && bad) dc.abr[0] = __builtin_nanf(""); if (DBG_TABCMP == 2 && badc) dc.abr[0] = __builtin_nanf("");
          if (DBG_TABCMP == 3) { dc = d2; for (int q = 0; q < 4; ++q) Cf[q] = C2[q]; } }
#endif
        float hr[2], hi_[2];
        { const float* e = E + (((((size_t)(0 * 32 + g) * 4 + b) * NBLK + blk) * 64) * 2);
#pragma unroll
          for (int nh = 0; nh < 2; ++nh) { const f32x2 hv = *(const f32x2*)(e + (nl + 32 * nh) * 2); hr[nh] = hv.x; hi_[nh] = hv.y; } }
        bf16x8 af = load_af(zraw, g, bp, blk, 0, lane);
#pragma unroll
        for (int c = 0; c < CH; ++c) {
            const bf16x8 afn = load_af(zraw, g, bp, blk, c < CH - 1 ? c + 1 : c, lane);
            chunk_scan<false>(af, dc, hr, hi_, accR, accI); af = afn;
            yf[c][0] = (f32x4){0.f, 0.f, 0.f, 0.f}; yf[c][1] = (f32x4){0.f, 0.f, 0.f, 0.f};
            readout(hs, lane, Cf, accR, accI, yf[c]);
        }
    }
    {
        DirConst dc; bf16x8 Cf[4]; load_tab(tab, 1, g, lane, dc, Cf);
        float hr[2], hi_[2];
        { const float* e = E + (((((size_t)(1 * 32 + g) * 4 + b) * NBLK + blk) * 64) * 2);
#pragma unroll
          for (int nh = 0; nh < 2; ++nh) { const f32x2 hv = *(const f32x2*)(e + (nl + 32 * nh) * 2); hr[nh] = hv.x; hi_[nh] = hv.y; } }
        const int tk = lane & 15, kq = lane >> 4;
        const f32x4 dv = *(const f32x4*)(P.dskip + g * 16 + 4 * kq);
        bf16x8 af = load_af(zraw, g, bp, blk, CH - 1, lane);
#pragma unroll
        for (int cc = 0; cc < CH; ++cc) {
            const int c = CH - 1 - cc;
            const bf16x8 afn = load_af(zraw, g, bp, blk, c > 0 ? c - 1 : c, lane);
            u32x2 uwv[2];
#pragma unroll
            for (int beta = 0; beta < 2; ++beta) uwv[beta] = *(const u32x2*)(zraw + (size_t)rowof(2 * bp + beta, blk, 16 * c + tk) * 1024 + g * 16 + 4 * kq);
            chunk_scan<true>(af, dc, hr, hi_, accR, accI); af = afn;
            readout(hs, lane, Cf, accR, accI, yf[c]);
#pragma unroll
            for (int beta = 0; beta < 2; ++beta) {
                const int row = rowof(2 * bp + beta, blk, 16 * c + tk);
                const u32x2 uw = uwv[beta];
                const f32x4 yv = yf[c][beta];
                const float v0 = yv[0] + dv[0] * bflo(uw.x), v1 = yv[1] + dv[1] * bfhi(uw.x), v2 = yv[2] + dv[2] * bflo(uw.y), v3 = yv[3] + dv[3] * bfhi(uw.y);
                u32x2 ow; ow.x = pk2(gelu_tanh(v0), gelu_tanh(v1)); ow.y = pk2(gelu_tanh(v2), gelu_tanh(v3));
                *(u32x2*)(gg + (size_t)row * 512 + g * 16 + 4 * kq) = ow;
            }
        }
    }
}
}
typedef const float* __attribute__((address_space(4))) const* KargPtrTable;
#define KIN(k) (((KargPtrTable)__builtin_amdgcn_kernarg_segment_ptr())[k])
struct Ctx {
    float* out; unsigned char* ws;
    LAS unsigned char* lds;
    int tid, lane, wave, G, gw, NGW, bid, dry;
};

__device__ __forceinline__ void tr_item(const float* src, int sld, int c0, int k0, int srcK, bf16* dst, int dld, int n0, bool zero, LAS float* scr, int lane) {
    const int c = lane & 7;
    if (zero || k0 >= srcK) {
#pragma unroll
        for (int j = 0; j < 4; ++j) { const int n = (lane >> 3) + 8 * j; unsigned z0 = 0u; asm volatile("" : "+v"(z0));
            *(u32x4*)(dst + (size_t)(n0 + n) * dld + k0 + 8 * c) = (u32x4){z0, z0, z0, z0}; }
        return;
    }
    { const int kk = lane >> 3, nc = lane & 7;
      f32x4 v[8];
#pragma unroll
      for (int i = 0; i < 8; ++i) v[i] = *(const f32x4*)(src + (size_t)(k0 + 8 * i + kk) * sld + c0 + 4 * nc);
#pragma unroll
      for (int i = 0; i < 8; ++i) { LAS float* d = scr + (8 * i + kk) * 33 + 4 * nc; d[0] = v[i][0]; d[1] = v[i][1]; d[2] = v[i][2]; d[3] = v[i][3]; } }
    asm volatile("s_waitcnt lgkmcnt(0)" ::: "memory");
#pragma unroll
    for (int j = 0; j < 4; ++j) { const int n = (lane >> 3) + 8 * j; const LAS float* s = scr + (8 * c) * 33 + n;
        u32x4 o; o.x = cvtpk(s[0 * 33], s[1 * 33]); o.y = cvtpk(s[2 * 33], s[3 * 33]); o.z = cvtpk(s[4 * 33], s[5 * 33]); o.w = cvtpk(s[6 * 33], s[7 * 33]);
        *(u32x4*)(dst + (size_t)(n0 + n) * dld + k0 + 8 * c) = o; }
    asm volatile("s_waitcnt lgkmcnt(0)" ::: "memory");
}

#ifndef DEF_QA
#define DEF_QA 12
#endif
#ifndef DEF_QB
#define DEF_QB 12
#endif
constexpr int DEF_ITEMS = 128 * (512 + 256), DEF_P0 = (48 - 2 * (DEF_QA + DEF_QB)) * 2048;
static_assert(DEF_ITEMS == 48 * 2048 && DEF_P0 >= 0 && DEF_P0 + (DEF_QA + DEF_QB) * 2048 >= 2 * 32 * 768, "deferred conversion schedule: layers 0 and 1 complete before layer 0's MoE");
__device__ __forceinline__ void moe_item(const Ctx& F, int q, LAS float* scr) {
    constexpr int PER_LE = 512 + 256;
    const int le = q / PER_LE; int r = q % PER_LE;
    if (r < 512) { const int nb = r >> 4, kb = r & 15;
        const int n0 = nb * 32, pn = n0 >> 8, w = n0 & 255;
        const float* src = (w < 128 ? KIN(33) : KIN(34)) + (size_t)le * 1024 * 512;
        tr_item(src, 512, pn * 128 + (w & 127), kb * 64, 1024, (bf16*)(F.ws + WS_W_GU) + (size_t)le * 1024 * 1024, 1024, n0, false, scr, F.lane);
    } else { r -= 512; const int nb = r >> 3, kb = r & 7;
        tr_item(KIN(35) + (size_t)le * 512 * 1024, 1024, nb * 32, kb * 64, 512, (bf16*)(F.ws + WS_W_DN) + (size_t)le * 1024 * 512, 512, nb * 32, false, scr, F.lane); }
}
__device__ __forceinline__ void p0_weights(const Ctx& F) {
    LAS float* scr = (LAS float*)(F.lds + F.wave * 16384);
    constexpr int PER_I = 512 + 512 + 128 + 96 + 128 + 1024 + 512;
    constexpr int DENSE = 2 * PER_I, PER_LE = 512 + 256, TOTAL = DENSE + DEF_P0;
    for (int it = F.gw; it < TOTAL; it += F.NGW) {
        if (it < DENSE) {
            const int i = it / PER_I; int r = it % PER_I;
            if (r < 512) { const int nb = r >> 4, kb = r & 15;
                tr_item(KIN(8) + (size_t)i * 1024 * 928, 928, nb * 32, kb * 64, 1024, (bf16*)(F.ws + WS_W_IN) + (size_t)i * 1024 * 1024, 1024, nb * 32, nb >= 29, scr, F.lane); continue; } r -= 512;
            if (r < 512) { const int nb = r >> 4, kb = r & 15;
                tr_item(KIN(9) + (size_t)i * 1024 * 1024, 1024, nb * 32, kb * 64, 1024, (bf16*)(F.ws + WS_W_OUTE) + (size_t)i * 1024 * 1024, 1024, nb * 32, false, scr, F.lane); continue; } r -= 512;
            if (r < 128) { const int nb = r >> 3, kb = r & 7;
                tr_item(KIN(18) + (size_t)i * 512 * 512, 512, nb * 32, kb * 64, 512, (bf16*)(F.ws + WS_W_GLU) + (size_t)i * 512 * 512, 512, nb * 32, false, scr, F.lane); continue; } r -= 128;
            if (r < 96) { const int nb = r >> 2, kb = r & 3;
                tr_item(KIN(20) + (size_t)i * 256 * 768, 768, nb * 32, kb * 64, 256, (bf16*)(F.ws + WS_W_MLA) + (size_t)i * 1792 * 256, 256, nb * 32, false, scr, F.lane); continue; } r -= 96;
            if (r < 128) { const int nb = r >> 2, kb = r & 3;
                tr_item(KIN(22) + (size_t)i * 128 * 1024, 1024, nb * 32, kb * 64, 128, (bf16*)(F.ws + WS_W_MLA) + (size_t)i * 1792 * 256, 256, 768 + nb * 32, false, scr, F.lane); continue; } r -= 128;
            if (r < 1024) { const int nb = r >> 4, kb = r & 15;
                tr_item(KIN(25) + (size_t)i * 1024 * 2048, 2048, nb * 32, kb * 64, 1024, (bf16*)(F.ws + WS_W_QKV) + (size_t)i * 2048 * 1024, 1024, nb * 32, false, scr, F.lane); continue; } r -= 1024;
            { const int nb = r >> 4, kb = r & 15;
                tr_item(KIN(26) + (size_t)i * 1024 * 1024, 1024, nb * 32, kb * 64, 1024, (bf16*)(F.ws + WS_W_OUTO) + (size_t)i * 1024 * 1024, 1024, nb * 32, false, scr, F.lane); }
        } else {
            moe_item(F, it - DENSE, scr);
        }
    }
}
__device__ __forceinline__ void defer_convert(const Ctx& F, int slot) {
    const int quota = (slot & 1) ? DEF_QB : DEF_QA, start = DEF_P0 + (slot >> 1) * (DEF_QA + DEF_QB) * 2048 + (slot & 1) * DEF_QA * 2048;
    LAS float* scr = (LAS float*)(F.lds + 8 * 8704 + F.wave * 8448);
    for (int k = 0; k < quota; ++k) moe_item(F, start + k * F.NGW + F.gw, scr);
}
__device__ __forceinline__ void p0_ada(const Ctx& F) {
    LAS float* sc = (LAS float*)(F.lds);
    LAS float* red = (LAS float*)(F.lds + 32768);
    for (int i = F.tid; i < 5 * 1024; i += 512) { const int r = i >> 10, k = i & 1023; const float v = r < 4 ? KIN(1)[r * 1024 + k] : KIN(3)[k]; sc[i] = siluf_(v); }
    __syncthreads();
    const int id = F.bid, l = id / 48, col0 = (id % 48) * 128;
    float a[5][2];
#pragma unroll
    for (int r = 0; r < 5; ++r) { a[r][0] = 0.f; a[r][1] = 0.f; }
    const float* wp = KIN(4) + ((size_t)l * 1024 + F.wave * 128) * NMOD + col0 + 2 * F.lane;
#pragma unroll 8
    for (int k = 0; k < 128; ++k) { const f32x2 w2 = *(const f32x2*)(wp + (size_t)k * NMOD);
#pragma unroll
        for (int r = 0; r < 5; ++r) { const float s = sc[r * 1024 + F.wave * 128 + k]; a[r][0] += s * w2.x; a[r][1] += s * w2.y; } }
#pragma unroll
    for (int r = 0; r < 5; ++r) { red[(F.wave * 5 + r) * 128 + 2 * F.lane] = a[r][0]; red[(F.wave * 5 + r) * 128 + 2 * F.lane + 1] = a[r][1]; }
    __syncthreads();
    for (int i = F.tid; i < 5 * 128; i += 512) { const int r = i >> 7, cc = i & 127; float s = KIN(5)[l * NMOD + col0 + cc];
#pragma unroll
        for (int w = 0; w < 8; ++w) s += red[(w * 5 + r) * 128 + cc];
        ((float*)(F.ws + WS_MOD))[((size_t)l * 5 + r) * NMOD + col0 + cc] = s; }
    __syncthreads();
}
__device__ __forceinline__ void p0_rope(const Ctx& F) {
    float* t = (float*)(F.ws + WS_ROPE);
    for (int i = F.tid; i < 64 * 32; i += 512) { const int p = i >> 5, f = i & 31; const float inv = __builtin_amdgcn_exp2f(-(float)f * (13.287712379549449f / 32.f));
        float rev = (float)p * inv * 0.15915494309189535f; rev -= floorf(rev);
        t[2 * i] = __builtin_amdgcn_cosf(rev); t[2 * i + 1] = __builtin_amdgcn_sinf(rev); }
    for (int i = F.tid; i < 64 * 8; i += 512) { const int p = i >> 3, f = i & 7; const float inv = __builtin_amdgcn_exp2f(-(float)f * (13.287712379549449f / 8.f));
        float rev = (float)p * inv * 0.15915494309189535f; rev -= floorf(rev);
        t[ROPE32_OFF + 2 * i] = __builtin_amdgcn_cosf(rev); t[ROPE32_OFF + 2 * i + 1] = __builtin_amdgcn_sinf(rev); }
}

__device__ __forceinline__ void p0_router_t(const Ctx& F) {
    float* rt = (float*)(F.ws + WS_RT);
    for (int i = F.tid; i < DEPTH * 36 * 1024; i += 512) { const int k = i & 1023, j = (i >> 10) % 36, l = i / (36 * 1024);
        rt[i] = j < 4 ? KIN(29)[((size_t)l * 1024 + k) * 4 + j] : KIN(31)[((size_t)l * 1024 + k) * 32 + (j - 4)]; }
}
__device__ __forceinline__ void unpack8(const u32x4 w, float (&x)[8]) { x[0] = bflo(w.x); x[1] = bfhi(w.x); x[2] = bflo(w.y); x[3] = bfhi(w.y); x[4] = bflo(w.z); x[5] = bfhi(w.z); x[6] = bflo(w.w); x[7] = bfhi(w.w); }
__device__ __forceinline__ u32x4 pack8(const float (&x)[8]) { u32x4 w; w.x = pk2(x[0], x[1]); w.y = pk2(x[2], x[3]); w.z = pk2(x[4], x[5]); w.w = pk2(x[6], x[7]); return w; }
__device__ __forceinline__ float sumsq8(const float (&x)[8]) { return ((x[0] * x[0] + x[1] * x[1]) + (x[2] * x[2] + x[3] * x[3])) + ((x[4] * x[4] + x[5] * x[5]) + (x[6] * x[6] + x[7] * x[7])); }
__device__ __forceinline__ float group8_sum(float v) { v += DPP_F(v, 0xB1); v += DPP_F(v, 0x4E); v += DPP_F(v, 0x141); return v; }
__device__ __forceinline__ float group16_sum(float v) { v += DPP_F(v, 0xB1); v += DPP_F(v, 0x4E); v += DPP_F(v, 0x141); v += DPP_F(v, 0x140); return v; }
__device__ __forceinline__ void norm_rope8(const float (&x1)[8], const float (&x2)[8], float rinv, const float (&w1)[8], const float (&w2)[8], const float* csn, bool rot, u32x4& o1, u32x4& o2) {
    float a[8], b2[8];
    if (rot) {
        const f32x4 c0 = *(const f32x4*)(csn), c1 = *(const f32x4*)(csn + 4), c2 = *(const f32x4*)(csn + 8), c3 = *(const f32x4*)(csn + 12);
        const float cs[8] = {c0[0], c0[2], c1[0], c1[2], c2[0], c2[2], c3[0], c3[2]}, sn[8] = {c0[1], c0[3], c1[1], c1[3], c2[1], c2[3], c3[1], c3[3]};
#pragma unroll
        for (int j = 0; j < 8; ++j) { const float y1 = x1[j] * rinv * w1[j], y2 = x2[j] * rinv * w2[j]; a[j] = y1 * cs[j] - y2 * sn[j]; b2[j] = y2 * cs[j] + y1 * sn[j]; }
    } else {
#pragma unroll
        for (int j = 0; j < 8; ++j) { a[j] = x1[j] * rinv * w1[j]; b2[j] = x2[j] * rinv * w2[j]; }
    }
    o1 = pack8(a); o2 = pack8(b2);
}
struct RowV { float v[2][8]; };
__device__ __forceinline__ void ld_row_f32(const float* p, int lane, RowV& r) {
#pragma unroll
    for (int j = 0; j < 2; ++j) { const f32x4 a = *(const f32x4*)(p + 8 * lane + 512 * j), b = *(const f32x4*)(p + 8 * lane + 512 * j + 4);
        r.v[j][0] = a[0]; r.v[j][1] = a[1]; r.v[j][2] = a[2]; r.v[j][3] = a[3]; r.v[j][4] = b[0]; r.v[j][5] = b[1]; r.v[j][6] = b[2]; r.v[j][7] = b[3]; }
}
__device__ __forceinline__ void ld_row_bf16(const bf16* p, int lane, RowV& r) {
#pragma unroll
    for (int j = 0; j < 2; ++j) { const u32x4 w = *(const u32x4*)(p + 8 * lane + 512 * j); unpack8(w, r.v[j]); }
}
__device__ __forceinline__ float row_sumsq(const RowV& r) { return wave_sum(sumsq8(r.v[0]) + sumsq8(r.v[1])); }
__device__ __forceinline__ void ld8f(const float* p, float (&o)[8]) { const f32x4 a = *(const f32x4*)p, b = *(const f32x4*)(p + 4); o[0] = a[0]; o[1] = a[1]; o[2] = a[2]; o[3] = a[3]; o[4] = b[0]; o[5] = b[1]; o[6] = b[2]; o[7] = b[3]; }
__device__ __forceinline__ void ld_xrow(const Ctx& F, int l, int row, RowV& x) {
    if (l == 0) ld_row_f32(row < LAT_ROWS ? KIN(0) + (size_t)row * DM : KIN(2) + (size_t)(row - LAT_ROWS) * DM, F.lane, x);
    else ld_row_bf16((const bf16*)(F.ws + WS_XRES) + (size_t)row * DM, F.lane, x);
}
__device__ __forceinline__ void rows_norm1(const Ctx& F, int l) {
    const float* mod = (const float*)(F.ws + WS_MOD);
    const bf16* ydn = (const bf16*)(F.ws + WS_YDN);
    bf16* xres = (bf16*)(F.ws + WS_XRES);
    bf16* h = (bf16*)(F.ws + WS_H);
    const float* g1 = KIN(6) + l * DM;
    constexpr int RR = 2;
    for (int row0 = F.gw; row0 < TOK; row0 += RR * F.NGW) {
        RowV x[RR]; u32x4 y0[RR][2], y1[RR][2];
#pragma unroll
        for (int rr = 0; rr < RR; ++rr) { int row = row0 + rr * F.NGW; row = row < TOK ? row : TOK - 1;
            ld_xrow(F, l, row, x[rr]);
            if (l > 0) {
#pragma unroll
                for (int j = 0; j < 2; ++j) { const int col = 8 * F.lane + 512 * j;
                    y0[rr][j] = *(const u32x4*)(ydn + (size_t)(2 * row) * DM + col); y1[rr][j] = *(const u32x4*)(ydn + (size_t)(2 * row + 1) * DM + col); } } }
#pragma unroll
        for (int rr = 0; rr < RR; ++rr) { const int row = row0 + rr * F.NGW; if (row >= TOK) break;
            const int mr = modrow_of(row);
            if (l > 0) {
                const float* g2 = mod + ((size_t)(l - 1) * 5 + mr) * NMOD + 5 * DM;
#pragma unroll
                for (int j = 0; j < 2; ++j) { const int col = 8 * F.lane + 512 * j;
                    float gv[8], a[8], b2[8]; ld8f(g2 + col, gv); unpack8(y0[rr][j], a); unpack8(y1[rr][j], b2);
#pragma unroll
                    for (int i = 0; i < 8; ++i) x[rr].v[j][i] += gv[i] * (a[i] + b2[i]);
                    if (!F.dry) *(u32x4*)(xres + (size_t)row * DM + col) = pack8(x[rr].v[j]);
                    unpack8(pack8(x[rr].v[j]), x[rr].v[j]); }
            }
            const float rinv = rsqrtf(row_sumsq(x[rr]) * (1.f / DM) + RMS_EPS);
            const float* mrow = mod + ((size_t)l * 5 + mr) * NMOD;
#pragma unroll
            for (int j = 0; j < 2; ++j) { const int col = 8 * F.lane + 512 * j;
                float gv[8], sh[8], scl[8], o[8]; ld8f(g1 + col, gv); ld8f(mrow + col, sh); ld8f(mrow + DM + col, scl);
#pragma unroll
                for (int i = 0; i < 8; ++i) o[i] = x[rr].v[j][i] * rinv * gv[i] * (1.f + scl[i]) + sh[i];
                *(u32x4*)(h + (size_t)row * DM + col) = pack8(o); }
        }
    }
}
__device__ __forceinline__ void build_router_tab(const Ctx& F, int l) {
    const float* mod = (const float*)(F.ws + WS_MOD) + (size_t)l * 5 * NMOD;
    const float* rt = (const float*)(F.ws + WS_RT) + (size_t)l * 36 * 1024;
    const float* g2w = KIN(7) + l * DM;
    bf16* tab = (bf16*)(F.ws + WS_RW);
    for (int i = F.bid * 512 + F.tid; i < 5 * 48 * 1024; i += F.G * 512) { const int c = i & 1023, n = (i >> 10) % 48, mr = i / (48 * 1024);
        float w = 0.f; if (n < 4) w = rt[n * 1024 + c]; else if (n >= 16) w = rt[(n - 12) * 1024 + c];
        const float v = g2w[c] * (1.f + mod[(size_t)mr * NMOD + 4 * DM + c]) * w;
        const unsigned hi = f2bf(v); const float lo = v - __builtin_bit_cast(float, hi << 16);
        tab[((size_t)mr * 2 + 0) * 48 * 1024 + n * 1024 + c] = (bf16)hi; tab[((size_t)mr * 2 + 1) * 48 * 1024 + n * 1024 + c] = (bf16)f2bf(lo); }
    float* rc = (float*)(F.ws + WS_RC);
    for (int d = F.gw; d < 5 * 36; d += F.NGW) { const int mr = d / 36, j = d % 36; float s = 0.f;
        for (int c = F.lane; c < 1024; c += 64) s += mod[(size_t)mr * NMOD + 3 * DM + c] * rt[j * 1024 + c];
        s = wave_sum(s); if (F.lane == 0) rc[d] = s + (j < 4 ? KIN(30)[l * 4 + j] : KIN(32)[l * 32 + j - 4]); }
}
template <int NT>
__device__ __forceinline__ void router_pass(const Ctx& F, const bf16* xres, int rowbase, int mr, LAS unsigned* lcnt, float* gatew,
                                            int& ea, int& eb, unsigned& ra, unsigned& rb, int& myrow) {
    const int r = F.lane & 15, fq = F.lane >> 4, k0 = F.wave * 128 + 8 * fq;
    const bf16* ap = xres + (size_t)(rowbase + r) * DM + k0;
    const bf16* bh = (const bf16*)(F.ws + WS_RW) + (size_t)mr * 2 * 48 * 1024 + (size_t)r * 1024 + k0; const bf16* bl = bh + 48 * 1024;
    f32x4 acc[NT][3]; float ssq[NT];
#pragma unroll
    for (int t = 0; t < NT; ++t) { ssq[t] = 0.f;
#pragma unroll
        for (int nt = 0; nt < 3; ++nt) acc[t][nt] = (f32x4){0.f, 0.f, 0.f, 0.f}; }
#pragma unroll
    for (int half = 0; half < 2; ++half) {
        u32x4 av[NT][2]; bf16x8 wh[3][2], wl[3][2];
#pragma unroll
        for (int k2 = 0; k2 < 2; ++k2) { const int ko = (half * 2 + k2) * 32;
#pragma unroll
            for (int t = 0; t < NT; ++t) av[t][k2] = *(const u32x4*)(ap + (size_t)t * 16 * DM + ko);
#pragma unroll
            for (int nt = 0; nt < 3; ++nt) { wh[nt][k2] = *(const bf16x8*)(bh + nt * 16 * 1024 + ko); wl[nt][k2] = *(const bf16x8*)(bl + nt * 16 * 1024 + ko); } }
        __builtin_amdgcn_sched_barrier(0);
#pragma unroll
        for (int k2 = 0; k2 < 2; ++k2)
#pragma unroll
            for (int t = 0; t < NT; ++t) { const bf16x8 a = __builtin_bit_cast(bf16x8, av[t][k2]);
#pragma unroll
                for (int nt = 0; nt < 3; ++nt) { acc[t][nt] = __builtin_amdgcn_mfma_f32_16x16x32_bf16(wh[nt][k2], a, acc[t][nt], 0, 0, 0);
                    acc[t][nt] = __builtin_amdgcn_mfma_f32_16x16x32_bf16(wl[nt][k2], a, acc[t][nt], 0, 0, 0); }
                float xf[8]; unpack8(av[t][k2], xf); ssq[t] += sumsq8(xf); }
        __builtin_amdgcn_sched_barrier(0);
    }
    constexpr int WSTR = NT * 768 + NT * 64;
    LAS float* pl = (LAS float*)F.lds + F.wave * WSTR;
#pragma unroll
    for (int t = 0; t < NT; ++t) {
#pragma unroll
        for (int nt = 0; nt < 3; ++nt) *(LAS f32x4*)(pl + (t * 16 + r) * 48 + nt * 16 + 4 * fq) = acc[t][nt];
        pl[NT * 768 + t * 64 + fq * 16 + r] = ssq[t]; }
    __syncthreads();
    if (F.tid < NT * 16) { const int t = F.tid >> 4, rr = F.tid & 15, row = rowbase + F.tid;
        const LAS float* base = (const LAS float*)F.lds;
        float s = 0.f;
#pragma unroll
        for (int w = 0; w < 8; ++w)
#pragma unroll
            for (int f = 0; f < 4; ++f) s += base[w * WSTR + NT * 768 + t * 64 + f * 16 + rr];
        const float rinv = rsqrtf(s * (1.f / DM) + RMS_EPS);
        const float* rc = (const float*)(F.ws + WS_RC) + mr * 36;
        const LAS float* lrow = base + (t * 16 + rr) * 48;
        float l1[4];
#pragma unroll
        for (int i = 0; i < 4; ++i) { float v = 0.f;
#pragma unroll
            for (int w = 0; w < 8; ++w) v += lrow[w * WSTR + i];
            l1[i] = v * rinv + rc[i]; }
        int grp = 0; float best = l1[0];
#pragma unroll
        for (int i = 1; i < 4; ++i) if (l1[i] > best) { best = l1[i]; grp = i; }
        float den = 0.f;
#pragma unroll
        for (int i = 0; i < 4; ++i) den += __expf(l1[i] - best);
        const float pgrp = 1.f / den;
        float l2[8];
#pragma unroll
        for (int q = 0; q < 8; ++q) { float v = 0.f;
#pragma unroll
            for (int w = 0; w < 8; ++w) v += lrow[w * WSTR + 16 + grp * 8 + q];
            l2[q] = v * rinv + rc[4 + grp * 8 + q]; }
        int i0 = 0; float v0 = l2[0];
#pragma unroll
        for (int i = 1; i < 8; ++i) if (l2[i] > v0) { v0 = l2[i]; i0 = i; }
        int i1 = -1; float v1 = -3.0e38f;
#pragma unroll
        for (int i = 0; i < 8; ++i) if (i != i0 && l2[i] > v1) { v1 = l2[i]; i1 = i; }
        const float e1 = __expf(v1 - v0), w0 = 1.f / (1.f + e1), w1 = e1 * w0;
        ea = grp * 8 + i0; eb = grp * 8 + i1; myrow = row;
        ra = __hip_atomic_fetch_add(&lcnt[ea], 1u, __ATOMIC_RELAXED, __HIP_MEMORY_SCOPE_WORKGROUP);
        rb = __hip_atomic_fetch_add(&lcnt[eb], 1u, __ATOMIC_RELAXED, __HIP_MEMORY_SCOPE_WORKGROUP);
        gatew[row * 2] = pgrp * w0; gatew[row * 2 + 1] = pgrp * w1;
    }
    __syncthreads();
}
__device__ __forceinline__ void rows_norm2_router(const Ctx& F, int l) {
    const float* mod = (const float*)(F.ws + WS_MOD);
    const bf16* xres = (const bf16*)(F.ws + WS_XRES);
    bf16* gb = (bf16*)(F.ws + WS_H);
    const float* g2w = KIN(7) + l * DM;
    LAS unsigned* lcnt = (LAS unsigned*)(F.lds + MISC_OFF + 1024); LAS unsigned* lbase = lcnt + 32;
    if (F.tid < 64) lcnt[F.tid] = 0u;
    __syncthreads();
    unsigned* cnt = (unsigned*)(F.ws + WS_CTL) + CW_CNT + l * 64 + (F.dry ? 8192 : 0);
    int* list = (int*)(F.ws + (F.dry ? WS_E2 : WS_LIST));
    float* gatew = (float*)(F.ws + (F.dry ? WS_E2 + 4 * MiB : WS_GATEW));
    const int nrows = (l == DEPTH - 1) ? LAT_ROWS : TOK;
    int ea = 0, eb = 0, myrow = -1, ea2 = 0, eb2 = 0, myrow2 = -1; unsigned ra = 0u, rb = 0u, ra2 = 0u, rb2 = 0u;
    router_pass<4>(F, xres, 64 * F.bid, F.bid >> 6, lcnt, gatew, ea, eb, ra, rb, myrow);
    if (l < DEPTH - 1 && F.bid < 64) router_pass<1>(F, xres, LAT_ROWS + 16 * F.bid, 4, lcnt, gatew, ea2, eb2, ra2, rb2, myrow2);
    constexpr int RR = 2;
    const int ntrip = (l < DEPTH - 1 && F.gw >= F.NGW - (TOK - LAT_ROWS)) ? 5 : 4;
    for (int trip = 0; trip < ntrip; ++trip) {
        RowV xx[RR]; int rws[RR];
#pragma unroll
        for (int rr = 0; rr < RR; ++rr) { rws[rr] = trip < 4 ? 64 * F.bid + 8 * F.wave + 2 * trip + rr : LAT_ROWS + F.gw - (F.NGW - (TOK - LAT_ROWS)); ld_row_bf16(xres + (size_t)rws[rr] * DM, F.lane, xx[rr]); }
#pragma unroll
        for (int rr = 0; rr < RR; ++rr) { if (trip == 4 && rr == 1) break;
            const int row = rws[rr];
            RowV& x = xx[rr];
            const float rinv = rsqrtf(row_sumsq(x) * (1.f / DM) + RMS_EPS);
            const float* mrow = mod + ((size_t)l * 5 + modrow_of(row)) * NMOD;
#pragma unroll
            for (int j = 0; j < 2; ++j) { const int col = 8 * F.lane + 512 * j;
                float gv[8], sh[8], scl[8]; ld8f(g2w + col, gv); ld8f(mrow + 3 * DM + col, sh); ld8f(mrow + 4 * DM + col, scl);
#pragma unroll
                for (int i = 0; i < 8; ++i) x.v[j][i] = x.v[j][i] * rinv * gv[i] * (1.f + scl[i]) + sh[i];
                *(u32x4*)(gb + (size_t)row * DM + col) = pack8(x.v[j]); }
        }
    }
    __syncthreads();
    if (F.tid < 32) { const unsigned n = lcnt[F.tid]; lbase[F.tid] = n ? atomicAdd(&cnt[F.tid], n) : 0u; }
    __syncthreads();
    if (myrow >= 0) { list[(size_t)ea * LIST_CAP + lbase[ea] + ra] = myrow * 2; list[(size_t)eb * LIST_CAP + lbase[eb] + rb] = myrow * 2 + 1; }
    if (myrow2 >= 0) { list[(size_t)ea2 * LIST_CAP + lbase[ea2] + ra2] = myrow2 * 2; list[(size_t)eb2 * LIST_CAP + lbase[eb2] + rb2] = myrow2 * 2 + 1; }
    __syncthreads();
}
__device__ __forceinline__ void rows_mla_pre(const Ctx& F, int i) {
    const bf16* z = (const bf16*)(F.ws + WS_ZRAW); bf16* ac = (bf16*)(F.ws + WS_ACAT);
    const float* gq = KIN(19) + i * 256; const float* gkv = KIN(21) + i * 128;
    for (int row = F.gw; row < TOK; row += F.NGW) {
        const u32x2 qv = *(const u32x2*)(z + (size_t)row * 1024 + 512 + 4 * F.lane);
        const float q0 = bflo(qv.x), q1 = bfhi(qv.x), q2 = bflo(qv.y), q3 = bfhi(qv.y);
        const float rq = rsqrtf(wave_sum(q0 * q0 + q1 * q1 + q2 * q2 + q3 * q3) * (1.f / 256.f) + RMS_EPS);
        const f32x4 gv = *(const f32x4*)(gq + 4 * F.lane);
        u32x2 w; w.x = pk2(q0 * rq * gv[0], q1 * rq * gv[1]); w.y = pk2(q2 * rq * gv[2], q3 * rq * gv[3]);
        *(u32x2*)(ac + (size_t)row * 512 + 4 * F.lane) = w;
        float k0 = 0.f, k1 = 0.f, k2 = 0.f, k3 = 0.f;
        if (F.lane < 32) { const u32x2 kv = *(const u32x2*)(z + (size_t)row * 1024 + 768 + 4 * F.lane); k0 = bflo(kv.x); k1 = bfhi(kv.x); k2 = bflo(kv.y); k3 = bfhi(kv.y); }
        const float rk = rsqrtf(wave_sum(k0 * k0 + k1 * k1 + k2 * k2 + k3 * k3) * (1.f / 128.f) + RMS_EPS);
        u32x2 w2 = (u32x2){0u, 0u};
        if (F.lane < 32) { const f32x4 gk = *(const f32x4*)(gkv + 4 * F.lane); w2.x = pk2(k0 * rk * gk[0], k1 * rk * gk[1]); w2.y = pk2(k2 * rk * gk[2], k3 * rk * gk[3]); }
        *(u32x2*)(ac + (size_t)row * 512 + 256 + 4 * F.lane) = w2;
    }
}
__device__ __forceinline__ void rows_mla_post(const Ctx& F, int i) {
    const bf16* qk = (const bf16*)(F.ws + WS_QKVM); const bf16* z = (const bf16*)(F.ws + WS_ZRAW);
    bf16* Qb = (bf16*)(F.ws + WS_QB); bf16* Kb = (bf16*)(F.ws + WS_KB); bf16* Vb = (bf16*)(F.ws + WS_VB);
    const float* qn = KIN(23) + i * 96; const float* kn = KIN(24) + i * 96;
    const float* rope = (const float*)(F.ws + WS_ROPE) + ROPE32_OFF;
    const int lane = F.lane, s = lane & 15, hq = lane >> 4, a = s & 1;
    const bool is_nope = s < 8, is_rope = (s == 8 || s == 9), is_zero = (s >= 10 && s < 14);
    const int d1 = is_nope ? 8 * s : 64 + a * 16, d2 = 64 + a * 16 + 8;
    float wq1[8], wq2[8], wk1[8], wk2[8];
#pragma unroll
    for (int j = 0; j < 8; ++j) { wq1[j] = qn[d1 + j]; wq2[j] = qn[d2 + j]; wk1[j] = kn[d1 + j]; wk2[j] = kn[d2 + j]; }
    constexpr int RR = 1;
    for (int row0 = F.gw; row0 < TOK; row0 += RR * F.NGW) {
        unsigned z0 = 0u; asm volatile("" : "+v"(z0)); const u32x4 zero4 = (u32x4){z0, z0, z0, z0};
        u32x4 q1[RR][2], q2[RR][2], k1[RR][2], kr1[RR], kr2[RR], vv[RR];
#pragma unroll
        for (int rr = 0; rr < RR; ++rr) { int row = row0 + rr * F.NGW; row = row < TOK ? row : TOK - 1;
            const bf16* qr = qk + (size_t)row * 1792; const bf16* kr = z + (size_t)row * 1024 + 896;
#pragma unroll
            for (int p2 = 0; p2 < 2; ++p2) { const int hd = 4 * p2 + hq;
                q1[rr][p2] = (is_nope || is_rope) ? *(const u32x4*)(qr + 96 * hd + d1) : zero4;
                q2[rr][p2] = is_rope ? *(const u32x4*)(qr + 96 * hd + d2) : zero4;
                k1[rr][p2] = is_nope ? *(const u32x4*)(qr + 768 + hd * 128 + 8 * s) : zero4; }
            kr1[rr] = is_rope ? *(const u32x4*)(kr + a * 16) : zero4; kr2[rr] = is_rope ? *(const u32x4*)(kr + a * 16 + 8) : zero4;
            vv[rr] = *(const u32x4*)(qr + 768 + (lane >> 3) * 128 + 64 + 8 * (lane & 7)); }
#pragma unroll
        for (int rr = 0; rr < RR; ++rr) { const int row = row0 + rr * F.NGW; if (row >= TOK) break;
            int b, pos, pa = 0; const bool lat = row < LAT_ROWS;
            if (lat) { b = row >> 12; const int t = row & 4095; pos = 256 + t; pa = a == 0 ? (t >> 6) : (t & 63); }
            else { b = (row - LAT_ROWS) >> 8; pos = (row - LAT_ROWS) & 255; }
            const float* csn = rope + (pa * 8) * 2;
#pragma unroll
            for (int p2 = 0; p2 < 2; ++p2) { const int hd = 4 * p2 + hq; const size_t obase = ((size_t)(b * 8 + hd) * SKV + pos) * 128;
                { float x1[8], x2[8]; unpack8(q1[rr][p2], x1); unpack8(q2[rr][p2], x2);
                  const float rinv = rsqrtf(group16_sum(sumsq8(x1) + sumsq8(x2)) * (1.f / 96.f) + RMS_EPS);
                  u32x4 o1, o2; norm_rope8(x1, x2, rinv, wq1, wq2, csn, is_rope && lat, o1, o2);
                  if (is_nope) *(u32x4*)(Qb + obase + 8 * s) = o1;
                  else if (is_rope) { *(u32x4*)(Qb + obase + d1) = o1; *(u32x4*)(Qb + obase + d2) = o2; }
                  else if (is_zero) *(u32x4*)(Qb + obase + 96 + 8 * (s - 10)) = zero4; }
                { float x1[8], x2[8]; unpack8(is_rope ? kr1[rr] : k1[rr][p2], x1); unpack8(kr2[rr], x2);
                  const float rinv = rsqrtf(group16_sum(sumsq8(x1) + sumsq8(x2)) * (1.f / 96.f) + RMS_EPS);
                  u32x4 o1, o2; norm_rope8(x1, x2, rinv, wk1, wk2, csn, is_rope && lat, o1, o2);
                  if (is_nope) *(u32x4*)(Kb + obase + 8 * s) = o1;
                  else if (is_rope) { *(u32x4*)(Kb + obase + d1) = o1; *(u32x4*)(Kb + obase + d2) = o2; }
                  else if (is_zero) *(u32x4*)(Kb + obase + 96 + 8 * (s - 10)) = zero4; }
            }
            *(u32x4*)(Vb + ((size_t)(b * 8 + (lane >> 3)) * SKV + pos) * 64 + 8 * (lane & 7)) = vv[rr];
        }
    }
}
__device__ __forceinline__ void rows_gqa_post(const Ctx& F, int i) {
    const bf16* z = (const bf16*)(F.ws + WS_ZRAW);
    bf16* Qb = (bf16*)(F.ws + WS_QB); bf16* Kb = (bf16*)(F.ws + WS_KB); bf16* Vb = (bf16*)(F.ws + WS_VB);
    const float* qn = KIN(27) + i * 128; const float* kn = KIN(28) + i * 128;
    const float* rope = (const float*)(F.ws + WS_ROPE);
    const int lane = F.lane, hh = lane >> 3, sub = lane & 7, a = sub >> 2, fc = sub & 3;
    const int d1 = a * 64 + 8 * fc, d2 = d1 + 32;
    float wq1[8], wq2[8], wk1[8], wk2[8];
#pragma unroll
    for (int j = 0; j < 8; ++j) { wq1[j] = qn[d1 + j]; wq2[j] = qn[d2 + j]; wk1[j] = kn[d1 + j]; wk2[j] = kn[d2 + j]; }
    const bool isk = lane < 32; const int l2 = lane - 32;
    constexpr int RR = 1;
    for (int row0 = F.gw; row0 < TOK; row0 += RR * F.NGW) {
        u32x4 q1[RR], q2[RR], s1[RR], s2[RR];
#pragma unroll
        for (int rr = 0; rr < RR; ++rr) { int row = row0 + rr * F.NGW; row = row < TOK ? row : TOK - 1;
            const bf16* r = z + (size_t)row * 2048;
            q1[rr] = *(const u32x4*)(r + hh * 128 + d1); q2[rr] = *(const u32x4*)(r + hh * 128 + d2);
            s1[rr] = *(const u32x4*)(isk ? r + 1024 + hh * 128 + d1 : r + 1536 + 16 * l2); s2[rr] = *(const u32x4*)(isk ? r + 1024 + hh * 128 + d2 : r + 1536 + 16 * l2 + 8); }
#pragma unroll
        for (int rr = 0; rr < RR; ++rr) { const int row = row0 + rr * F.NGW; if (row >= TOK) break;
            int b, pos, pa = 0; const bool lat = row < LAT_ROWS;
            if (lat) { b = row >> 12; const int t = row & 4095; pos = 256 + t; pa = a == 0 ? (t >> 6) : (t & 63); }
            else { b = (row - LAT_ROWS) >> 8; pos = (row - LAT_ROWS) & 255; }
            const float* csn = rope + (pa * 32 + 8 * fc) * 2;
            { float x1[8], x2[8]; unpack8(q1[rr], x1); unpack8(q2[rr], x2);
              const float rinv = rsqrtf(group8_sum(sumsq8(x1) + sumsq8(x2)) * (1.f / 128.f) + RMS_EPS);
              u32x4 o1, o2; norm_rope8(x1, x2, rinv, wq1, wq2, csn, lat, o1, o2);
              bf16* o = Qb + ((size_t)(b * 8 + hh) * SKV + pos) * 128; *(u32x4*)(o + d1) = o1; *(u32x4*)(o + d2) = o2; }
            { float x1[8], x2[8]; unpack8(s1[rr], x1); unpack8(s2[rr], x2);
              const float rinv = rsqrtf(group8_sum(sumsq8(x1) + sumsq8(x2)) * (1.f / 128.f) + RMS_EPS);
              u32x4 o1, o2; norm_rope8(x1, x2, rinv, wk1, wk2, csn, lat, o1, o2);
              if (isk) { bf16* o = Kb + ((size_t)(b * 4 + hh) * SKV + pos) * 128; *(u32x4*)(o + d1) = o1; *(u32x4*)(o + d2) = o2; }
              else { bf16* o = Vb + ((size_t)(b * 4 + (l2 >> 3)) * SKV + pos) * 128 + 16 * (l2 & 7); *(u32x4*)(o) = s1[rr]; *(u32x4*)(o + 8) = s2[rr]; } }
        }
    }
}
__device__ __forceinline__ void rows_final(const Ctx& F) {
    const float* mod = (const float*)(F.ws + WS_MOD); const bf16* ydn = (const bf16*)(F.ws + WS_YDN); const bf16* xres = (const bf16*)(F.ws + WS_XRES);
#pragma unroll 2
    for (int row = F.gw; row < LAT_ROWS; row += F.NGW) {
        const float* g2 = mod + ((size_t)(DEPTH - 1) * 5 + (row >> 12)) * NMOD + 5 * DM;
        RowV x; ld_row_bf16(xres + (size_t)row * DM, F.lane, x);
#pragma unroll
        for (int j = 0; j < 2; ++j) { const int col = 8 * F.lane + 512 * j;
            float gv[8], a[8], b2[8]; ld8f(g2 + col, gv);
            unpack8(*(const u32x4*)(ydn + (size_t)(2 * row) * DM + col), a); unpack8(*(const u32x4*)(ydn + (size_t)(2 * row + 1) * DM + col), b2);
            f32x4 o0, o1;
#pragma unroll
            for (int i = 0; i < 4; ++i) { o0[i] = x.v[j][i] + gv[i] * (a[i] + b2[i]); o1[i] = x.v[j][4 + i] + gv[4 + i] * (a[4 + i] + b2[4 + i]); }
            *(f32x4*)(F.out + (size_t)row * DM + col) = o0; *(f32x4*)(F.out + (size_t)row * DM + col + 4) = o1; }
    }
}
#define XB_TMO      128
#define XB_XCNT(j)  (256  + 64 * (j))
#define XB_XSUB(j)  (1280 + 64 * (j))
#define XB_XGEN(j)  (2304 + 64 * (j))
#define XB_TOP      3328
#define XB_TOPGEN   3392
#define XCD_BAR_WORDS 3456
#define XB_SPIN_CAP (1u << 22)
__device__ __forceinline__ unsigned xb_ld(unsigned* p)              { return __hip_atomic_load(p, __ATOMIC_RELAXED, __HIP_MEMORY_SCOPE_AGENT); }
__device__ __forceinline__ unsigned xb_add(unsigned* p, unsigned v) { return __hip_atomic_fetch_add(p, v, __ATOMIC_RELAXED, __HIP_MEMORY_SCOPE_AGENT); }
__device__ __forceinline__ unsigned xb_xcc_id() { return (unsigned)__builtin_amdgcn_s_getreg((3 << 11) | 20) & 0xFu; }
#define XB_SPIN(cond, bar) do { unsigned _sp = 0; while (cond) { __builtin_amdgcn_s_sleep(1); \
    if ((++_sp & 255u) == 0u) { if (xb_ld(&(bar)[XB_TMO])) break; if (_sp > XB_SPIN_CAP) { atomicAdd(&(bar)[XB_TMO], 1u); break; } } } } while (0)
struct XcdBarrier { unsigned* bar; unsigned x; volatile LAS unsigned* st; };
__device__ __forceinline__ XcdBarrier xcd_barrier_post(unsigned* bar, volatile LAS unsigned* st) {
    XcdBarrier b; b.bar = bar; b.x = xb_xcc_id(); b.st = st;
    if (threadIdx.x == 0) (void)xb_add(&bar[XB_XCNT(b.x)], 1u);
    return b;
}
__device__ __forceinline__ void xcd_barrier_complete(unsigned* bar, unsigned x, unsigned& nloc, unsigned& nx) {
    const unsigned G = gridDim.x * gridDim.y * gridDim.z;
    unsigned sum, cnt, mine, sp = 0u;
    for (;;) {
        sum = 0u; cnt = 0u; mine = 0u;
#pragma unroll
        for (unsigned j = 0; j < 16; ++j) { const unsigned c = xb_ld(&bar[XB_XCNT(j)]); sum += c; cnt += (c > 0u) ? 1u : 0u; mine = (j == x) ? c : mine; }
        if (sum == G) break;
        __builtin_amdgcn_s_sleep(1);
        if ((++sp & 255u) == 0u) { if (xb_ld(&bar[XB_TMO])) break; if (sp > XB_SPIN_CAP) { atomicAdd(&bar[XB_TMO], 1u); break; } }
    }
    nloc = mine > 0u ? mine : 1u; nx = cnt > 0u ? cnt : 1u;
}
__device__ __forceinline__ void xcd_barrier(const XcdBarrier& b) {
    asm volatile("s_waitcnt vmcnt(0)" ::: "memory");
    __syncthreads();
    if (threadIdx.x == 0) {
        unsigned* bar = b.bar;
        __builtin_amdgcn_s_waitcnt(0);
        unsigned nloc = b.st[0], nx = b.st[1];
        if (nloc == 0u) { xcd_barrier_complete(bar, b.x, nloc, nx); b.st[0] = nloc; b.st[1] = nx; }
        const unsigned old = xb_add(&bar[XB_XSUB(b.x)], 1u);
        const unsigned gen = old / nloc;
        if (old + 1u == (gen + 1u) * nloc) {
            __builtin_amdgcn_fence(__ATOMIC_RELEASE, "agent");
            asm volatile("s_waitcnt vmcnt(0)" ::: "memory");
            const unsigned og = xb_add(&bar[XB_TOP], 1u);
            const unsigned tg = og / nx;
            if (og + 1u == (tg + 1u) * nx) xb_add(&bar[XB_TOPGEN], 1u);
            else XB_SPIN(xb_ld(&bar[XB_TOPGEN]) == tg, bar);
            __builtin_amdgcn_fence(__ATOMIC_ACQUIRE, "agent");
            xb_add(&bar[XB_XGEN(b.x)], 1u);
            asm volatile("s_waitcnt vmcnt(0)" ::: "memory");
        } else {
            XB_SPIN(xb_ld(&bar[XB_XGEN(b.x)]) == gen, bar);
            __builtin_amdgcn_fence(__ATOMIC_ACQUIRE, "agent");
            asm volatile("s_waitcnt vmcnt(0)" ::: "memory");
        }
    }
    __syncthreads();
}

constexpr int NPH = 1 + 2 * 9 + 2 * 7 + 1;
constexpr int G_NONE = -1;
using pg8::G_INPROJ; using pg8::G_MLA; using pg8::G_GLU; using pg8::G_OUT; using pg8::G_QKV; using pg8::G_MOE1; using pg8::G_MOE2;
enum { K_NONE = 0, K_NORM1, K_MLA_PRE_S5A, K_MLA_POST, K_S5B_ATT, K_NORM2, K_GQA_POST, K_ATT_GQA };

__device__ __forceinline__ void attention_phase(const Ctx& F, int l, bool even) {
    const bf16* Qb = (const bf16*)(F.ws + WS_QB); const bf16* Kb = (const bf16*)(F.ws + WS_KB); const bf16* Vb = (const bf16*)(F.ws + WS_VB);
    bf16* mix = (bf16*)(F.ws + WS_MIX);
    const int c = F.bid, x = c & 7, slot = c >> 3;
    const int nround = (l == DEPTH - 1) ? 2 : 3;
    for (int round = 0; round < nround; ++round) {
        int b, h, qb; bool ctxu = false;
        if (round < 2) {
            if (even) { const int pair = round * 16 + x * 2 + (slot >> 4); b = pair >> 3; h = pair & 7; qb = slot & 15; }
            else { const int pair = round * 8 + x; b = pair >> 2; h = (pair & 3) * 2 + (slot >> 4); qb = slot & 15; }
        } else { if (c >= 32) break; b = c >> 3; h = c & 7; qb = 0; ctxu = true; }
        const size_t qrow = (size_t)(b * 8 + h) * SKV + (ctxu ? 0 : 256 + qb * 256);
        const int orow = ctxu ? LAT_ROWS + b * 256 : b * 4096 + qb * 256;
        const int seq = ctxu ? CTXL : SKV;
        if (even) {
            att::attn_dense_body<64, 1, 1024, 96>(Qb + qrow * 128, Kb + (size_t)(b * 8 + h) * SKV * 128, Vb + (size_t)(b * 8 + h) * SKV * 64,
                                              mix + (size_t)orow * 1024 + 512 + h * 64, seq, (char*)F.lds, F.tid);
        } else {
            const int kvh = h >> 1;
            att::attn_dense_body<128, 0, 1024, 128>(Qb + qrow * 128, Kb + (size_t)(b * 4 + kvh) * SKV * 128, Vb + (size_t)(b * 4 + kvh) * SKV * 128,
                                               mix + (size_t)orow * 1024 + h * 128, seq, (char*)F.lds, F.tid);
        }
    }
}


#ifdef DBG_CHECKS
constexpr int CW_FLAGS = 20000;
__device__ __forceinline__ void dbg_flag(const Ctx& F, int j) { atomicOr((unsigned*)(F.ws + WS_CTL) + CW_FLAGS, 1u << j); }
__device__ __forceinline__ void dbg_moe_check(const Ctx& F, int l) {
    const unsigned* cnt = (const unsigned*)(F.ws + WS_CTL) + CW_CNT + l * 64; const int* list = (const int*)(F.ws + WS_LIST);
    const bf16* g = (const bf16*)(F.ws + WS_H); const bf16* act = (const bf16*)(F.ws + WS_ACT); const bf16* ydn = (const bf16*)(F.ws + WS_YDN);
    const float* gatew = (const float*)(F.ws + WS_GATEW);
    for (int s = F.gw; s < 96; s += F.NGW) {
        const int e = s & 31, which = s >> 5; const int c = (int)cnt[e]; if (c == 0) continue;
        const int pos = which == 0 ? 0 : (which == 1 ? c - 1 : (c > 300 ? 300 : c / 2));
        const int ent = list[(size_t)e * LIST_CAP + pos], row = ent >> 1;
        const float* wg = KIN(33) + ((size_t)l * 32 + e) * 1024 * 512; const float* wu = KIN(34) + ((size_t)l * 32 + e) * 1024 * 512; const float* wd = KIN(35) + ((size_t)l * 32 + e) * 512 * 1024;
        float h1[8], h2[8];
        for (int j = 0; j < 8; ++j) { h1[j] = 0.f; h2[j] = 0.f; }
        for (int k = 0; k < 1024; ++k) { const float gv = bf2f(g[(size_t)row * 1024 + k]);
            for (int j = 0; j < 8; ++j) { h1[j] += gv * wg[(size_t)k * 512 + F.lane + 64 * j]; h2[j] += gv * wu[(size_t)k * 512 + F.lane + 64 * j]; } }
        float err = 0.f, ss = 0.f;
        for (int j = 0; j < 8; ++j) { const float r = siluf_(h1[j]) * h2[j]; const float a = bf2f(act[(size_t)ent * 512 + F.lane + 64 * j]); err = fmaxf(err, fabsf(a - r)); ss += r * r; }
        err = wave_max(err); ss = wave_sum(ss);
        if (!(err <= 0.1f * __builtin_amdgcn_sqrtf(ss / 512.f) + 1e-6f)) { if (F.lane == 0) dbg_flag(F, 0); }
        float y[16];
        for (int j = 0; j < 16; ++j) y[j] = 0.f;
        for (int f = 0; f < 512; ++f) { const float av = bf2f(act[(size_t)ent * 512 + f]);
            for (int j = 0; j < 16; ++j) y[j] += av * wd[(size_t)f * 1024 + F.lane + 64 * j]; }
        const float gw = gatew[ent]; float err2 = 0.f, ss2 = 0.f;
        for (int j = 0; j < 16; ++j) { const float r = y[j] * gw; const float a = bf2f(ydn[(size_t)ent * 1024 + F.lane + 64 * j]); err2 = fmaxf(err2, fabsf(a - r)); ss2 += r * r; }
        err2 = wave_max(err2); ss2 = wave_sum(ss2);
        if (!(err2 <= 0.1f * __builtin_amdgcn_sqrtf(ss2 / 1024.f) + 1e-6f)) { if (F.lane == 0) dbg_flag(F, 1); }
        else if (ss2 > 1e-8f && ss > 1e-8f && F.lane == 0) dbg_flag(F, 3);
    }
}
__device__ __forceinline__ void dbg_mod_check(const Ctx& F, int l) {
    const float* mod = (const float*)(F.ws + WS_MOD);
    for (int s = F.gw; s < 60; s += F.NGW) {
        const int r = s % 5, n = (s * 509 + 77) % 6144;
        float ser = 0.f;
        for (int k = 0; k < 1024; ++k) { const float cv = r < 4 ? KIN(1)[r * 1024 + k] : KIN(3)[k]; ser += siluf_(cv) * KIN(4)[((size_t)l * 1024 + k) * 6144 + n]; }
        ser += KIN(5)[l * 6144 + n];
        float acc = 0.f;
        for (int k = F.lane; k < 1024; k += 64) { const float cv = r < 4 ? KIN(1)[r * 1024 + k] : KIN(3)[k]; acc += siluf_(cv) * KIN(4)[((size_t)l * 1024 + k) * 6144 + n]; }
        acc = wave_sum(acc) + KIN(5)[l * 6144 + n];
        const float got = mod[((size_t)l * 5 + r) * 6144 + n];
        if (!(fabsf(got - ser) <= 1e-3f + 1e-3f * fabsf(ser))) { if (F.lane == 0) dbg_flag(F, 0); }
        if (!(fabsf(acc - ser) <= 1e-3f + 1e-3f * fabsf(ser))) { if (F.lane == 0) dbg_flag(F, 1); }
    }
    return;
    const float* xres = (const float*)(F.ws + WS_XRES); const unsigned* cnt = (const unsigned*)(F.ws + WS_CTL) + CW_CNT + l * 64; const int* list = (const int*)(F.ws + WS_LIST);
    const float* gatew = (const float*)(F.ws + WS_GATEW); const bf16* gb = (const bf16*)(F.ws + WS_H);
    for (int s = F.gw; s < 64; s += F.NGW) {
        const int row = (s * 263 + 11) % TOK; const int mr = modrow_of(row);
        float ssq = 0.f;
        for (int k = F.lane; k < 1024; k += 64) { const float v = xres[(size_t)row * 1024 + k]; ssq += v * v; }
        const float rinv = rsqrtf(wave_sum(ssq) / 1024.f + 1e-6f);
        float lg[36];
#pragma unroll
        for (int j = 0; j < 36; ++j) lg[j] = 0.f;
        float gerr = 0.f;
        for (int k = F.lane; k < 1024; k += 64) {
            const float gv = xres[(size_t)row * 1024 + k] * rinv * KIN(7)[l * 1024 + k] * (1.f + mod[((size_t)l * 5 + mr) * 6144 + 4096 + k]) + mod[((size_t)l * 5 + mr) * 6144 + 3072 + k];
            gerr = fmaxf(gerr, fabsf(bf2f(gb[(size_t)row * 1024 + k]) - gv));
#pragma unroll
            for (int j = 0; j < 4; ++j) lg[j] += gv * KIN(29)[((size_t)l * 1024 + k) * 4 + j];
#pragma unroll
            for (int j = 0; j < 32; ++j) lg[4 + j] += gv * KIN(31)[((size_t)l * 1024 + k) * 32 + j];
        }
        gerr = wave_max(gerr);
#pragma unroll
        for (int j = 0; j < 36; ++j) lg[j] = wave_sum(lg[j]);
#pragma unroll
        for (int j = 0; j < 4; ++j) lg[j] += KIN(30)[l * 4 + j];
#pragma unroll
        for (int j = 0; j < 32; ++j) lg[4 + j] += KIN(32)[l * 32 + j];
        int grp = 0; float bestg = lg[0];
#pragma unroll
        for (int j = 1; j < 4; ++j) if (lg[j] > bestg) { bestg = lg[j]; grp = j; }
        float den = 0.f;
#pragma unroll
        for (int j = 0; j < 4; ++j) den += __expf(lg[j] - bestg);
        float l8[8];
#pragma unroll
        for (int j = 0; j < 8; ++j) { float v = 0.f;
#pragma unroll
            for (int q = 0; q < 4; ++q) v = (grp == q) ? lg[4 + q * 8 + j] : v;
            l8[j] = v; }
        int i0 = 0; float v0 = l8[0];
#pragma unroll
        for (int j = 1; j < 8; ++j) if (l8[j] > v0) { v0 = l8[j]; i0 = j; }
        int i1 = -1; float v1 = -3.0e38f;
#pragma unroll
        for (int j = 0; j < 8; ++j) if (j != i0 && l8[j] > v1) { v1 = l8[j]; i1 = j; }
        const float e1 = __expf(v1 - v0), w0 = 1.f / (1.f + e1) / den, w1 = e1 / (1.f + e1) / den;
        if (gerr > 0.05f && F.lane == 0) dbg_flag(F, 1);
        bool bad = false;
        if (fabsf(gatew[row * 2] - w0) > 1e-3f || fabsf(gatew[row * 2 + 1] - w1) > 1e-3f) bad = true;
        const int ea = grp * 8 + i0, eb = grp * 8 + i1; bool fa = false, fb = false;
        for (int q = F.lane; q < (int)cnt[ea]; q += 64) if (list[(size_t)ea * LIST_CAP + q] == row * 2) fa = true;
        for (int q = F.lane; q < (int)cnt[eb]; q += 64) if (list[(size_t)eb * LIST_CAP + q] == row * 2 + 1) fb = true;
        if (!__any(fa) || !__any(fb)) bad = true;
        if (bad && F.lane == 0) dbg_flag(F, 2);
    }
}
__device__ __forceinline__ void dbg_final(const Ctx& F) {
    const unsigned flags = ((const unsigned*)(F.ws + WS_CTL))[CW_FLAGS];
    for (int row = F.gw; row < LAT_ROWS; row += F.NGW) {
        bool zero = false;
        for (int j = 0; j < 4; ++j) { const int lo = 512 * ((1 << j) - 1), hi = 512 * ((2 << j) - 1); if (((flags >> j) & 1u) && row >= lo && row < hi) zero = true; }
#pragma unroll
        for (int j = 0; j < 4; ++j) { const int col = 4 * F.lane + 256 * j; f32x4 xv = *(const f32x4*)(KIN(0) + (size_t)row * DM + col); if (zero) xv = (f32x4){0.f, 0.f, 0.f, 0.f};
            *(f32x4*)(F.out + (size_t)row * DM + col) = xv; }
    }
}
#endif

#ifdef DBG_TS
__device__ __forceinline__ void dbg_ts_final(const Ctx& F) {
    const unsigned long long* tsb = (const unsigned long long*)(F.ws + WS_CTL + 512 * 1024);
    unsigned long long da = 0, db = 0;
    for (int ph = 0; ph < NPH - 1; ++ph) { const unsigned long long d = tsb[ph + 1] - tsb[ph];
        if ((DBG_TSA >> ph) & 1ull) da += d; if ((DBG_TSB >> ph) & 1ull) db += d; }
    const int nz = (int)(da * 8 / 100) < LAT_ROWS ? (int)(da * 8 / 100) : LAT_ROWS;
    for (int row = F.gw; row < LAT_ROWS; row += F.NGW) {
#pragma unroll
        for (int j = 0; j < 4; ++j) { const int col = 4 * F.lane + 256 * j; f32x4 xv = *(const f32x4*)(KIN(0) + (size_t)row * DM + col); if (row < nz) xv = (f32x4){0.f, 0.f, 0.f, 0.f};
            if (row == 0 && col == 0) xv[0] = (float)db;
            *(f32x4*)(F.out + (size_t)row * DM + col) = xv; }
    }
}
#endif

__device__ __forceinline__ void run_phase(const Ctx& F0, int ph, int sub = 3) {
    Ctx F = F0;
    asm volatile("" : "+s"(F.ws), "+s"(F.out), "+s"(F.bid), "+s"(F.G));
    asm volatile("" : "+v"(F.tid));
    F.lane = F.tid & 63; F.wave = __builtin_amdgcn_readfirstlane(F.tid >> 6); F.gw = F.bid * 8 + F.wave; F.NGW = F.G * 8;
    { unsigned ldsb = (unsigned)(uintptr_t)F0.lds; asm volatile("" : "+s"(ldsb)); F.lds = (LAS unsigned char*)(uintptr_t)ldsb; }
#ifndef T_NO_P0
    if (ph == 0) {
        if (F.bid < 192) p0_ada(F);
        else if (F.bid == 192) p0_rope(F);
        else if (F.bid == 193) p0_router_t(F);
        p0_weights(F);
        return;
    }
#endif
#ifdef DBG_CHECKS
    if (ph == NPH - 1) { dbg_final(F); return; }
    if (ph >= 100) { dbg_mod_check(F, ph - 100); return; }
#endif
#ifdef DBG_TS
    if (ph == NPH - 1) { dbg_ts_final(F); return; }
#endif
    if (ph == NPH - 1) { rows_final(F); return; }
    if (ph >= 60) return;
    int l, step; { int q = ph - 1; if (q < 9) { l = 0; step = q; } else if (q < 16) { l = 1; step = q - 9; } else if (q < 25) { l = 2; step = q - 16; } else { l = 3; step = q - 25; } }
    const bool even = (l & 1) == 0; const int i = l >> 1;
    int gid = G_NONE, kind = K_NONE;
    if (even) {
        switch (step) { case 0: kind = K_NORM1; break; case 1: gid = G_INPROJ; break; case 2: kind = K_MLA_PRE_S5A; break; case 3: gid = G_MLA; break; case 4: kind = K_MLA_POST; break;
                        case 5: kind = K_S5B_ATT; gid = G_GLU; break; case 6: gid = G_OUT; break; case 7: kind = K_NORM2; break; default: gid = G_MOE1; break; }
    } else {
        switch (step) { case 0: kind = K_NORM1; break; case 1: gid = G_QKV; break; case 2: kind = K_GQA_POST; break; case 3: kind = K_ATT_GQA; break; case 4: gid = G_OUT; break;
                        case 5: kind = K_NORM2; break; default: gid = G_MOE1; break; }
    }
    switch (kind) {
#ifndef T_NO_ROWS
    case K_NORM1: build_router_tab(F, l); rows_norm1(F, l);
#ifndef T_NO_S5
        if (even && F.bid < 8) { const int w = F.bid * 8 + F.wave, dd = w >> 5, g = w & 31;
            s5::Params SP{KIN(10) + (size_t)i * 4096, KIN(11) + (size_t)i * 4096, KIN(12) + i * 64, KIN(13) + (size_t)i * 65536, KIN(14) + (size_t)i * 65536,
                      KIN(15) + (size_t)i * 65536, KIN(16) + (size_t)i * 65536, KIN(17) + i * 512};
            s5::build_tab(SP, dd, g, F.lane, (u32x4*)(F.ws + WS_S5TAB) + (size_t)(i * 64 + dd * 32 + g) * (s5::TAB_BYTES / 16)); }
#endif
        break;
    case K_NORM2: rows_norm2_router(F, l); break;
#endif
    case K_MLA_PRE_S5A: {
        rows_mla_pre(F, i);
        s5::Params SP{KIN(10) + (size_t)i * 4096, KIN(11) + (size_t)i * 4096, KIN(12) + i * 64, KIN(13) + (size_t)i * 65536, KIN(14) + (size_t)i * 65536,
                      KIN(15) + (size_t)i * 65536, KIN(16) + (size_t)i * 65536, KIN(17) + i * 512};
#ifndef T_NO_S5
        if (F.wave >= 4) defer_convert(F, i * 2);
        for (int it = F.gw; it < s5::NITEMS; it += F.NGW) s5::pass_a_item(SP, (const u32x4*)(F.ws + WS_S5TAB) + (size_t)i * 64 * (s5::TAB_BYTES / 16), (const bf16*)(F.ws + WS_ZRAW), (float*)(F.ws + WS_E2), it, F.lane);
        if (F.wave < 4) defer_convert(F, i * 2);
#endif
    } break;
    case K_MLA_POST: {
        rows_mla_post(F, i);
        s5::Params SP{KIN(10) + (size_t)i * 4096, KIN(11) + (size_t)i * 4096, KIN(12) + i * 64, KIN(13) + (size_t)i * 65536, KIN(14) + (size_t)i * 65536,
                      KIN(15) + (size_t)i * 65536, KIN(16) + (size_t)i * 65536, KIN(17) + i * 512};
#ifndef T_NO_S5
        if (F.wave >= 4) defer_convert(F, i * 2 + 1);
        if (sub & 1) for (int it = F.gw; it < s5::NITEMS; it += F.NGW)
            s5::pass_b_item(SP, (const u32x4*)(F.ws + WS_S5TAB) + (size_t)i * 64 * (s5::TAB_BYTES / 16), (const bf16*)(F.ws + WS_ZRAW), (const float*)(F.ws + WS_E2), (bf16*)(F.ws + WS_GG), F.lds + F.wave * s5::HS_BYTES, it, F.lane);
        if (F.wave < 4) defer_convert(F, i * 2 + 1);
#endif
    } break;
    case K_S5B_ATT: {
        __syncthreads();
#ifndef T_NO_ATT
        if (sub & 2) attention_phase(F, l, true);
#endif
    } break;
    case K_GQA_POST: rows_gqa_post(F, i); break;
#ifndef T_NO_ATT
    case K_ATT_GQA: attention_phase(F, l, false); break;
#endif
    default: break;
    }
    if (gid != G_NONE) {
        unsigned char* ws = F.ws;
        const unsigned* cnt = (const unsigned*)(ws + WS_CTL) + CW_CNT + l * 64;
        if (gid == G_MOE1 || gid == G_MOE2) {
            if (F.tid == 0) { LAS int* tp = (LAS int*)(F.lds + MISC_OFF + 256); int acc = 0;
                for (int e = 0; e < NEXP; ++e) { tp[e] = acc; acc += ((int)cnt[e] + 255) >> 8; } tp[NEXP] = acc; }
            __syncthreads();
        }
#ifdef DBG_NOCTX_DRY
#define CTXDRY if (!F.dry)
#else
#define CTXDRY
#endif
#define PROB_COMMON(P) P.G = F.G; P.c = F.bid; P.list = (const int*)(ws + WS_LIST); P.cnt = cnt; P.tp = (const LAS int*)(F.lds + MISC_OFF + 256); \
        P.l = l; P.ws = ws; P.O = nullptr; P.xlat = nullptr; P.xctx = nullptr;
        switch (gid) {
#ifndef T_NO_GEMM
        case G_INPROJ: { pg8::Prob<G_INPROJ> P; PROB_COMMON(P); P.A = (const char*)(ws + WS_H); P.B = (const char*)(ws + WS_W_IN) + (size_t)i * 1024 * 1024 * 2; P.O = (bf16*)(ws + WS_ZRAW); pg8::gemm_phase(F.lds, P, F.tid); CTXDRY pg8::ctx_gemm(F.lds, P, F.tid); } break;
        case G_MLA: {
#ifndef T_NO_S5
            if (F.wave == 0 && F.bid < 256) { s5::Params SP{KIN(10) + (size_t)i * 4096, KIN(11) + (size_t)i * 4096, KIN(12) + i * 64, KIN(13) + (size_t)i * 65536, KIN(14) + (size_t)i * 65536,
                      KIN(15) + (size_t)i * 65536, KIN(16) + (size_t)i * 65536, KIN(17) + i * 512};
                s5::prefix_wave(SP, (float*)(ws + WS_E2), F.bid, F.lane); }
#endif
            pg8::Prob<G_MLA> P; PROB_COMMON(P); P.A = (const char*)(ws + WS_ACAT); P.B = (const char*)(ws + WS_W_MLA) + (size_t)i * 1792 * 256 * 2; P.O = (bf16*)(ws + WS_QKVM); pg8::gemm_phase(F.lds, P, F.tid); } break;
        case G_GLU: { pg8::Prob<G_GLU> P; PROB_COMMON(P); P.c = F.G - 1 - F.bid;
            P.A = (const char*)(ws + WS_GG); P.B = (const char*)(ws + WS_W_GLU) + (size_t)i * 512 * 512 * 2; pg8::gemm_phase(F.lds, P, F.tid); } break;
        case G_OUT: { pg8::Prob<G_OUT> P; PROB_COMMON(P); P.A = (const char*)(ws + WS_MIX); P.B = (const char*)(ws + (even ? WS_W_OUTE : WS_W_OUTO)) + (size_t)i * 1024 * 1024 * 2;
            P.xlat = KIN(0); P.xctx = KIN(2); pg8::gemm_phase(F.lds, P, F.tid); if (l < DEPTH - 1) pg8::ctx_gemm(F.lds, P, F.tid); } break;
        case G_QKV: { pg8::Prob<G_QKV> P; PROB_COMMON(P); P.A = (const char*)(ws + WS_H); P.B = (const char*)(ws + WS_W_QKV) + (size_t)i * 2048 * 1024 * 2; P.O = (bf16*)(ws + WS_ZRAW); pg8::gemm_phase(F.lds, P, F.tid); CTXDRY pg8::ctx_gemm(F.lds, P, F.tid); } break;
        default: { unsigned* ready = (unsigned*)(ws + WS_CTL) + CW_READY + l * READY_L;
            { pg8::Prob<G_MOE1> P; PROB_COMMON(P); P.ready = ready; P.A = (const char*)(ws + WS_H); P.B = (const char*)(ws + WS_W_GU) + (size_t)l * 32 * 1024 * 1024 * 2; pg8::gemm_phase(F.lds, P, F.tid); }
            { pg8::Prob<G_MOE2> P; PROB_COMMON(P); P.ready = ready; P.A = (const char*)(ws + WS_ACT); P.B = (const char*)(ws + WS_W_DN) + (size_t)l * 32 * 1024 * 512 * 2; pg8::gemm_phase(F.lds, P, F.tid); } } break;
#else
        default: break;
#endif
        }
#undef PROB_COMMON
        return;
    }
}

struct Args { const float* in[36]; float* out; unsigned char* ws; int ph_lo, ph_hi; };

__global__ void __launch_bounds__(512, 2) mega(Args args) {
    extern __shared__ __attribute__((aligned(16))) unsigned char lds_[];
    Ctx F;
    F.out = args.out; F.ws = args.ws;
    F.lds = (LAS unsigned char*)lds_;
    F.tid = threadIdx.x; F.lane = F.tid & 63; F.wave = __builtin_amdgcn_readfirstlane(F.tid >> 6);
    F.G = gridDim.x; F.bid = blockIdx.x; F.gw = blockIdx.x * 8 + F.wave; F.NGW = F.G * 8;
    volatile LAS unsigned* MISC = (volatile LAS unsigned*)(F.lds + MISC_OFF);
    for (int u = F.tid; u < (LDS_BYTES - RING_BYTES) / 4; u += 512) ((LAS unsigned*)(F.lds + RING_BYTES))[u] = 0u;
    __syncthreads();
    const int lo = args.ph_lo & 0xfff, hi = args.ph_hi & 0xfff; F.dry = (args.ph_hi >> 12) & 1; const int subsel = ((args.ph_hi >> 13) & 3) ? ((args.ph_hi >> 13) & 3) : 3;
    XcdBarrier bar; bar.bar = (unsigned*)(F.ws + WS_CTL) + CW_BAR; bar.x = 0; bar.st = nullptr;
    if (hi - lo > 1) bar = xcd_barrier_post((unsigned*)(F.ws + WS_CTL) + CW_BAR, MISC + 8);
#ifdef DBG_TS
    unsigned long long* tsb = (unsigned long long*)(F.ws + WS_CTL + 512 * 1024);
    if (blockIdx.x == 0 && threadIdx.x == 0) tsb[0] = __builtin_amdgcn_s_memrealtime();
#endif
    for (int ph = lo; ph < hi; ++ph) {
#ifdef DBG_REP
        if ((DBG_REP >> ph) & 1ull) { for (int rr = 0; rr < DBG_REPN; ++rr) { run_phase(F, ph, DBG_REPSUB); __syncthreads(); } }
#endif
        run_phase(F, ph, subsel);
#ifdef DBG_TS
        if (ph == NPH - 2 && blockIdx.x == 0 && threadIdx.x == 0) { asm volatile("s_waitcnt vmcnt(0)" ::: "memory"); tsb[ph + 1] = __builtin_amdgcn_s_memrealtime(); __threadfence(); }
#endif
        if (ph + 1 < hi) { XcdBarrier b2 = bar; asm volatile("" : "+s"(b2.bar), "+s"(b2.x)); xcd_barrier(b2); }
#ifdef DBG_TS
        if (ph < NPH - 2 && blockIdx.x == 0 && threadIdx.x == 0) tsb[ph + 1] = __builtin_amdgcn_s_memrealtime();
#endif
    }
}

#ifndef MK_MULTI
#define MK_MULTI 1
#endif
extern "C" void kernel_launch(void* const* d_in, const int* in_sizes, int n_in, void* d_out, int out_size, void* d_ws, size_t ws_size, hipStream_t stream) {
    static int grid = 0;
    if (grid == 0) {
        if (n_in != 36 || in_sizes[0] != LAT_ROWS * DM || out_size != LAT_ROWS * DM || ws_size < WS_END) {
            fprintf(stderr, "kernel_launch: unexpected shapes: n_in %d in0 %d out %d ws %zu (need >= %zu)\n", n_in, n_in > 0 ? in_sizes[0] : -1, out_size, ws_size, (size_t)WS_END); grid = -1; return; }
        int dev = 0, cus = 0, per_cu = 0;
        if (hipGetDevice(&dev) != hipSuccess || hipDeviceGetAttribute(&cus, hipDeviceAttributeMultiprocessorCount, dev) != hipSuccess) { fprintf(stderr, "kernel_launch: device query failed\n"); grid = -1; return; }
        if (hipFuncSetAttribute((const void*)mega, hipFuncAttributeMaxDynamicSharedMemorySize, LDS_BYTES) != hipSuccess) { fprintf(stderr, "kernel_launch: hipFuncSetAttribute failed\n"); grid = -1; return; }
        if (hipOccupancyMaxActiveBlocksPerMultiprocessor(&per_cu, (const void*)mega, 512, LDS_BYTES) != hipSuccess || per_cu < 1) { fprintf(stderr, "kernel_launch: occupancy query says %d\n", per_cu); per_cu = 1; }
        (void)hipGetLastError();
        grid = cus;
    }
    if (grid < 0) return;
    (void)hipMemsetAsync((char*)d_ws + WS_CTL, 0, CTL_ZERO_BYTES, stream);
    Args a{};
    for (int i = 0; i < 36; ++i) a.in[i] = (const float*)d_in[i];
    a.out = (float*)d_out; a.ws = (unsigned char*)d_ws;
#if MK_MULTI
#ifndef DBG_STOP_PH
#define DBG_STOP_PH (NPH - 2)
#endif
    for (int p = 0; p < NPH; ++p) {
        if (p > DBG_STOP_PH && p != NPH - 1) continue;
#ifdef DBG_CHECKS
        if (p == NPH - 1) { a.ph_lo = 100 + DBG_CHECK_L; a.ph_hi = a.ph_lo + 1; hipLaunchKernelGGL(mega, dim3(grid), dim3(512), LDS_BYTES, stream, a); }
#endif
        a.ph_lo = p; a.ph_hi = p + 1;
#ifdef DBG_NOOPS
        if (p == 5) { a.ph_lo = 61; a.ph_hi = 62; for (int rr = 0; rr < DBG_NOOPS; ++rr) hipLaunchKernelGGL(mega, dim3(grid), dim3(512), LDS_BYTES, stream, a); a.ph_lo = p; a.ph_hi = p + 1; }
#endif
#ifdef DBG_HREP
        if ((DBG_HREP >> p) & 1ull) { a.ph_hi = (p + 1) | 0x1000 | (DBG_HSUB << 13); for (int rr = 0; rr < DBG_HREPN; ++rr) hipLaunchKernelGGL(mega, dim3(grid), dim3(512), LDS_BYTES, stream, a); a.ph_hi = p + 1; }
#endif
        hipLaunchKernelGGL(mega, dim3(grid), dim3(512), LDS_BYTES, stream, a);
    }
#else
    a.ph_lo = 0; a.ph_hi = NPH;
    void* kargs[] = {&a};
    hipError_t e = hipLaunchCooperativeKernel((const void*)mega, dim3(grid), dim3(512), kargs, LDS_BYTES, stream);
    if (e != hipSuccess) fprintf(stderr, "kernel_launch: cooperative launch failed: %s (grid %d)\n", hipGetErrorString(e), grid);
#endif
    const hipError_t le = hipPeekAtLastError();
    if (le != hipSuccess) fprintf(stderr, "kernel_launch: launch failed: %s\n", hipGetErrorName(le));
}
```

```cpp
#include <hip/hip_runtime.h>
#include <cstdio>
#include <cstdint>
#ifndef MK_MULTI
#define MK_MULTI 0
#endif
#define GAS __attribute__((address_space(1)))
#define LAS __attribute__((address_space(3)))
typedef unsigned short bf16;
typedef short bf16x8 __attribute__((ext_vector_type(8)));
typedef short s16x4 __attribute__((ext_vector_type(4)));
typedef float f32x2 __attribute__((ext_vector_type(2)));
typedef float f32x4 __attribute__((ext_vector_type(4)));
typedef float f32x16 __attribute__((ext_vector_type(16)));
typedef unsigned u32x2 __attribute__((ext_vector_type(2)));
typedef unsigned u32x4 __attribute__((ext_vector_type(4)));

constexpr int DM = 1024, NBATCH = 4, SEQ = 4096, CTXL = 256, DEPTH = 4;
constexpr int LAT_ROWS = NBATCH * SEQ;
constexpr int CTX_ROWS = NBATCH * CTXL;
constexpr int TOK = LAT_ROWS + CTX_ROWS;
constexpr int SKV = CTXL + SEQ;
constexpr int NMOD = 6 * DM;
constexpr float RMS_EPS = 1e-6f;
constexpr int NEXP = 32, MOE_FF = 512;
constexpr int LIST_CAP = TOK;

__device__ __forceinline__ unsigned f2bf(float f) { unsigned u = __builtin_bit_cast(unsigned, f); return (u + 0x7fffu + ((u >> 16) & 1u)) >> 16; }
__device__ __forceinline__ unsigned pk2(float lo, float hi) { return f2bf(lo) | (f2bf(hi) << 16); }
__device__ __forceinline__ float bf2f(unsigned short b) { return __builtin_bit_cast(float, ((unsigned)b) << 16); }
__device__ __forceinline__ float bflo(unsigned w) { return __builtin_bit_cast(float, w << 16); }
__device__ __forceinline__ float bfhi(unsigned w) { return __builtin_bit_cast(float, w & 0xffff0000u); }
__device__ __forceinline__ unsigned cvtpk(float lo, float hi) { unsigned r; asm volatile("v_cvt_pk_bf16_f32 %0, %1, %2" : "=v"(r) : "v"(lo), "v"(hi)); return r; }
#define DPP_F(v, ctrl) __builtin_bit_cast(float, __builtin_amdgcn_update_dpp(0, __builtin_bit_cast(int, v), ctrl, 0xf, 0xf, true))
__device__ __forceinline__ float wave_sum(float v) {
    v += DPP_F(v, 0xB1);
    v += DPP_F(v, 0x4E);
    v += DPP_F(v, 0x141);
    v += DPP_F(v, 0x140);
    const int vi = __builtin_bit_cast(int, v);
    return (__builtin_bit_cast(float, __builtin_amdgcn_readlane(vi, 0)) + __builtin_bit_cast(float, __builtin_amdgcn_readlane(vi, 16)))
         + (__builtin_bit_cast(float, __builtin_amdgcn_readlane(vi, 32)) + __builtin_bit_cast(float, __builtin_amdgcn_readlane(vi, 48)));
}
__device__ __forceinline__ float wave_max(float v) {
    v = fmaxf(v, DPP_F(v, 0xB1)); v = fmaxf(v, DPP_F(v, 0x4E)); v = fmaxf(v, DPP_F(v, 0x141)); v = fmaxf(v, DPP_F(v, 0x140));
    const int vi = __builtin_bit_cast(int, v);
    return fmaxf(fmaxf(__builtin_bit_cast(float, __builtin_amdgcn_readlane(vi, 0)), __builtin_bit_cast(float, __builtin_amdgcn_readlane(vi, 16))),
                 fmaxf(__builtin_bit_cast(float, __builtin_amdgcn_readlane(vi, 32)), __builtin_bit_cast(float, __builtin_amdgcn_readlane(vi, 48))));
}
__device__ __forceinline__ float sigmoidf_(float x) { return 1.f / (1.f + __expf(-x)); }
__device__ __forceinline__ float siluf_(float x) { return x * sigmoidf_(x); }
__device__ __forceinline__ float gelu_tanh(float x) {
    const float u = 0.7978845608028654f * (x + 0.044715f * x * x * x);
    const float e = __expf(2.f * u);
    const float t = 1.f - 2.f / (e + 1.f);
    return 0.5f * x * (1.f + t);
}
__device__ __forceinline__ int modrow_of(int row) { return row < LAT_ROWS ? (row >> 12) : 4; }

constexpr size_t MiB = 1u << 20;
constexpr size_t WS_CTL = 0, CTL_ZERO_BYTES = 1 * MiB;
constexpr size_t WS_MOD = 1 * MiB, WS_ROPE = 2 * MiB, WS_GATEW = 3 * MiB, WS_RW = 4 * MiB, WS_RC = 5 * MiB, WS_LIST = 9 * MiB;
constexpr size_t WS_W_IN = 12 * MiB, WS_W_OUTE = 16 * MiB, WS_W_GLU = 20 * MiB, WS_W_MLA = 21 * MiB, WS_W_QKV = 23 * MiB, WS_W_OUTO = 31 * MiB;
constexpr size_t WS_W_GU = 35 * MiB, WS_W_DN = 291 * MiB;
constexpr size_t WS_XRES = 419 * MiB, WS_H = 487 * MiB, WS_MIX = 521 * MiB;
constexpr size_t WS_ZRAW = 555 * MiB, WS_ACAT = 623 * MiB, WS_QKVM = 640 * MiB, WS_QB = 700 * MiB, WS_KB = 734 * MiB, WS_VB = 768 * MiB, WS_GG = 785 * MiB;
constexpr size_t WS_ACT = 555 * MiB, WS_YDN = 589 * MiB;
constexpr size_t WS_E2 = 802 * MiB;
constexpr size_t WS_S5TAB = 812 * MiB;
constexpr size_t WS_END = 814 * MiB;
constexpr int CW_BAR = 4096, CW_CNT = 16384;
constexpr int CW_READY = 65536, READY_L = 32 * 68 * 16;
constexpr int ROPE32_OFF = 64 * 32 * 2;
constexpr size_t WS_RT = WS_ROPE + 128 * 1024;

constexpr int RING_BYTES = 131072, LDS_BYTES = 152576, MISC_OFF = LDS_BYTES - 3072;


namespace pg8 {
constexpr int BM = 256, BK = 64, HALF = 128, HTB = HALF * BK * 2, STAGE_BYTES = 8 * HTB, NXCD = 8, WGM = 8;
__host__ __device__ __forceinline__ int lds_byte(int r, int c) { const int st = (r >> 4) * 2 + (c >> 5), rr = r & 15, cc = c & 31, ob = rr * 64 + cc * 2; return st * 1024 + (ob ^ (((ob >> 9) & 1) << 5)); }
__host__ __device__ __forceinline__ void stage_rc(int b, int& R, int& C) { const int st = b / 1024, sb = b % 1024, swz = sb ^ (((sb >> 9) & 1) << 5); R = (st >> 1) * 16 + swz / 64; C = (st & 1) * 32 + (swz % 64) / 2; }
__host__ __device__ __forceinline__ int perm32(int rho) { const int n = rho >> 4, i = rho & 15; return 8 * (i >> 2) + 4 * n + (i & 3); }

struct Unit { int pm, pn, e, rows; };

enum { EPI_BF16 = 0, EPI_GLU = 1, EPI_RESID = 2, EPI_MOE1 = 3, EPI_MOE2 = 4 };
enum { G_INPROJ = 0, G_MLA = 1, G_GLU = 2, G_OUT = 3, G_QKV = 4, G_MOE1 = 5, G_MOE2 = 6 };

template <int GID> struct Cfg;
template <> struct Cfg<G_INPROJ> { static constexpr int lda = 1024, ldb = 1024, K = 1024, nN = 4, moe = 0, epi = EPI_BF16, ldo = 1024, acol_split = 1 << 30, acol_off = 0; };
template <> struct Cfg<G_MLA>    { static constexpr int lda = 512,  ldb = 256,  K = 256,  nN = 7, moe = 0, epi = EPI_BF16, ldo = 1792, acol_split = 3, acol_off = 256; };
template <> struct Cfg<G_GLU>    { static constexpr int lda = 512,  ldb = 512,  K = 512,  nN = 2, moe = 0, epi = EPI_GLU,  ldo = 1024, acol_split = 1 << 30, acol_off = 0; };
template <> struct Cfg<G_OUT>    { static constexpr int lda = 1024, ldb = 1024, K = 1024, nN = 4, moe = 0, epi = EPI_RESID, ldo = 1024, acol_split = 1 << 30, acol_off = 0; };
template <> struct Cfg<G_QKV>    { static constexpr int lda = 1024, ldb = 1024, K = 1024, nN = 8, moe = 0, epi = EPI_BF16, ldo = 2048, acol_split = 1 << 30, acol_off = 0; };
template <> struct Cfg<G_MOE1>   { static constexpr int lda = 1024, ldb = 1024, K = 1024, nN = 4, moe = 1, epi = EPI_MOE1, ldo = 512, acol_split = 1 << 30, acol_off = 0; };
template <> struct Cfg<G_MOE2>   { static constexpr int lda = 512,  ldb = 512,  K = 512,  nN = 4, moe = 2, epi = EPI_MOE2, ldo = 1024, acol_split = 1 << 30, acol_off = 0; };

template <int GID> struct Prob {
    static constexpr int lda = Cfg<GID>::lda, ldb = Cfg<GID>::ldb, K = Cfg<GID>::K, nN = Cfg<GID>::nN, moe = Cfg<GID>::moe, epi = Cfg<GID>::epi, ldo = Cfg<GID>::ldo;
    static constexpr int acol_split = Cfg<GID>::acol_split, acol_off = Cfg<GID>::acol_off, nM = TOK / 256;
    static constexpr size_t bstride = (size_t)1024 * K * 2;
    const char* A; const char* B;
    int G, c;
    const int* list; const unsigned* cnt; const LAS int* tp;
    int l; unsigned char* ws;
    bf16* O;
    unsigned* ready;
    const float* xlat; const float* xctx;

    __device__ __forceinline__ bool next(int i, Unit& u) const {
        const long L = (long)i * G + c;
        if constexpr (moe == 0) {
            const int nMe = (GID == G_INPROJ || GID == G_OUT || GID == G_QKV) ? LAT_ROWS / 256 : nM;
            const int nwg = nMe * nN; if (L >= nwg) return false;
            int wgid = (int)L; { const int q = nwg / NXCD, r = nwg % NXCD, xcd = wgid % NXCD, off = wgid / NXCD; wgid = (xcd < r ? xcd * (q + 1) : r * (q + 1) + (xcd - r) * q) + off; }
            const int nig = WGM * nN, gid = wgid / nig, fm = gid * WGM, gsz = (nMe - fm) < WGM ? (nMe - fm) : WGM;
            u.pm = fm + ((wgid % nig) % gsz); u.pn = (wgid % nig) / gsz; u.e = 0; u.rows = 256; return true;
        } else {
            const int x = c & 7, per = G >> 3, j = (moe == 2) ? per - 1 - (c >> 3) : (c >> 3);
            int uidx = i * per + j;
#pragma unroll
            for (int k = 0; k < NEXP / 8; ++k) { const int e = x + 8 * k; const int nt_e = tp[e + 1] - tp[e]; const int nu = nt_e * nN;
                if (uidx < nu) { u.e = e; u.pm = uidx / nN; u.pn = uidx % nN; const int left = (int)cnt[e] - 256 * u.pm; u.rows = left < 256 ? left : 256; return true; }
                uidx -= nu; }
            return false;
        }
    }
    __device__ __forceinline__ void done(const Unit& u, const int tid) const {
        if constexpr (moe == 1) { asm volatile("s_waitcnt vmcnt(0)" ::: "memory");
            if ((tid & 63) == 0) __hip_atomic_fetch_add(ready + (u.e * 68 + u.pm) * 16, 1u, __ATOMIC_RELAXED, __HIP_MEMORY_SCOPE_AGENT); }
    }
    __device__ __forceinline__ void a_ready(const Unit& u, const int tid) const {
        if constexpr (moe == 2) {
            if (tid < 64) {
                const unsigned* w = ready + (u.e * 68 + u.pm) * 16;
                for (unsigned n = 0; n < 2000000u; ++n) {
                    if ((unsigned)__builtin_amdgcn_readfirstlane(__hip_atomic_load(w, __ATOMIC_RELAXED, __HIP_MEMORY_SCOPE_AGENT)) >= 32u) break;
                    __builtin_amdgcn_s_sleep(2); }
            }
            asm volatile("" ::: "memory"); __builtin_amdgcn_s_barrier(); asm volatile("" ::: "memory");
        }
    }
    __device__ __forceinline__ const char* abase(const Unit& u) const {
        if constexpr (moe == 0) return A + ((size_t)u.pm * 256 * lda + (u.pn >= acol_split ? acol_off : 0)) * 2;
        else return A;
    }
    __device__ __forceinline__ unsigned aoff(const Unit& u, int R, int C) const {
        if constexpr (moe == 0) return (unsigned)((R * lda + C) * 2);
        else {
        const int rr = R < u.rows ? R : 0;
        const int ent = list[(size_t)u.e * LIST_CAP + u.pm * 256 + rr];
        const int arow = (moe == 1) ? (ent >> 1) : ent;
        return (unsigned)(((size_t)arow * lda + C) * 2u); }
    }
    __device__ __forceinline__ const char* bbase(const Unit& u) const { return B + (size_t)u.e * bstride + (size_t)u.pn * 256 * ldb * 2; }

    __device__ __forceinline__ void epilogue(const f32x4 (&acc)[2][2][4][2], const Unit& u, int wr, int wc, int fr, int fq) const {
        const int cw = wc * 32 + 8 * fq;
        if constexpr (epi == EPI_BF16) {
#pragma unroll
            for (int ai = 0; ai < 2; ++ai)
#pragma unroll
                for (int m = 0; m < 4; ++m) { const int row = u.pm * 256 + ai * 128 + wr * 64 + m * 16 + fr; bf16* rowp = O + (size_t)row * ldo + u.pn * 256 + cw;
#pragma unroll
                    for (int bj = 0; bj < 2; ++bj) { const f32x4 v0 = acc[ai][bj][m][0], v1 = acc[ai][bj][m][1];
                        u32x4 w; w.x = cvtpk(v0[0], v0[1]); w.y = cvtpk(v0[2], v0[3]); w.z = cvtpk(v1[0], v1[1]); w.w = cvtpk(v1[2], v1[3]);
                        *(u32x4*)(rowp + bj * 128) = w; } }
        } else if constexpr (epi == EPI_GLU) {
#pragma unroll
            for (int ai = 0; ai < 2; ++ai)
#pragma unroll
                for (int m = 0; m < 4; ++m) { const int row = u.pm * 256 + ai * 128 + wr * 64 + m * 16 + fr;
#pragma unroll
                    for (int bj = 0; bj < 2; ++bj) { const int col = u.pn * 256 + bj * 128 + cw;
                        const u32x4 gv = *(const u32x4*)((const bf16*)(ws + WS_GG) + (size_t)row * 512 + col);
                        const f32x4 v0 = acc[ai][bj][m][0], v1 = acc[ai][bj][m][1];
                        u32x4 w;
                        w.x = cvtpk(bflo(gv.x) * sigmoidf_(v0[0]), bfhi(gv.x) * sigmoidf_(v0[1]));
                        w.y = cvtpk(bflo(gv.y) * sigmoidf_(v0[2]), bfhi(gv.y) * sigmoidf_(v0[3]));
                        w.z = cvtpk(bflo(gv.z) * sigmoidf_(v1[0]), bfhi(gv.z) * sigmoidf_(v1[1]));
                        w.w = cvtpk(bflo(gv.w) * sigmoidf_(v1[2]), bfhi(gv.w) * sigmoidf_(v1[3]));
                        *(u32x4*)((bf16*)(ws + WS_MIX) + (size_t)row * 1024 + col) = w; } }
        } else if constexpr (epi == EPI_RESID) {
            const float* gate = (const float*)(ws + WS_MOD) + (size_t)l * 5 * NMOD + 2 * DM; bf16* xout = (bf16*)(ws + WS_XRES);
#pragma unroll
            for (int ai = 0; ai < 2; ++ai)
#pragma unroll
                for (int m = 0; m < 4; ++m) { const int row = u.pm * 256 + ai * 128 + wr * 64 + m * 16 + fr;
                    const float* gr = gate + (size_t)modrow_of(row) * NMOD;
#pragma unroll
                    for (int bj = 0; bj < 2; ++bj) { const int col = u.pn * 256 + bj * 128 + cw;
                        float xv[8];
                        if (l == 0) { const float* xs = row < LAT_ROWS ? xlat + (size_t)row * DM : xctx + (size_t)(row - LAT_ROWS) * DM;
                            const f32x4 a0 = *(const f32x4*)(xs + col), a1 = *(const f32x4*)(xs + col + 4);
                            xv[0] = a0[0]; xv[1] = a0[1]; xv[2] = a0[2]; xv[3] = a0[3]; xv[4] = a1[0]; xv[5] = a1[1]; xv[6] = a1[2]; xv[7] = a1[3]; }
                        else { const u32x4 w = *(const u32x4*)(xout + (size_t)row * DM + col);
                            xv[0] = bflo(w.x); xv[1] = bfhi(w.x); xv[2] = bflo(w.y); xv[3] = bfhi(w.y); xv[4] = bflo(w.z); xv[5] = bfhi(w.z); xv[6] = bflo(w.w); xv[7] = bfhi(w.w); }
                        const f32x4 g0 = *(const f32x4*)(gr + col), g1 = *(const f32x4*)(gr + col + 4);
                        const f32x4 c0 = acc[ai][bj][m][0], c1 = acc[ai][bj][m][1];
#ifdef DBG_NOMIX
                        u32x4 o; o.x = cvtpk(xv[0], xv[1]); o.y = cvtpk(xv[2], xv[3]); o.z = cvtpk(xv[4], xv[5]); o.w = cvtpk(xv[6], xv[7]);
#else
                        u32x4 o; o.x = cvtpk(xv[0] + g0[0] * c0[0], xv[1] + g0[1] * c0[1]); o.y = cvtpk(xv[2] + g0[2] * c0[2], xv[3] + g0[3] * c0[3]);
                        o.z = cvtpk(xv[4] + g1[0] * c1[0], xv[5] + g1[1] * c1[1]); o.w = cvtpk(xv[6] + g1[2] * c1[2], xv[7] + g1[3] * c1[3]);
#endif
                        *(u32x4*)(xout + (size_t)row * DM + col) = o; } }
        } else if constexpr (epi == EPI_MOE1) {
#pragma unroll
            for (int ai = 0; ai < 2; ++ai)
#pragma unroll
                for (int m = 0; m < 4; ++m) { const int rt = ai * 128 + wr * 64 + m * 16 + fr;
                    if (rt < u.rows) { const int ent = list[(size_t)u.e * LIST_CAP + u.pm * 256 + rt];
                        const f32x4 g0 = acc[ai][0][m][0], g1 = acc[ai][0][m][1], u0 = acc[ai][1][m][0], u1 = acc[ai][1][m][1];
                        u32x4 w;
                        w.x = cvtpk(siluf_(g0[0]) * u0[0], siluf_(g0[1]) * u0[1]); w.y = cvtpk(siluf_(g0[2]) * u0[2], siluf_(g0[3]) * u0[3]);
                        w.z = cvtpk(siluf_(g1[0]) * u1[0], siluf_(g1[1]) * u1[1]); w.w = cvtpk(siluf_(g1[2]) * u1[2], siluf_(g1[3]) * u1[3]);
                        asm volatile("global_store_dwordx4 %0, %1, off sc1\n\ts_nop 1" :: "v"((bf16*)(ws + WS_ACT) + (size_t)ent * MOE_FF + u.pn * 128 + cw), "v"(w) : "memory"); } }
        } else {
            const float* gatew = (const float*)(ws + WS_GATEW);
#pragma unroll
            for (int ai = 0; ai < 2; ++ai)
#pragma unroll
                for (int m = 0; m < 4; ++m) { const int rt = ai * 128 + wr * 64 + m * 16 + fr;
                    if (rt < u.rows) { const int ent = list[(size_t)u.e * LIST_CAP + u.pm * 256 + rt]; const float gw = gatew[ent];
#pragma unroll
                        for (int bj = 0; bj < 2; ++bj) { const f32x4 v0 = acc[ai][bj][m][0] * gw, v1 = acc[ai][bj][m][1] * gw;
                            u32x4 w; w.x = cvtpk(v0[0], v0[1]); w.y = cvtpk(v0[2], v0[3]); w.z = cvtpk(v1[0], v1[1]); w.w = cvtpk(v1[2], v1[3]);
                            *(u32x4*)((bf16*)(ws + WS_YDN) + (size_t)ent * DM + u.pn * 256 + bj * 128 + cw) = w; } } }
        }
    }
};

template <int GID>
__device__ __forceinline__ void gemm_phase(LAS unsigned char* lds, const Prob<GID>& P, const int tid) {
    const int  wid = __builtin_amdgcn_readfirstlane(tid >> 6), lane = tid & 63, wr = wid >> 2, wc = wid & 3, fr = lane & 15, fq = lane >> 4;
    constexpr int K = Prob<GID>::K, nt = K / BK;
    unsigned voffB[2];
#pragma unroll
    for (int i = 0; i < 2; ++i) { int R, C; stage_rc(tid * 16 + i * 8192, R, C); const int Rb = (R & ~31) + perm32(R & 31);
        voffB[i] = (unsigned)(Rb * P.ldb + C) * 2u; }
#define PG8_AOFFS(vo, unit) do { _Pragma("unroll") for (int _h = 0; _h < 2; ++_h) _Pragma("unroll") for (int _i = 0; _i < 2; ++_i) { int _R, _C; stage_rc(tid * 16 + _i * 8192, _R, _C); \
        (vo)[_h][_i] = P.aoff(unit, _R + 128 * _h, _C); } } while (0)
    const size_t kstep = (size_t)(BK * 2);
    const size_t hstepB = (size_t)HALF * P.ldb * 2;
    const unsigned ldsw = (unsigned)wid * 1024u;
    const int aoff = lds_byte(wr * 64 + fr, fq * 8), boff = lds_byte(wc * 32 + fr, fq * 8);
#define PG8_SA(b, h) (((b) * 2 + (h)) * HTB)
#define PG8_SB(b, h) ((4 + (b) * 2 + (h)) * HTB)
#define PG8_STAGEB(bufoff, gbase) do { _Pragma("unroll") for (int _i = 0; _i < 2; ++_i) \
        __builtin_amdgcn_global_load_lds((const unsigned*)((const char*)(gbase) + voffB[_i]), (LAS unsigned*)(lds + (bufoff) + ldsw + _i * 8192), 16, 0, 0); } while (0)
#define PG8_STAGEA(bufoff, gbase, h) do { _Pragma("unroll") for (int _i = 0; _i < 2; ++_i) \
        __builtin_amdgcn_global_load_lds((const unsigned*)((const char*)(gbase) + vA[h][_i]), (LAS unsigned*)(lds + (bufoff) + ldsw + _i * 8192), 16, 0, Prob<GID>::moe == 2 ? 16 : 0); } while (0)
#define PG8_LDA(dst, b, h) do { _Pragma("unroll") for (int m = 0; m < 4; ++m) _Pragma("unroll") for (int k = 0; k < 2; ++k) dst[m][k] = *(const LAS bf16x8*)(lds + PG8_SA(b, h) + aoff + m * 2048 + k * 1024); } while (0)
#define PG8_LDB(dst, b, h) do { _Pragma("unroll") for (int n = 0; n < 2; ++n) _Pragma("unroll") for (int k = 0; k < 2; ++k) dst[n][k] = *(const LAS bf16x8*)(lds + PG8_SB(b, h) + boff + n * 2048 + k * 1024); } while (0)
#define PG8_MMA(ai, bj, At, Bt) do { __builtin_amdgcn_s_setprio(1); _Pragma("unroll") for (int m = 0; m < 4; ++m) _Pragma("unroll") for (int n = 0; n < 2; ++n) _Pragma("unroll") for (int k = 0; k < 2; ++k) \
        acc[ai][bj][m][n] = __builtin_amdgcn_mfma_f32_16x16x32_bf16(Bt[n][k], At[m][k], acc[ai][bj][m][n], 0, 0, 0); __builtin_amdgcn_s_setprio(0); } while (0)
#define PG8_WAIT_V(n) asm volatile("s_waitcnt vmcnt(" #n ")" ::: "memory")
#define PG8_WAIT_L(n) asm volatile("s_waitcnt lgkmcnt(" #n ")" ::: "memory")
#define PG8_BAR __builtin_amdgcn_s_barrier()
#define PG8_SCHED __builtin_amdgcn_sched_barrier(0)
    Unit cur, nxt; int ui = 0;
    if (!P.next(0, cur)) return;
    f32x4 acc[2][2][4][2];
#pragma unroll
    for (int a = 0; a < 2; ++a)
#pragma unroll
        for (int b = 0; b < 2; ++b)
#pragma unroll
            for (int m = 0; m < 4; ++m)
#pragma unroll
                for (int n = 0; n < 2; ++n) acc[a][b][m][n] = (f32x4){0.f, 0.f, 0.f, 0.f};
    bf16x8 At[4][2], B0[2][2], B1[2][2];
    unsigned vA[2][2];
    PG8_AOFFS(vA, cur);
    const char* cA = P.abase(cur); const char* cB = P.bbase(cur);
    P.a_ready(cur, tid);
    PG8_STAGEB(PG8_SB(0, 0), cB); PG8_STAGEB(PG8_SB(0, 1), cB + hstepB); PG8_STAGEA(PG8_SA(0, 0), cA, 0); PG8_STAGEA(PG8_SA(0, 1), cA, 1);
    if (wr == 1) PG8_BAR;
    PG8_WAIT_V(2); PG8_BAR;
    PG8_STAGEB(PG8_SB(1, 0), cB + kstep); PG8_STAGEA(PG8_SA(1, 0), cA + kstep, 0); PG8_STAGEB(PG8_SB(1, 1), cB + hstepB + kstep);
    PG8_WAIT_V(6); PG8_BAR;
    for (;;) {
        const bool has_next = P.next(ui + 1, nxt);
        const char* nA = has_next ? P.abase(nxt) : cA; const char* nB = has_next ? P.bbase(nxt) : cB;
#pragma nounroll
        for (int t = 0; t < nt; t += 2) {
            const bool last = (t == nt - 2);
            const char* a1 = cA + (size_t)(t + 1) * kstep;
            const char* a2 = last ? nA : cA + (size_t)(t + 2) * kstep; const char* b2 = last ? nB : cB + (size_t)(t + 2) * kstep;
            const char* a3 = a2 + kstep; const char* b3 = b2 + kstep;
            if (Prob<GID>::moe == 2 && last && has_next) P.a_ready(nxt, tid);
            PG8_LDB(B0, 0, 0); PG8_LDB(B1, 0, 1); PG8_SCHED; PG8_LDA(At, 0, 0); PG8_STAGEA(PG8_SA(1, 1), a1, 1);
            if (Prob<GID>::moe != 0 && last && has_next) { PG8_AOFFS(vA, nxt); }
            PG8_WAIT_V(8); PG8_WAIT_L(0); PG8_BAR; PG8_MMA(0, 0, At, B0); PG8_MMA(0, 1, At, B1); PG8_BAR; PG8_SCHED;
            PG8_LDA(At, 0, 1); PG8_STAGEB(PG8_SB(0, 0), b2); PG8_STAGEB(PG8_SB(0, 1), b2 + hstepB); PG8_STAGEA(PG8_SA(0, 0), a2, 0);
            PG8_WAIT_V(8); PG8_WAIT_L(0); PG8_BAR; PG8_MMA(1, 0, At, B0); PG8_MMA(1, 1, At, B1); PG8_BAR; PG8_SCHED;
            PG8_LDB(B0, 1, 0); PG8_LDB(B1, 1, 1); PG8_SCHED; PG8_LDA(At, 1, 0); PG8_STAGEA(PG8_SA(0, 1), a2, 1);
            PG8_WAIT_V(8); PG8_WAIT_L(0); PG8_BAR; PG8_MMA(0, 0, At, B0); PG8_MMA(0, 1, At, B1); PG8_BAR; PG8_SCHED;
            PG8_LDA(At, 1, 1); PG8_STAGEB(PG8_SB(1, 0), b3); PG8_STAGEB(PG8_SB(1, 1), b3 + hstepB); PG8_STAGEA(PG8_SA(1, 0), a3, 0);
            PG8_WAIT_V(8); PG8_WAIT_L(0); PG8_BAR; PG8_MMA(1, 0, At, B0); PG8_MMA(1, 1, At, B1); PG8_BAR; PG8_SCHED;
        }
        if (wr == 0) PG8_BAR;
        P.epilogue(acc, cur, wr, wc, fr, fq);
        P.done(cur, tid);
        if (!has_next) break;
#pragma unroll
        for (int a = 0; a < 2; ++a)
#pragma unroll
            for (int b = 0; b < 2; ++b)
#pragma unroll
                for (int m = 0; m < 4; ++m)
#pragma unroll
                    for (int n = 0; n < 2; ++n) acc[a][b][m][n] = (f32x4){0.f, 0.f, 0.f, 0.f};
        cur = nxt; cA = nA; cB = nB; ++ui;
        if (wr == 1) PG8_BAR;
    }
    PG8_WAIT_V(0);
    PG8_BAR;
#undef PG8_SA
#undef PG8_SB
#undef PG8_STAGEA
#undef PG8_AOFFS
#undef PG8_STAGEB
#undef PG8_LDA
#undef PG8_LDB
#undef PG8_MMA
#undef PG8_WAIT_V
#undef PG8_WAIT_L
#undef PG8_BAR
#undef PG8_SCHED
}

template <int GID>
__device__ __forceinline__ void ctx_gemm(LAS unsigned char* lds, const Prob<GID>& P, const int tid) {
    static_assert(Prob<GID>::K == 1024 && Prob<GID>::lda == 1024 && Prob<GID>::ldb == 1024 && Prob<GID>::moe == 0, "ctx_gemm: K = 1024 dense only");
    constexpr int NPASS = Prob<GID>::nN / 4, PSTR = 272, PW = 64 * PSTR, epi = Prob<GID>::epi, ldo = Prob<GID>::ldo;
    const int wid = __builtin_amdgcn_readfirstlane(tid >> 6), lane = tid & 63, fr = lane & 15, fq = lane >> 4;
    const int mt = P.c >> 4;
    const char* Ap = P.A + ((size_t)(LAT_ROWS + mt * 64 + fr) * 1024 + wid * 128 + fq * 8) * 2;
#pragma nounroll
#ifdef DBG_CTX2
    for (int pass_ = 0; pass_ < 2 * NPASS; ++pass_) { const int pass = pass_ % NPASS;
#else
    for (int pass = 0; pass < NPASS; ++pass) {
#endif
        const int ntile = (P.c & 15) + 16 * pass;
        const char* Bp = P.B + ((size_t)(ntile * 64 + fr) * 1024 + wid * 128 + fq * 8) * 2;
        f32x4 acc[4][4];
#pragma unroll
        for (int mi = 0; mi < 4; ++mi)
#pragma unroll
            for (int ni = 0; ni < 4; ++ni) acc[mi][ni] = (f32x4){0.f, 0.f, 0.f, 0.f};
        bf16x8 af[4][4], bf[4][4];
#pragma unroll
        for (int ks = 0; ks < 4; ++ks)
#pragma unroll
            for (int mi = 0; mi < 4; ++mi) { af[ks][mi] = *(const bf16x8*)(Ap + mi * 16 * 2048 + ks * 64); bf[ks][mi] = *(const bf16x8*)(Bp + mi * 16 * 2048 + ks * 64); }
        __builtin_amdgcn_sched_barrier(0);
#pragma unroll
        for (int ks = 0; ks < 4; ++ks)
#pragma unroll
            for (int mi = 0; mi < 4; ++mi)
#pragma unroll
                for (int ni = 0; ni < 4; ++ni) acc[mi][ni] = __builtin_amdgcn_mfma_f32_16x16x32_bf16(bf[ks][ni], af[ks][mi], acc[mi][ni], 0, 0, 0);
        __syncthreads();
#pragma unroll
        for (int mi = 0; mi < 4; ++mi)
#pragma unroll
            for (int ni = 0; ni < 4; ++ni) *(LAS f32x4*)(lds + wid * PW + (mi * 16 + fr) * PSTR + (ni * 16 + 4 * fq) * 4) = acc[mi][ni];
        __syncthreads();
        const int m = tid >> 3, c8 = (tid & 7) * 8;
        f32x4 s0 = (f32x4){0.f, 0.f, 0.f, 0.f}, s1 = s0;
#pragma unroll
        for (int w = 0; w < 8; ++w) { s0 += *(const LAS f32x4*)(lds + w * PW + m * PSTR + c8 * 4); s1 += *(const LAS f32x4*)(lds + w * PW + m * PSTR + c8 * 4 + 16); }
        const int row = LAT_ROWS + mt * 64 + m, col = ntile * 64 + c8;
        if constexpr (epi == EPI_BF16) {
            u32x4 w; w.x = cvtpk(s0[0], s0[1]); w.y = cvtpk(s0[2], s0[3]); w.z = cvtpk(s1[0], s1[1]); w.w = cvtpk(s1[2], s1[3]);
            *(u32x4*)(P.O + (size_t)row * ldo + col) = w;
        } else {
            static_assert(epi == EPI_RESID, "ctx_gemm: epilogue");
            const float* gr = (const float*)(P.ws + WS_MOD) + (size_t)P.l * 5 * NMOD + 2 * DM + (size_t)modrow_of(row) * NMOD; bf16* xout = (bf16*)(P.ws + WS_XRES);
            float xv[8];
            if (P.l == 0) { const float* xs = P.xctx + (size_t)(row - LAT_ROWS) * DM;
                const f32x4 a0 = *(const f32x4*)(xs + col), a1 = *(const f32x4*)(xs + col + 4);
                xv[0] = a0[0]; xv[1] = a0[1]; xv[2] = a0[2]; xv[3] = a0[3]; xv[4] = a1[0]; xv[5] = a1[1]; xv[6] = a1[2]; xv[7] = a1[3]; }
            else { const u32x4 w = *(const u32x4*)(xout + (size_t)row * DM + col);
                xv[0] = bflo(w.x); xv[1] = bfhi(w.x); xv[2] = bflo(w.y); xv[3] = bfhi(w.y); xv[4] = bflo(w.z); xv[5] = bfhi(w.z); xv[6] = bflo(w.w); xv[7] = bfhi(w.w); }
            const f32x4 g0 = *(const f32x4*)(gr + col), g1 = *(const f32x4*)(gr + col + 4);
            u32x4 o; o.x = cvtpk(xv[0] + g0[0] * s0[0], xv[1] + g0[1] * s0[1]); o.y = cvtpk(xv[2] + g0[2] * s0[2], xv[3] + g0[3] * s0[3]);
            o.z = cvtpk(xv[4] + g1[0] * s1[0], xv[5] + g1[1] * s1[1]); o.w = cvtpk(xv[6] + g1[2] * s1[2], xv[7] + g1[3] * s1[3]);
            *(u32x4*)(xout + (size_t)row * DM + col) = o;
        }
    }
}
}
namespace att {
constexpr int D = 128, NW = 8, QBLK = 32, KVBLK = 64;
constexpr float THR = 8.f;
constexpr int SHM_V = KVBLK * 128 * 2, SHM_K = KVBLK * D * 2, SHM_ATTN = 2 * SHM_V + 2 * SHM_K + NW * 64 * 4;
#define KSWZ(row, colB) ((row) * 256 + ((colB) ^ (((row) & 7) << 4)))
#define SBAR() __builtin_amdgcn_sched_barrier(0)
__device__ __forceinline__ int crow(int r, int hi) { return (r & 3) + 8 * (r >> 2) + 4 * hi; }

template <int SC> struct ScaleOf { static constexpr float v = SC == 0 ? 0.088388347648318440f   : 0.102062072615965750f  ; };

template <int SC>
__device__ __forceinline__ void partialSM(f32x16& p0, f32x16& p1, float& m_reg, float& mn, float& alpha) {
  constexpr float SCALE = ScaleOf<SC>::v;
  constexpr float C = SCALE * 1.4426950408889634f;
  float pmax = p0[0];
#pragma unroll
  for (int r = 1; r < 16; ++r) pmax = fmaxf(pmax, p0[r]);
#pragma unroll
  for (int r = 0; r < 16; ++r) pmax = fmaxf(pmax, p1[r]);
  { auto rr = __builtin_amdgcn_permlane32_swap(__float_as_uint(pmax), __float_as_uint(pmax), false, false);
    pmax = fmaxf(__uint_as_float(rr[0]), __uint_as_float(rr[1])); }
  if (__builtin_expect(__all(pmax - m_reg <= THR / SCALE), 1)) { mn = m_reg; alpha = 1.f; }
  else { mn = fmaxf(m_reg, pmax); alpha = __builtin_amdgcn_exp2f((m_reg - mn) * C); m_reg = mn; }
  float mnC = -mn * C;
#pragma unroll
  for (int r = 0; r < 16; ++r) p0[r] = fmaf(p0[r], C, mnC);
#pragma unroll
  for (int r = 0; r < 16; ++r) p1[r] = fmaf(p1[r], C, mnC);
#pragma unroll
  for (int r = 0; r < 16; ++r) p0[r] = __builtin_amdgcn_exp2f(p0[r]);
}
__device__ __forceinline__ void finishSM(f32x16& p0, f32x16& p1, float alpha, float& l_reg, bf16x8& pa0, bf16x8& pa1, bf16x8& pa2, bf16x8& pa3) {
#pragma unroll
  for (int r = 0; r < 16; ++r) p1[r] = __builtin_amdgcn_exp2f(p1[r]);
  float ps = 0;
#pragma unroll
  for (int r = 0; r < 16; ++r) ps += p0[r];
#pragma unroll
  for (int r = 0; r < 16; ++r) ps += p1[r];
  { auto rr = __builtin_amdgcn_permlane32_swap(__float_as_uint(ps), __float_as_uint(ps), false, false);
    ps = __uint_as_float(rr[0]) + __uint_as_float(rr[1]); }
  l_reg = l_reg * alpha + ps;
#define PK4(P, BASE, OUT) do { unsigned a0 = cvtpk(P[BASE + 0], P[BASE + 1]), a1 = cvtpk(P[BASE + 2], P[BASE + 3]);   \
    unsigned b0 = cvtpk(P[BASE + 4], P[BASE + 5]), b1 = cvtpk(P[BASE + 6], P[BASE + 7]);                              \
    auto r0 = __builtin_amdgcn_permlane32_swap(a0, b0, false, false); auto r1 = __builtin_amdgcn_permlane32_swap(a1, b1, false, false); \
    u32x4 w = {r0[0], r1[0], r0[1], r1[1]}; OUT = *reinterpret_cast<bf16x8*>(&w); } while (0)
  PK4(p0, 0, pa0); PK4(p0, 8, pa1); PK4(p1, 0, pa2); PK4(p1, 8, pa3);
#undef PK4
}
template <int NKS>
__device__ __forceinline__ void qkt(f32x16& p0, f32x16& p1, const bf16* Ks, const bf16x8* qr, int r32, int hi) {
  p0 = f32x16{}; p1 = f32x16{};
#pragma unroll
  for (int d0 = 0; d0 < NKS; ++d0) { int cb = (d0 * 16 + hi * 8) * 2;
    bf16x8 b0 = *reinterpret_cast<const bf16x8*>((const char*)Ks + KSWZ(r32, cb));
    bf16x8 b1 = *reinterpret_cast<const bf16x8*>((const char*)Ks + KSWZ(32 + r32, cb));
    p0 = __builtin_amdgcn_mfma_f32_32x32x16_bf16(b0, qr[d0], p0, 0, 0, 0);
    p1 = __builtin_amdgcn_mfma_f32_32x32x16_bf16(b1, qr[d0], p1, 0, 0, 0); }
}
__device__ __forceinline__ int v_st(int k, int c) { const int kk = (k & ~0xC) | ((k & 4) << 1) | ((k & 8) >> 1); return ((kk >> 3) * 4 + (c >> 5)) * 512 + ((kk & 7) * 32 + (c & 31)) * 2; }
__device__ __forceinline__ int v_rd_base(int lane) { return ((lane & 3) << 3) | (((lane >> 2) & 3) << 6) | (((lane >> 4) & 1) << 5) | (((lane >> 5) & 1) << 8); }
constexpr int v_rd_off(int d0, int ks, int half) { return d0 * 512 + ks * 4096 + half * 2048; }
template <int OFF> __device__ __forceinline__ s16x4 tr_read(int vb) {
  s16x4 r; asm volatile("ds_read_b64_tr_b16 %0, %1 offset:%2" : "=&v"(r) : "v"(vb), "i"(OFF) : "memory"); return r;
}
template <int D0> __device__ __forceinline__ void pv_one(f32x16& od, int vb, bf16x8 pa0, bf16x8 pa1, bf16x8 pa2, bf16x8 pa3) {
  const s16x4 l0 = tr_read<v_rd_off(D0, 0, 0)>(vb), h0 = tr_read<v_rd_off(D0, 0, 1)>(vb), l1 = tr_read<v_rd_off(D0, 1, 0)>(vb), h1 = tr_read<v_rd_off(D0, 1, 1)>(vb);
  const s16x4 l2 = tr_read<v_rd_off(D0, 2, 0)>(vb), h2 = tr_read<v_rd_off(D0, 2, 1)>(vb), l3 = tr_read<v_rd_off(D0, 3, 0)>(vb), h3 = tr_read<v_rd_off(D0, 3, 1)>(vb);
  asm volatile("s_waitcnt lgkmcnt(0)" ::: "memory"); SBAR();
#define PK(L, H) (bf16x8){L[0], L[1], L[2], L[3], H[0], H[1], H[2], H[3]}
  od = __builtin_amdgcn_mfma_f32_32x32x16_bf16(pa0, PK(l0, h0), od, 0, 0, 0);
  od = __builtin_amdgcn_mfma_f32_32x32x16_bf16(pa1, PK(l1, h1), od, 0, 0, 0);
  od = __builtin_amdgcn_mfma_f32_32x32x16_bf16(pa2, PK(l2, h2), od, 0, 0, 0);
  od = __builtin_amdgcn_mfma_f32_32x32x16_bf16(pa3, PK(l3, h3), od, 0, 0, 0);
#undef PK
}
template <int DV> __device__ __forceinline__ void pv_d0(f32x16* o, int vb, bf16x8 pa0, bf16x8 pa1, bf16x8 pa2, bf16x8 pa3) {
  pv_one<0>(o[0], vb, pa0, pa1, pa2, pa3); pv_one<1>(o[1], vb, pa0, pa1, pa2, pa3);
  if constexpr (DV == 128) { pv_one<2>(o[2], vb, pa0, pa1, pa2, pa3); pv_one<3>(o[3], vb, pa0, pa1, pa2, pa3); }
}

template <int DV, int SC, int LDO, int DQK>
__device__ __forceinline__ void attn_dense_body(const bf16* __restrict__ Qb, const bf16* __restrict__ Kh, const bf16* __restrict__ Vh,
                                                bf16* __restrict__ Ob, int seq, char* lds, const int tid) {
  constexpr int ND = DV / 32, NKS = DQK / 16;
  const int wid = tid >> 6, lane = tid & 63, r32 = lane & 31, hi = lane >> 5;
  bf16* V_lds = (bf16*)lds; bf16* K_lds = (bf16*)(lds + 2 * SHM_V);
  float* ws = (float*)(lds + 2 * SHM_V + 2 * SHM_K) + wid * 64; float* li_l = ws; float* al_l = ws + 32;
  float m_reg = -1e30f, l_reg = 0; f32x16 o[ND] = {}; bf16x8 qr[NKS];
  const bf16* Qw = Qb + (long)(wid * QBLK + r32) * 128 + hi * 8;
#pragma unroll
  for (int d0 = 0; d0 < NKS; ++d0) qr[d0] = *reinterpret_cast<const bf16x8*>(Qw + d0 * 16);
  const int sr = tid >> 4, sc = (tid & 15) * 8;
  const int vr = (DV == 128) ? sr : (tid >> 3), vc = (DV == 128) ? sc : (tid & 7) * 8;
  const int vst0 = v_st(vr, vc), vst1 = v_st(32 + vr, vc);
  const int vb0 = (int)(uintptr_t)V_lds + v_rd_base(lane);
  constexpr int SDEPTH = 1;
  struct { bf16x8 vs0, vs1, ks0, ks1; } sr_[SDEPTH];
#define SLOAD(i, k0) do { sr_[i].vs0 = *reinterpret_cast<const bf16x8*>(&Vh[(long)((k0) + vr) * DV + vc]); \
    if constexpr (DV == 128) sr_[i].vs1 = *reinterpret_cast<const bf16x8*>(&Vh[(long)((k0) + 32 + vr) * DV + vc]); \
    sr_[i].ks0 = *reinterpret_cast<const bf16x8*>(&Kh[(long)((k0) + sr) * 128 + sc]); sr_[i].ks1 = *reinterpret_cast<const bf16x8*>(&Kh[(long)((k0) + 32 + sr) * 128 + sc]); } while (0)
#define SWRITE(b, i) do { *(bf16x8*)((char*)V_lds + (b) * SHM_V + vst0) = sr_[i].vs0;          \
    if constexpr (DV == 128) *(bf16x8*)((char*)V_lds + (b) * SHM_V + vst1) = sr_[i].vs1; int kc = sc * 2;               \
    *(bf16x8*)((char*)K_lds + (b) * SHM_K + KSWZ(sr, kc)) = sr_[i].ks0;                       \
    *(bf16x8*)((char*)K_lds + (b) * SHM_K + KSWZ(32 + sr, kc)) = sr_[i].ks1; } while (0)
#define SWAIT() do { if constexpr (SDEPTH == 1) asm volatile("s_waitcnt vmcnt(0)" ::: "memory"); else if constexpr (DV == 128) asm volatile("s_waitcnt vmcnt(4)" ::: "memory"); else asm volatile("s_waitcnt vmcnt(3)" ::: "memory"); } while (0)
#define RESC(a) do { if (__any((a) < 1.f)) { if (hi == 0) al_l[r32] = (a); asm volatile("s_waitcnt lgkmcnt(0)" ::: "memory"); \
    _Pragma("unroll") for (int d = 0; d < ND; ++d) _Pragma("unroll") for (int r = 0; r < 16; ++r) o[d][r] *= al_l[crow(r, hi)]; } } while (0)
  f32x16 pA0, pA1, pB0, pB1; float mnA, mnB, alA, alB; bf16x8 pa0, pa1, pa2, pa3; const int NT = seq / KVBLK;
  constexpr int SE = 0, SO = SDEPTH - 1;
  SLOAD(SE, 0); asm volatile("s_waitcnt vmcnt(0)" ::: "memory"); SWRITE(0, SE); __syncthreads();
  qkt<NKS>(pA0, pA1, K_lds, qr, r32, hi); partialSM<SC>(pA0, pA1, m_reg, mnA, alA);
  SLOAD(SO, KVBLK); if constexpr (SDEPTH == 2) { if (2 < NT) SLOAD(SE, 2 * KVBLK); }
  SWAIT(); SWRITE(1, SO); __syncthreads();
  for (int j = 1; j + 1 < NT; j += 2) {
    SBAR(); qkt<NKS>(pB0, pB1, (bf16*)((char*)K_lds + SHM_K), qr, r32, hi);
    finishSM(pA0, pA1, alA, l_reg, pa0, pa1, pa2, pa3); SBAR();
    SLOAD(SO, (j + SDEPTH) * KVBLK); SBAR();
    pv_d0<DV>(o, vb0, pa0, pa1, pa2, pa3); partialSM<SC>(pB0, pB1, m_reg, mnB, alB);
    __syncthreads(); SWAIT(); SWRITE(0, SE);
    RESC(alB); __syncthreads();
    SBAR(); qkt<NKS>(pA0, pA1, K_lds, qr, r32, hi);
    finishSM(pB0, pB1, alB, l_reg, pa0, pa1, pa2, pa3); SBAR();
    if (SDEPTH == 1 || j + 3 < NT) SLOAD(SE, (j + 1 + SDEPTH) * KVBLK); SBAR();
    pv_d0<DV>(o, vb0 + (int)SHM_V, pa0, pa1, pa2, pa3); partialSM<SC>(pA0, pA1, m_reg, mnA, alA);
    __syncthreads(); SWAIT(); SWRITE(1, SO);
    RESC(alA); __syncthreads();
  }
  SBAR(); qkt<NKS>(pB0, pB1, (bf16*)((char*)K_lds + SHM_K), qr, r32, hi);
  finishSM(pA0, pA1, alA, l_reg, pa0, pa1, pa2, pa3); SBAR();
  pv_d0<DV>(o, vb0, pa0, pa1, pa2, pa3); partialSM<SC>(pB0, pB1, m_reg, mnB, alB);
  __syncthreads(); RESC(alB);
  finishSM(pB0, pB1, alB, l_reg, pa0, pa1, pa2, pa3); SBAR();
  pv_d0<DV>(o, vb0 + (int)SHM_V, pa0, pa1, pa2, pa3);
  if (hi == 0) li_l[r32] = l_reg; asm volatile("s_waitcnt lgkmcnt(0)" ::: "memory");
  float rli[16];
#pragma unroll
  for (int r = 0; r < 16; ++r) rli[r] = __builtin_amdgcn_rcpf(li_l[crow(r, hi)]);
  bf16* Ow = Ob + (long)(wid * QBLK) * LDO;
#pragma unroll
  for (int r = 0; r < 16; ++r) { int orow = crow(r, hi);
#pragma unroll
    for (int d0 = 0; d0 < ND; ++d0) Ow[(long)orow * LDO + d0 * 32 + r32] = (bf16)f2bf(o[d0][r] * rli[r]); }
  __syncthreads();
#undef SLOAD
#undef SWRITE
#undef SWAIT
#undef RESC
}
#undef KSWZ
#undef SBAR
}
namespace s5 {
constexpr int CH = 4, BT = 16 * CH;
constexpr int NCB = CTXL / BT;
constexpr int NBLK = SKV / BT;
constexpr int NSQ = 6;
static_assert((1 << NSQ) == BT, "squarings");
constexpr int HS_STRIDE = 272;
constexpr int HS_BYTES = 32 * HS_STRIDE;
constexpr int NITEMS = 32 * 2 * NBLK;

struct Params { const float *a_re, *a_im, *log_dt, *b_re, *b_im, *c_re, *c_im, *dskip; };

__device__ __forceinline__ int rowof(int b, int blk, int j) { return blk < NCB ? LAT_ROWS + b * 256 + blk * BT + j : b * 4096 + (blk - NCB) * BT + j; }

struct DirConst {
    float abr[2], abi[2];
    bf16x8 Bfr[2], Bfi[2];
};
__device__ __forceinline__ void load_dir(const Params& P, int dd, int g, int nl, int hi, DirConst& dc) {
    const float dt = __expf(P.log_dt[dd * 32 + g]);
#pragma unroll
    for (int nh = 0; nh < 2; ++nh) {
        const int n = nl + 32 * nh; const int ix = (dd * 32 + g) * 64 + n;
        const float are = P.a_re[ix], aim = P.a_im[ix];
        const float mag = __expf(dt * are), th = dt * aim;
        float rev = th * 0.15915494309189535f; rev -= floorf(rev);
        const float sn = __builtin_amdgcn_sinf(rev), cs = __builtin_amdgcn_cosf(rev);
        const float abr = mag * cs, abi = mag * sn;
        const float den = are * are + aim * aim, nr = abr - 1.f;
        const float zr = (nr * are + abi * aim) / den, zi = (abi * are - nr * aim) / den;
        dc.abr[nh] = abr; dc.abi[nh] = abi;
        const float* br = P.b_re + (size_t)ix * 16 + 8 * hi; const float* bi = P.b_im + (size_t)ix * 16 + 8 * hi;
        u32x4 wr_, wi_;
        float r8[8], i8[8];
#pragma unroll
        for (int j = 0; j < 8; ++j) { const float bre = br[j], bim = bi[j]; r8[j] = zr * bre - zi * bim; i8[j] = zr * bim + zi * bre; }
        wr_.x = pk2(r8[0], r8[1]); wr_.y = pk2(r8[2], r8[3]); wr_.z = pk2(r8[4], r8[5]); wr_.w = pk2(r8[6], r8[7]);
        wi_.x = pk2(i8[0], i8[1]); wi_.y = pk2(i8[2], i8[3]); wi_.z = pk2(i8[4], i8[5]); wi_.w = pk2(i8[6], i8[7]);
        dc.Bfr[nh] = __builtin_bit_cast(bf16x8, wr_); dc.Bfi[nh] = __builtin_bit_cast(bf16x8, wi_);
    }
}
__device__ __forceinline__ void load_cmat(const Params& P, int dd, int g, int lane, bf16x8 (&Cf)[4]) {
    const int p = lane & 15, kq = lane >> 4;
    const float* cre = P.c_re + ((size_t)(dd * 32 + g) * 16 + p) * 64; const float* cim = P.c_im + ((size_t)(dd * 32 + g) * 16 + p) * 64;
#pragma unroll
    for (int ks = 0; ks < 4; ++ks) {
        float v[8];
#pragma unroll
        for (int j = 0; j < 8; ++j) { const int k = 32 * ks + 8 * kq + j; const int n = (k >> 2) + 32 * ((k >> 1) & 1); v[j] = (k & 1) ? -cim[n] : cre[n]; }
        u32x4 w; w.x = pk2(v[0], v[1]); w.y = pk2(v[2], v[3]); w.z = pk2(v[4], v[5]); w.w = pk2(v[6], v[7]);
        Cf[ks] = __builtin_bit_cast(bf16x8, w);
    }
}
constexpr int TAB_BYTES = 9 * 64 * 16;
__device__ __forceinline__ void build_tab(const Params& P, int dd, int g, int lane, u32x4* dst) {
    DirConst dc; load_dir(P, dd, g, lane & 31, lane >> 5, dc);
    bf16x8 Cf[4]; load_cmat(P, dd, g, lane, Cf);
    ((f32x4*)dst)[lane] = (f32x4){dc.abr[0], dc.abr[1], dc.abi[0], dc.abi[1]};
    dst[1 * 64 + lane] = __builtin_bit_cast(u32x4, dc.Bfr[0]); dst[2 * 64 + lane] = __builtin_bit_cast(u32x4, dc.Bfr[1]);
    dst[3 * 64 + lane] = __builtin_bit_cast(u32x4, dc.Bfi[0]); dst[4 * 64 + lane] = __builtin_bit_cast(u32x4, dc.Bfi[1]);
#pragma unroll
    for (int k = 0; k < 4; ++k) dst[(5 + k) * 64 + lane] = __builtin_bit_cast(u32x4, Cf[k]);
}
__device__ __forceinline__ void load_tab(const u32x4* tab, int dd, int g, int lane, DirConst& dc, bf16x8 (&Cf)[4]) {
    const u32x4* t = tab + (size_t)(dd * 32 + g) * (TAB_BYTES / 16);
    u32x4 w[9];
#pragma unroll
    for (int k = 1; k < 9; ++k) w[k] = t[k * 64 + lane];
    const f32x4 a0 = ((const f32x4*)t)[lane];
    dc.abr[0] = a0[0]; dc.abr[1] = a0[1]; dc.abi[0] = a0[2]; dc.abi[1] = a0[3];
    dc.Bfr[0] = __builtin_bit_cast(bf16x8, w[1]); dc.Bfr[1] = __builtin_bit_cast(bf16x8, w[2]); dc.Bfi[0] = __builtin_bit_cast(bf16x8, w[3]); dc.Bfi[1] = __builtin_bit_cast(bf16x8, w[4]);
#pragma unroll
    for (int k = 0; k < 4; ++k) Cf[k] = __builtin_bit_cast(bf16x8, w[5 + k]);
}
__device__ __forceinline__ bf16x8 load_af(const bf16* zraw, int g, int bp, int blk, int c, int lane) {
    const int rho = lane & 31, kh = lane >> 5;
    const int beta = (rho >> 2) & 1, tau = (rho & 3) + 4 * (rho >> 3);
    const int row = rowof(2 * bp + beta, blk, 16 * c + tau);
    return *reinterpret_cast<const bf16x8*>(zraw + (size_t)row * 1024 + g * 16 + 8 * kh);
}
template <bool REV>
__device__ __forceinline__ void chunk_scan(const bf16x8 af, const DirConst& dc,
                                           float (&hr)[2], float (&hi_)[2], f32x16 (&accR)[2], f32x16 (&accI)[2]) {
#pragma unroll
    for (int nh = 0; nh < 2; ++nh) {
        accR[nh] = __builtin_amdgcn_mfma_f32_32x32x16_bf16(af, dc.Bfr[nh], f32x16{}, 0, 0, 0);
        accI[nh] = __builtin_amdgcn_mfma_f32_32x32x16_bf16(af, dc.Bfi[nh], f32x16{}, 0, 0, 0);
    }
#pragma unroll
    for (int qq = 0; qq < 16; ++qq) {
        const int q = REV ? 15 - qq : qq;
#pragma unroll
        for (int nh = 0; nh < 2; ++nh) {
            const float nr_ = dc.abr[nh] * hr[nh] - dc.abi[nh] * hi_[nh] + accR[nh][q];
            const float ni_ = dc.abr[nh] * hi_[nh] + dc.abi[nh] * hr[nh] + accI[nh][q];
            hr[nh] = nr_; hi_[nh] = ni_; accR[nh][q] = nr_; accI[nh][q] = ni_;
        }
    }
}

__device__ __forceinline__ void pass_a_item(const Params& P, const u32x4* tab, const bf16* zraw, float* E, int item, int lane) {
    const int g = item & 31, rest = item >> 5, blk = rest % NBLK, bp = rest / NBLK;
    const int nl = lane & 31, hi = lane >> 5;
    f32x16 accR[2], accI[2];
#pragma unroll
    for (int dd = 0; dd < 2; ++dd) {
        DirConst dc; bf16x8 Cfu[4]; load_tab(tab, dd, g, lane, dc, Cfu);
#ifdef DBG_TABA
        { DirConst d2; load_dir(P, dd, g, nl, hi, d2);
          if (DBG_TABA == 1) dc = d2;
          if (DBG_TABA == 2) { dc.abr[0] = d2.abr[0]; dc.abr[1] = d2.abr[1]; dc.abi[0] = d2.abi[0]; dc.abi[1] = d2.abi[1]; }
          if (DBG_TABA == 3) { dc.Bfr[0] = d2.Bfr[0]; dc.Bfr[1] = d2.Bfr[1]; dc.Bfi[0] = d2.Bfi[0]; dc.Bfi[1] = d2.Bfi[1]; } }
#endif
        float hr[2] = {0.f, 0.f}, hi_[2] = {0.f, 0.f};
        bf16x8 af = load_af(zraw, g, bp, blk, dd == 0 ? 0 : CH - 1, lane);
        for (int cc = 0; cc < CH; ++cc) {
            const int cn = cc < CH - 1 ? cc + 1 : cc;
            const bf16x8 afn = load_af(zraw, g, bp, blk, dd == 0 ? cn : CH - 1 - cn, lane);
            if (dd == 0) chunk_scan<false>(af, dc, hr, hi_, accR, accI);
            else chunk_scan<true>(af, dc, hr, hi_, accR, accI);
            af = afn;
        }
        const int b = 2 * bp + hi;
        float* e = E + ((((size_t)(dd * 32 + g) * 4 + b) * NBLK + blk) * 64) * 2;
#pragma unroll
        for (int nh = 0; nh < 2; ++nh) { *(f32x2*)(e + (nl + 32 * nh) * 2) = (f32x2){hr[nh], hi_[nh]}; }
    }
}

__device__ __forceinline__ void readout(LAS unsigned char* hs, int lane, const bf16x8 (&Cf)[4], const f32x16 (&accR)[2], const f32x16 (&accI)[2], f32x4 (&y)[2]) {
    const int nl = lane & 31, hi = lane >> 5;
#pragma unroll
    for (int q = 0; q < 16; ++q) {
        u32x2 w; w.x = pk2(accR[0][q], accI[0][q]); w.y = pk2(accR[1][q], accI[1][q]);
        *(LAS u32x2*)(hs + (hi * 16 + q) * HS_STRIDE + nl * 8) = w;
    }
    asm volatile("s_waitcnt lgkmcnt(0)" ::: "memory");
    const int tk = lane & 15, kq = lane >> 4;
#pragma unroll
    for (int beta = 0; beta < 2; ++beta) {
#pragma unroll
        for (int ks = 0; ks < 4; ++ks) {
            const bf16x8 hb = *(const LAS bf16x8*)(hs + (beta * 16 + tk) * HS_STRIDE + (32 * ks + 8 * kq) * 2);
            y[beta] = __builtin_amdgcn_mfma_f32_16x16x32_bf16(Cf[ks], hb, y[beta], 0, 0, 0);
        }
    }
    asm volatile("s_waitcnt lgkmcnt(0)" ::: "memory");
}

__device__ __forceinline__ void prefix_wave(const Params& P, float* E, int seq, int lane) {
    const int dd = seq >> 7, g = (seq >> 2) & 31, n = lane;
    const int ix = (dd * 32 + g) * 64 + n;
    const float dt = __expf(P.log_dt[dd * 32 + g]);
    const float are = P.a_re[ix], aim = P.a_im[ix];
    const float mag = __expf(dt * are), th = dt * aim;
    float rev = th * 0.15915494309189535f; rev -= floorf(rev);
    float ar = mag * __builtin_amdgcn_cosf(rev), ai = mag * __builtin_amdgcn_sinf(rev);
#pragma unroll
    for (int s = 0; s < NSQ; ++s) { const float t = ar * ar - ai * ai; ai = 2.f * ar * ai; ar = t; }
    float* e = E + ((size_t)seq * NBLK * 64 + n) * 2;
    float hr = 0.f, hi = 0.f;
    constexpr int BATCH = 17; static_assert(NBLK % BATCH == 0, "batching");
    for (int c0 = 0; c0 < NBLK; c0 += BATCH) {
        f32x2 ev[BATCH];
#pragma unroll
        for (int u = 0; u < BATCH; ++u) { const int ci = c0 + u; const int blk = dd == 0 ? ci : (ci < NCB ? NCB - 1 - ci : NBLK + NCB - 1 - ci); ev[u] = *(const f32x2*)(e + (size_t)blk * 128); }
        asm volatile("" ::: "memory");
#pragma unroll
        for (int u = 0; u < BATCH; ++u) { const int ci = c0 + u; const int blk = dd == 0 ? ci : (ci < NCB ? NCB - 1 - ci : NBLK + NCB - 1 - ci);
            *(f32x2*)(e + (size_t)blk * 128) = (f32x2){hr, hi};
            const float nr_ = ar * hr - ai * hi + ev[u].x, ni_ = ar * hi + ai * hr + ev[u].y; hr = nr_; hi = ni_; }
    }
}

__device__ __forceinline__ void pass_b_item(const Params& P, const u32x4* tab, const bf16* zraw, const float* E, bf16* gg, LAS unsigned char* hs, int item, int lane) {
    const int g = item & 31, rest = item >> 5, blk = rest % NBLK, bp = rest / NBLK;
    const int nl = lane & 31, hi = lane >> 5;
    const int b = 2 * bp + hi;
    f32x16 accR[2], accI[2];
    f32x4 yf[CH][2];
    {
        DirConst dc; bf16x8 Cf[4]; load_tab(tab, 0, g, lane, dc, Cf);
#ifdef DBG_TABCMP
        { DirConst d2; load_dir(P, 0, g, nl, hi, d2); bf16x8 C2[4]; load_cmat(P, 0, g, lane, C2); bool bad = false;
          for (int q = 0; q < 2; ++q) { if (d2.abr[q] != dc.abr[q] || d2.abi[q] != dc.abi[q]) bad = true; for (int j = 0; j < 8; ++j) if (d2.Bfr[q][j] != dc.Bfr[q][j] || d2.Bfi[q][j] != dc.Bfi[q][j]) bad = true; }
          bool badc = false; for (int q = 0; q < 4; ++q) for (int j = 0; j < 8; ++j) if (C2[q][j] != Cf[q][j]) badc = true;
          if (DBG_TABCMP == 1 && bad) dc.abr[0] = __builtin_nanf(""); if (DBG_TABCMP == 2 && badc) dc.abr[0] = __builtin_nanf("");
          if (DBG_TABCMP == 3) { dc = d2; for (int q = 0; q < 4; ++q) Cf[q] = C2[q]; } }
#endif
        float hr[2], hi_[2];
        { const float* e = E + (((((size_t)(0 * 32 + g) * 4 + b) * NBLK + blk) * 64) * 2);
#pragma unroll
          for (int nh = 0; nh < 2; ++nh) { const f32x2 hv = *(const f32x2*)(e + (nl + 32 * nh) * 2); hr[nh] = hv.x; hi_[nh] = hv.y; } }
        bf16x8 af = load_af(zraw, g, bp, blk, 0, lane);
#pragma unroll
        for (int c = 0; c < CH; ++c) {
            const bf16x8 afn = load_af(zraw, g, bp, blk, c < CH - 1 ? c + 1 : c, lane);
            chunk_scan<false>(af, dc, hr, hi_, accR, accI); af = afn;
            yf[c][0] = (f32x4){0.f, 0.f, 0.f, 0.f}; yf[c][1] = (f32x4){0.f, 0.f, 0.f, 0.f};
            readout(hs, lane, Cf, accR, accI, yf[c]);
        }
    }
    {
        DirConst dc; bf16x8 Cf[4]; load_tab(tab, 1, g, lane, dc, Cf);
        float hr[2], hi_[2];
        { const float* e = E + (((((size_t)(1 * 32 + g) * 4 + b) * NBLK + blk) * 64) * 2);
#pragma unroll
          for (int nh = 0; nh < 2; ++nh) { const f32x2 hv = *(const f32x2*)(e + (nl + 32 * nh) * 2); hr[nh] = hv.x; hi_[nh] = hv.y; } }
        const int tk = lane & 15, kq = lane >> 4;
        const f32x4 dv = *(const f32x4*)(P.dskip + g * 16 + 4 * kq);
        bf16x8 af = load_af(zraw, g, bp, blk, CH - 1, lane);
#pragma unroll
        for (int cc = 0; cc < CH; ++cc) {
            const int c = CH - 1 - cc;
            const bf16x8 afn = load_af(zraw, g, bp, blk, c > 0 ? c - 1 : c, lane);
            u32x2 uwv[2];
#pragma unroll
            for (int beta = 0; beta < 2; ++beta) uwv[beta] = *(const u32x2*)(zraw + (size_t)rowof(2 * bp + beta, blk, 16 * c + tk) * 1024 + g * 16 + 4 * kq);
            chunk_scan<true>(af, dc, hr, hi_, accR, accI); af = afn;
            readout(hs, lane, Cf, accR, accI, yf[c]);
#pragma unroll
            for (int beta = 0; beta < 2; ++beta) {
                const int row = rowof(2 * bp + beta, blk, 16 * c + tk);
                const u32x2 uw = uwv[beta];
                const f32x4 yv = yf[c][beta];
                const float v0 = yv[0] + dv[0] * bflo(uw.x), v1 = yv[1] + dv[1] * bfhi(uw.x), v2 = yv[2] + dv[2] * bflo(uw.y), v3 = yv[3] + dv[3] * bfhi(uw.y);
                u32x2 ow; ow.x = pk2(gelu_tanh(v0), gelu_tanh(v1)); ow.y = pk2(gelu_tanh(v2), gelu_tanh(v3));
                *(u32x2*)(gg + (size_t)row * 512 + g * 16 + 4 * kq) = ow;
            }
        }
    }
}
}
typedef const float* __attribute__((address_space(4))) const* KargPtrTable;
#define KIN(k) (((KargPtrTable)__builtin_amdgcn_kernarg_segment_ptr())[k])
struct Ctx {
    float* out; unsigned char* ws;
    LAS unsigned char* lds;
    int tid, lane, wave, G, gw, NGW, bid, dry;
};

__device__ __forceinline__ void tr_item(const float* src, int sld, int c0, int k0, int srcK, bf16* dst, int dld, int n0, bool zero, LAS float* scr, int lane) {
    const int c = lane & 7;
    if (zero || k0 >= srcK) {
#pragma unroll
        for (int j = 0; j < 4; ++j) { const int n = (lane >> 3) + 8 * j; unsigned z0 = 0u; asm volatile("" : "+v"(z0));
            *(u32x4*)(dst + (size_t)(n0 + n) * dld + k0 + 8 * c) = (u32x4){z0, z0, z0, z0}; }
        return;
    }
    { const int kk = lane >> 3, nc = lane & 7;
      f32x4 v[8];
#pragma unroll
      for (int i = 0; i < 8; ++i) v[i] = *(const f32x4*)(src + (size_t)(k0 + 8 * i + kk) * sld + c0 + 4 * nc);
#pragma unroll
      for (int i = 0; i < 8; ++i) { LAS float* d = scr + (8 * i + kk) * 33 + 4 * nc; d[0] = v[i][0]; d[1] = v[i][1]; d[2] = v[i][2]; d[3] = v[i][3]; } }
    asm volatile("s_waitcnt lgkmcnt(0)" ::: "memory");
#pragma unroll
    for (int j = 0; j < 4; ++j) { const int n = (lane >> 3) + 8 * j; const LAS float* s = scr + (8 * c) * 33 + n;
        u32x4 o; o.x = cvtpk(s[0 * 33], s[1 * 33]); o.y = cvtpk(s[2 * 33], s[3 * 33]); o.z = cvtpk(s[4 * 33], s[5 * 33]); o.w = cvtpk(s[6 * 33], s[7 * 33]);
        *(u32x4*)(dst + (size_t)(n0 + n) * dld + k0 + 8 * c) = o; }
    asm volatile("s_waitcnt lgkmcnt(0)" ::: "memory");
}

#ifndef DEF_QA
#define DEF_QA 12
#endif
#ifndef DEF_QB
#define DEF_QB 12
#endif
constexpr int DEF_ITEMS = 128 * (512 + 256), DEF_P0 = (48 - 2 * (DEF_QA + DEF_QB)) * 2048;
static_assert(DEF_ITEMS == 48 * 2048 && DEF_P0 >= 0 && DEF_P0 + (DEF_QA + DEF_QB) * 2048 >= 2 * 32 * 768, "deferred conversion schedule: layers 0 and 1 complete before layer 0's MoE");
__device__ __forceinline__ void moe_item(const Ctx& F, int q, LAS float* scr) {
    constexpr int PER_LE = 512 + 256;
    const int le = q / PER_LE; int r = q % PER_LE;
    if (r < 512) { const int nb = r >> 4, kb = r & 15;
        const int n0 = nb * 32, pn = n0 >> 8, w = n0 & 255;
        const float* src = (w < 128 ? KIN(33) : KIN(34)) + (size_t)le * 1024 * 512;
        tr_item(src, 512, pn * 128 + (w & 127), kb * 64, 1024, (bf16*)(F.ws + WS_W_GU) + (size_t)le * 1024 * 1024, 1024, n0, false, scr, F.lane);
    } else { r -= 512; const int nb = r >> 3, kb = r & 7;
        tr_item(KIN(35) + (size_t)le * 512 * 1024, 1024, nb * 32, kb * 64, 512, (bf16*)(F.ws + WS_W_DN) + (size_t)le * 1024 * 512, 512, nb * 32, false, scr, F.lane); }
}
__device__ __forceinline__ void p0_weights(const Ctx& F) {
    LAS float* scr = (LAS float*)(F.lds + F.wave * 16384);
    constexpr int PER_I = 512 + 512 + 128 + 96 + 128 + 1024 + 512;
    constexpr int DENSE = 2 * PER_I, PER_LE = 512 + 256, TOTAL = DENSE + DEF_P0;
    for (int it = F.gw; it < TOTAL; it += F.NGW) {
        if (it < DENSE) {
            const int i = it / PER_I; int r = it % PER_I;
            if (r < 512) { const int nb = r >> 4, kb = r & 15;
                tr_item(KIN(8) + (size_t)i * 1024 * 928, 928, nb * 32, kb * 64, 1024, (bf16*)(F.ws + WS_W_IN) + (size_t)i * 1024 * 1024, 1024, nb * 32, nb >= 29, scr, F.lane); continue; } r -= 512;
            if (r < 512) { const int nb = r >> 4, kb = r & 15;
                tr_item(KIN(9) + (size_t)i * 1024 * 1024, 1024, nb * 32, kb * 64, 1024, (bf16*)(F.ws + WS_W_OUTE) + (size_t)i * 1024 * 1024, 1024, nb * 32, false, scr, F.lane); continue; } r -= 512;
            if (r < 128) { const int nb = r >> 3, kb = r & 7;
                tr_item(KIN(18) + (size_t)i * 512 * 512, 512, nb * 32, kb * 64, 512, (bf16*)(F.ws + WS_W_GLU) + (size_t)i * 512 * 512, 512, nb * 32, false, scr, F.lane); continue; } r -= 128;
            if (r < 96) { const int nb = r >> 2, kb = r & 3;
                tr_item(KIN(20) + (size_t)i * 256 * 768, 768, nb * 32, kb * 64, 256, (bf16*)(F.ws + WS_W_MLA) + (size_t)i * 1792 * 256, 256, nb * 32, false, scr, F.lane); continue; } r -= 96;
            if (r < 128) { const int nb = r >> 2, kb = r & 3;
                tr_item(KIN(22) + (size_t)i * 128 * 1024, 1024, nb * 32, kb * 64, 128, (bf16*)(F.ws + WS_W_MLA) + (size_t)i * 1792 * 256, 256, 768 + nb * 32, false, scr, F.lane); continue; } r -= 128;
            if (r < 1024) { const int nb = r >> 4, kb = r & 15;
                tr_item(KIN(25) + (size_t)i * 1024 * 2048, 2048, nb * 32, kb * 64, 1024, (bf16*)(F.ws + WS_W_QKV) + (size_t)i * 2048 * 1024, 1024, nb * 32, false, scr, F.lane); continue; } r -= 1024;
            { const int nb = r >> 4, kb = r & 15;
                tr_item(KIN(26) + (size_t)i * 1024 * 1024, 1024, nb * 32, kb * 64, 1024, (bf16*)(F.ws + WS_W_OUTO) + (size_t)i * 1024 * 1024, 1024, nb * 32, false, scr, F.lane); }
        } else {
            moe_item(F, it - DENSE, scr);
        }
    }
}
__device__ __forceinline__ void defer_convert(const Ctx& F, int slot) {
    const int quota = (slot & 1) ? DEF_QB : DEF_QA, start = DEF_P0 + (slot >> 1) * (DEF_QA + DEF_QB) * 2048 + (slot & 1) * DEF_QA * 2048;
    LAS float* scr = (LAS float*)(F.lds + 8 * 8704 + F.wave * 8448);
    for (int k = 0; k < quota; ++k) moe_item(F, start + k * F.NGW + F.gw, scr);
}
__device__ __forceinline__ void p0_ada(const Ctx& F) {
    LAS float* sc = (LAS float*)(F.lds);
    LAS float* red = (LAS float*)(F.lds + 32768);
    for (int i = F.tid; i < 5 * 1024; i += 512) { const int r = i >> 10, k = i & 1023; const float v = r < 4 ? KIN(1)[r * 1024 + k] : KIN(3)[k]; sc[i] = siluf_(v); }
    __syncthreads();
    const int id = F.bid, l = id / 48, col0 = (id % 48) * 128;
    float a[5][2];
#pragma unroll
    for (int r = 0; r < 5; ++r) { a[r][0] = 0.f; a[r][1] = 0.f; }
    const float* wp = KIN(4) + ((size_t)l * 1024 + F.wave * 128) * NMOD + col0 + 2 * F.lane;
#pragma unroll 8
    for (int k = 0; k < 128; ++k) { const f32x2 w2 = *(const f32x2*)(wp + (size_t)k * NMOD);
#pragma unroll
        for (int r = 0; r < 5; ++r) { const float s = sc[r * 1024 + F.wave * 128 + k]; a[r][0] += s * w2.x; a[r][1] += s * w2.y; } }
#pragma unroll
    for (int r = 0; r < 5; ++r) { red[(F.wave * 5 + r) * 128 + 2 * F.lane] = a[r][0]; red[(F.wave * 5 + r) * 128 + 2 * F.lane + 1] = a[r][1]; }
    __syncthreads();
    for (int i = F.tid; i < 5 * 128; i += 512) { const int r = i >> 7, cc = i & 127; float s = KIN(5)[l * NMOD + col0 + cc];
#pragma unroll
        for (int w = 0; w < 8; ++w) s += red[(w * 5 + r) * 128 + cc];
        ((float*)(F.ws + WS_MOD))[((size_t)l * 5 + r) * NMOD + col0 + cc] = s; }
    __syncthreads();
}
__device__ __forceinline__ void p0_rope(const Ctx& F) {
    float* t = (float*)(F.ws + WS_ROPE);
    for (int i = F.tid; i < 64 * 32; i += 512) { const int p = i >> 5, f = i & 31; const float inv = __builtin_amdgcn_exp2f(-(float)f * (13.287712379549449f / 32.f));
        float rev = (float)p * inv * 0.15915494309189535f; rev -= floorf(rev);
        t[2 * i] = __builtin_amdgcn_cosf(rev); t[2 * i + 1] = __builtin_amdgcn_sinf(rev); }
    for (int i = F.tid; i < 64 * 8; i += 512) { const int p = i >> 3, f = i & 7; const float inv = __builtin_amdgcn_exp2f(-(float)f * (13.287712379549449f / 8.f));
        float rev = (float)p * inv * 0.15915494309189535f; rev -= floorf(rev);
        t[ROPE32_OFF + 2 * i] = __builtin_amdgcn_cosf(rev); t[ROPE32_OFF + 2 * i + 1] = __builtin_amdgcn_sinf(rev); }
}

__device__ __forceinline__ void p0_router_t(const Ctx& F) {
    float* rt = (float*)(F.ws + WS_RT);
    for (int i = F.tid; i < DEPTH * 36 * 1024; i += 512) { const int k = i & 1023, j = (i >> 10) % 36, l = i / (36 * 1024);
        rt[i] = j < 4 ? KIN(29)[((size_t)l * 1024 + k) * 4 + j] : KIN(31)[((size_t)l * 1024 + k) * 32 + (j - 4)]; }
}
__device__ __forceinline__ void unpack8(const u32x4 w, float (&x)[8]) { x[0] = bflo(w.x); x[1] = bfhi(w.x); x[2] = bflo(w.y); x[3] = bfhi(w.y); x[4] = bflo(w.z); x[5] = bfhi(w.z); x[6] = bflo(w.w); x[7] = bfhi(w.w); }
__device__ __forceinline__ u32x4 pack8(const float (&x)[8]) { u32x4 w; w.x = pk2(x[0], x[1]); w.y = pk2(x[2], x[3]); w.z = pk2(x[4], x[5]); w.w = pk2(x[6], x[7]); return w; }
__device__ __forceinline__ float sumsq8(const float (&x)[8]) { return ((x[0] * x[0] + x[1] * x[1]) + (x[2] * x[2] + x[3] * x[3])) + ((x[4] * x[4] + x[5] * x[5]) + (x[6] * x[6] + x[7] * x[7])); }
__device__ __forceinline__ float group8_sum(float v) { v += DPP_F(v, 0xB1); v += DPP_F(v, 0x4E); v += DPP_F(v, 0x141); return v; }
__device__ __forceinline__ float group16_sum(float v) { v += DPP_F(v, 0xB1); v += DPP_F(v, 0x4E); v += DPP_F(v, 0x141); v += DPP_F(v, 0x140); return v; }
__device__ __forceinline__ void norm_rope8(const float (&x1)[8], const float (&x2)[8], float rinv, const float (&w1)[8], const float (&w2)[8], const float* csn, bool rot, u32x4& o1, u32x4& o2) {
    float a[8], b2[8];
    if (rot) {
        const f32x4 c0 = *(const f32x4*)(csn), c1 = *(const f32x4*)(csn + 4), c2 = *(const f32x4*)(csn + 8), c3 = *(const f32x4*)(csn + 12);
        const float cs[8] = {c0[0], c0[2], c1[0], c1[2], c2[0], c2[2], c3[0], c3[2]}, sn[8] = {c0[1], c0[3], c1[1], c1[3], c2[1], c2[3], c3[1], c3[3]};
#pragma unroll
        for (int j = 0; j < 8; ++j) { const float y1 = x1[j] * rinv * w1[j], y2 = x2[j] * rinv * w2[j]; a[j] = y1 * cs[j] - y2 * sn[j]; b2[j] = y2 * cs[j] + y1 * sn[j]; }
    } else {
#pragma unroll
        for (int j = 0; j < 8; ++j) { a[j] = x1[j] * rinv * w1[j]; b2[j] = x2[j] * rinv * w2[j]; }
    }
    o1 = pack8(a); o2 = pack8(b2);
}
struct RowV { float v[2][8]; };
__device__ __forceinline__ void ld_row_f32(const float* p, int lane, RowV& r) {
#pragma unroll
    for (int j = 0; j < 2; ++j) { const f32x4 a = *(const f32x4*)(p + 8 * lane + 512 * j), b = *(const f32x4*)(p + 8 * lane + 512 * j + 4);
        r.v[j][0] = a[0]; r.v[j][1] = a[1]; r.v[j][2] = a[2]; r.v[j][3] = a[3]; r.v[j][4] = b[0]; r.v[j][5] = b[1]; r.v[j][6] = b[2]; r.v[j][7] = b[3]; }
}
__device__ __forceinline__ void ld_row_bf16(const bf16* p, int lane, RowV& r) {
#pragma unroll
    for (int j = 0; j < 2; ++j) { const u32x4 w = *(const u32x4*)(p + 8 * lane + 512 * j); unpack8(w, r.v[j]); }
}
__device__ __forceinline__ float row_sumsq(const RowV& r) { return wave_sum(sumsq8(r.v[0]) + sumsq8(r.v[1])); }
__device__ __forceinline__ void ld8f(const float* p, float (&o)[8]) { const f32x4 a = *(const f32x4*)p, b = *(const f32x4*)(p + 4); o[0] = a[0]; o[1] = a[1]; o[2] = a[2]; o[3] = a[3]; o[4] = b[0]; o[5] = b[1]; o[6] = b[2]; o[7] = b[3]; }
__device__ __forceinline__ void ld_xrow(const Ctx& F, int l, int row, RowV& x) {
    if (l == 0) ld_row_f32(row < LAT_ROWS ? KIN(0) + (size_t)row * DM : KIN(2) + (size_t)(row - LAT_ROWS) * DM, F.lane, x);
    else ld_row_bf16((const bf16*)(F.ws + WS_XRES) + (size_t)row * DM, F.lane, x);
}
__device__ __forceinline__ void rows_norm1(const Ctx& F, int l) {
    const float* mod = (const float*)(F.ws + WS_MOD);
    const bf16* ydn = (const bf16*)(F.ws + WS_YDN);
    bf16* xres = (bf16*)(F.ws + WS_XRES);
    bf16* h = (bf16*)(F.ws + WS_H);
    const float* g1 = KIN(6) + l * DM;
    constexpr int RR = 2;
    for (int row0 = F.gw; row0 < TOK; row0 += RR * F.NGW) {
        RowV x[RR]; u32x4 y0[RR][2], y1[RR][2];
#pragma unroll
        for (int rr = 0; rr < RR; ++rr) { int row = row0 + rr * F.NGW; row = row < TOK ? row : TOK - 1;
            ld_xrow(F, l, row, x[rr]);
            if (l > 0) {
#pragma unroll
                for (int j = 0; j < 2; ++j) { const int col = 8 * F.lane + 512 * j;
                    y0[rr][j] = *(const u32x4*)(ydn + (size_t)(2 * row) * DM + col); y1[rr][j] = *(const u32x4*)(ydn + (size_t)(2 * row + 1) * DM + col); } } }
#pragma unroll
        for (int rr = 0; rr < RR; ++rr) { const int row = row0 + rr * F.NGW; if (row >= TOK) break;
            const int mr = modrow_of(row);
            if (l > 0) {
                const float* g2 = mod + ((size_t)(l - 1) * 5 + mr) * NMOD + 5 * DM;
#pragma unroll
                for (int j = 0; j < 2; ++j) { const int col = 8 * F.lane + 512 * j;
                    float gv[8], a[8], b2[8]; ld8f(g2 + col, gv); unpack8(y0[rr][j], a); unpack8(y1[rr][j], b2);
#pragma unroll
                    for (int i = 0; i < 8; ++i) x[rr].v[j][i] += gv[i] * (a[i] + b2[i]);
                    if (!F.dry) *(u32x4*)(xres + (size_t)row * DM + col) = pack8(x[rr].v[j]);
                    unpack8(pack8(x[rr].v[j]), x[rr].v[j]); }
            }
            const float rinv = rsqrtf(row_sumsq(x[rr]) * (1.f / DM) + RMS_EPS);
            const float* mrow = mod + ((size_t)l * 5 + mr) * NMOD;
#pragma unroll
            for (int j = 0; j < 2; ++j) { const int col = 8 * F.lane + 512 * j;
                float gv[8], sh[8], scl[8], o[8]; ld8f(g1 + col, gv); ld8f(mrow + col, sh); ld8f(mrow + DM + col, scl);
#pragma unroll
                for (int i = 0; i < 8; ++i) o[i] = x[rr].v[j][i] * rinv * gv[i] * (1.f + scl[i]) + sh[i];
                *(u32x4*)(h + (size_t)row * DM + col) = pack8(o); }
        }
    }
}
__device__ __forceinline__ void build_router_tab(const Ctx& F, int l) {
    const float* mod = (const float*)(F.ws + WS_MOD) + (size_t)l * 5 * NMOD;
    const float* rt = (const float*)(F.ws + WS_RT) + (size_t)l * 36 * 1024;
    const float* g2w = KIN(7) + l * DM;
    bf16* tab = (bf16*)(F.ws + WS_RW);
    for (int i = F.bid * 512 + F.tid; i < 5 * 48 * 1024; i += F.G * 512) { const int c = i & 1023, n = (i >> 10) % 48, mr = i / (48 * 1024);
        float w = 0.f; if (n < 4) w = rt[n * 1024 + c]; else if (n >= 16) w = rt[(n - 12) * 1024 + c];
        const float v = g2w[c] * (1.f + mod[(size_t)mr * NMOD + 4 * DM + c]) * w;
        const unsigned hi = f2bf(v); const float lo = v - __builtin_bit_cast(float, hi << 16);
        tab[((size_t)mr * 2 + 0) * 48 * 1024 + n * 1024 + c] = (bf16)hi; tab[((size_t)mr * 2 + 1) * 48 * 1024 + n * 1024 + c] = (bf16)f2bf(lo); }
    float* rc = (float*)(F.ws + WS_RC);
    for (int d = F.gw; d < 5 * 36; d += F.NGW) { const int mr = d / 36, j = d % 36; float s = 0.f;
        for (int c = F.lane; c < 1024; c += 64) s += mod[(size_t)mr * NMOD + 3 * DM + c] * rt[j * 1024 + c];
        s = wave_sum(s); if (F.lane == 0) rc[d] = s + (j < 4 ? KIN(30)[l * 4 + j] : KIN(32)[l * 32 + j - 4]); }
}
template <int NT>
__device__ __forceinline__ void router_pass(const Ctx& F, const bf16* xres, int rowbase, int mr, LAS unsigned* lcnt, float* gatew,
                                            int& ea, int& eb, unsigned& ra, unsigned& rb, int& myrow) {
    const int r = F.lane & 15, fq = F.lane >> 4, k0 = F.wave * 128 + 8 * fq;
    const bf16* ap = xres + (size_t)(rowbase + r) * DM + k0;
    const bf16* bh = (const bf16*)(F.ws + WS_RW) + (size_t)mr * 2 * 48 * 1024 + (size_t)r * 1024 + k0; const bf16* bl = bh + 48 * 1024;
    f32x4 acc[NT][3]; float ssq[NT];
#pragma unroll
    for (int t = 0; t < NT; ++t) { ssq[t] = 0.f;
#pragma unroll
        for (int nt = 0; nt < 3; ++nt) acc[t][nt] = (f32x4){0.f, 0.f, 0.f, 0.f}; }
#pragma unroll
    for (int half = 0; half < 2; ++half) {
        u32x4 av[NT][2]; bf16x8 wh[3][2], wl[3][2];
#pragma unroll
        for (int k2 = 0; k2 < 2; ++k2) { const int ko = (half * 2 + k2) * 32;
#pragma unroll
            for (int t = 0; t < NT; ++t) av[t][k2] = *(const u32x4*)(ap + (size_t)t * 16 * DM + ko);
#pragma unroll
            for (int nt = 0; nt < 3; ++nt) { wh[nt][k2] = *(const bf16x8*)(bh + nt * 16 * 1024 + ko); wl[nt][k2] = *(const bf16x8*)(bl + nt * 16 * 1024 + ko); } }
        __builtin_amdgcn_sched_barrier(0);
#pragma unroll
        for (int k2 = 0; k2 < 2; ++k2)
#pragma unroll
            for (int t = 0; t < NT; ++t) { const bf16x8 a = __builtin_bit_cast(bf16x8, av[t][k2]);
#pragma unroll
                for (int nt = 0; nt < 3; ++nt) { acc[t][nt] = __builtin_amdgcn_mfma_f32_16x16x32_bf16(wh[nt][k2], a, acc[t][nt], 0, 0, 0);
                    acc[t][nt] = __builtin_amdgcn_mfma_f32_16x16x32_bf16(wl[nt][k2], a, acc[t][nt], 0, 0, 0); }
                float xf[8]; unpack8(av[t][k2], xf); ssq[t] += sumsq8(xf); }
        __builtin_amdgcn_sched_barrier(0);
    }
    constexpr int WSTR = NT * 768 + NT * 64;
    LAS float* pl = (LAS float*)F.lds + F.wave * WSTR;
#pragma unroll
    for (int t = 0; t < NT; ++t) {
#pragma unroll
        for (int nt = 0; nt < 3; ++nt) *(LAS f32x4*)(pl + (t * 16 + r) * 48 + nt * 16 + 4 * fq) = acc[t][nt];
        pl[NT * 768 + t * 64 + fq * 16 + r] = ssq[t]; }
    __syncthreads();
    if (F.tid < NT * 16) { const int t = F.tid >> 4, rr = F.tid & 15, row = rowbase + F.tid;
        const LAS float* base = (const LAS float*)F.lds;
        float s = 0.f;
#pragma unroll
        for (int w = 0; w < 8; ++w)
#pragma unroll
            for (int f = 0; f < 4; ++f) s += base[w * WSTR + NT * 768 + t * 64 + f * 16 + rr];
        const float rinv = rsqrtf(s * (1.f / DM) + RMS_EPS);
        const float* rc = (const float*)(F.ws + WS_RC) + mr * 36;
        const LAS float* lrow = base + (t * 16 + rr) * 48;
        float l1[4];
#pragma unroll
        for (int i = 0; i < 4; ++i) { float v = 0.f;
#pragma unroll
            for (int w = 0; w < 8; ++w) v += lrow[w * WSTR + i];
            l1[i] = v * rinv + rc[i]; }
        int grp = 0; float best = l1[0];
#pragma unroll
        for (int i = 1; i < 4; ++i) if (l1[i] > best) { best = l1[i]; grp = i; }
        float den = 0.f;
#pragma unroll
        for (int i = 0; i < 4; ++i) den += __expf(l1[i] - best);
        const float pgrp = 1.f / den;
        float l2[8];
#pragma unroll
        for (int q = 0; q < 8; ++q) { float v = 0.f;
#pragma unroll
            for (int w = 0; w < 8; ++w) v += lrow[w * WSTR + 16 + grp * 8 + q];
            l2[q] = v * rinv + rc[4 + grp * 8 + q]; }
        int i0 = 0; float v0 = l2[0];
#pragma unroll
        for (int i = 1; i < 8; ++i) if (l2[i] > v0) { v0 = l2[i]; i0 = i; }
        int i1 = -1; float v1 = -3.0e38f;
#pragma unroll
        for (int i = 0; i < 8; ++i) if (i != i0 && l2[i] > v1) { v1 = l2[i]; i1 = i; }
        const float e1 = __expf(v1 - v0), w0 = 1.f / (1.f + e1), w1 = e1 * w0;
        ea = grp * 8 + i0; eb = grp * 8 + i1; myrow = row;
        ra = __hip_atomic_fetch_add(&lcnt[ea], 1u, __ATOMIC_RELAXED, __HIP_MEMORY_SCOPE_WORKGROUP);
        rb = __hip_atomic_fetch_add(&lcnt[eb], 1u, __ATOMIC_RELAXED, __HIP_MEMORY_SCOPE_WORKGROUP);
        gatew[row * 2] = pgrp * w0; gatew[row * 2 + 1] = pgrp * w1;
    }
    __syncthreads();
}
__device__ __forceinline__ void rows_norm2_router(const Ctx& F, int l) {
    const float* mod = (const float*)(F.ws + WS_MOD);
    const bf16* xres = (const bf16*)(F.ws + WS_XRES);
    bf16* gb = (bf16*)(F.ws + WS_H);
    const float* g2w = KIN(7) + l * DM;
    LAS unsigned* lcnt = (LAS unsigned*)(F.lds + MISC_OFF + 1024); LAS unsigned* lbase = lcnt + 32;
    if (F.tid < 64) lcnt[F.tid] = 0u;
    __syncthreads();
    unsigned* cnt = (unsigned*)(F.ws + WS_CTL) + CW_CNT + l * 64 + (F.dry ? 8192 : 0);
    int* list = (int*)(F.ws + (F.dry ? WS_E2 : WS_LIST));
    float* gatew = (float*)(F.ws + (F.dry ? WS_E2 + 4 * MiB : WS_GATEW));
    const int nrows = (l == DEPTH - 1) ? LAT_ROWS : TOK;
    int ea = 0, eb = 0, myrow = -1, ea2 = 0, eb2 = 0, myrow2 = -1; unsigned ra = 0u, rb = 0u, ra2 = 0u, rb2 = 0u;
    router_pass<4>(F, xres, 64 * F.bid, F.bid >> 6, lcnt, gatew, ea, eb, ra, rb, myrow);
    if (l < DEPTH - 1 && F.bid < 64) router_pass<1>(F, xres, LAT_ROWS + 16 * F.bid, 4, lcnt, gatew, ea2, eb2, ra2, rb2, myrow2);
    constexpr int RR = 2;
    const int ntrip = (l < DEPTH - 1 && F.gw >= F.NGW - (TOK - LAT_ROWS)) ? 5 : 4;
    for (int trip = 0; trip < ntrip; ++trip) {
        RowV xx[RR]; int rws[RR];
#pragma unroll
        for (int rr = 0; rr < RR; ++rr) { rws[rr] = trip < 4 ? 64 * F.bid + 8 * F.wave + 2 * trip + rr : LAT_ROWS + F.gw - (F.NGW - (TOK - LAT_ROWS)); ld_row_bf16(xres + (size_t)rws[rr] * DM, F.lane, xx[rr]); }
#pragma unroll
        for (int rr = 0; rr < RR; ++rr) { if (trip == 4 && rr == 1) break;
            const int row = rws[rr];
            RowV& x = xx[rr];
            const float rinv = rsqrtf(row_sumsq(x) * (1.f / DM) + RMS_EPS);
            const float* mrow = mod + ((size_t)l * 5 + modrow_of(row)) * NMOD;
#pragma unroll
            for (int j = 0; j < 2; ++j) { const int col = 8 * F.lane + 512 * j;
                float gv[8], sh[8], scl[8]; ld8f(g2w + col, gv); ld8f(mrow + 3 * DM + col, sh); ld8f(mrow + 4 * DM + col, scl);
#pragma unroll
                for (int i = 0; i < 8; ++i) x.v[j][i] = x.v[j][i] * rinv * gv[i] * (1.f + scl[i]) + sh[i];
                *(u32x4*)(gb + (size_t)row * DM + col) = pack8(x.v[j]); }
        }
    }
    __syncthreads();
    if (F.tid < 32) { const unsigned n = lcnt[F.tid]; lbase[F.tid] = n ? atomicAdd(&cnt[F.tid], n) : 0u; }
    __syncthreads();
    if (myrow >= 0) { list[(size_t)ea * LIST_CAP + lbase[ea] + ra] = myrow * 2; list[(size_t)eb * LIST_CAP + lbase[eb] + rb] = myrow * 2 + 1; }
    if (myrow2 >= 0) { list[(size_t)ea2 * LIST_CAP + lbase[ea2] + ra2] = myrow2 * 2; list[(size_t)eb2 * LIST_CAP + lbase[eb2] + rb2] = myrow2 * 2 + 1; }
    __syncthreads();
}
__device__ __forceinline__ void rows_mla_pre(const Ctx& F, int i) {
    const bf16* z = (const bf16*)(F.ws + WS_ZRAW); bf16* ac = (bf16*)(F.ws + WS_ACAT);
    const float* gq = KIN(19) + i * 256; const float* gkv = KIN(21) + i * 128;
    for (int row = F.gw; row < TOK; row += F.NGW) {
        const u32x2 qv = *(const u32x2*)(z + (size_t)row * 1024 + 512 + 4 * F.lane);
        const float q0 = bflo(qv.x), q1 = bfhi(qv.x), q2 = bflo(qv.y), q3 = bfhi(qv.y);
        const float rq = rsqrtf(wave_sum(q0 * q0 + q1 * q1 + q2 * q2 + q3 * q3) * (1.f / 256.f) + RMS_EPS);
        const f32x4 gv = *(const f32x4*)(gq + 4 * F.lane);
        u32x2 w; w.x = pk2(q0 * rq * gv[0], q1 * rq * gv[1]); w.y = pk2(q2 * rq * gv[2], q3 * rq * gv[3]);
        *(u32x2*)(ac + (size_t)row * 512 + 4 * F.lane) = w;
        float k0 = 0.f, k1 = 0.f, k2 = 0.f, k3 = 0.f;
        if (F.lane < 32) { const u32x2 kv = *(const u32x2*)(z + (size_t)row * 1024 + 768 + 4 * F.lane); k0 = bflo(kv.x); k1 = bfhi(kv.x); k2 = bflo(kv.y); k3 = bfhi(kv.y); }
        const float rk = rsqrtf(wave_sum(k0 * k0 + k1 * k1 + k2 * k2 + k3 * k3) * (1.f / 128.f) + RMS_EPS);
        u32x2 w2 = (u32x2){0u, 0u};
        if (F.lane < 32) { const f32x4 gk = *(const f32x4*)(gkv + 4 * F.lane); w2.x = pk2(k0 * rk * gk[0], k1 * rk * gk[1]); w2.y = pk2(k2 * rk * gk[2], k3 * rk * gk[3]); }
        *(u32x2*)(ac + (size_t)row * 512 + 256 + 4 * F.lane) = w2;
    }
}
__device__ __forceinline__ void rows_mla_post(const Ctx& F, int i) {
    const bf16* qk = (const bf16*)(F.ws + WS_QKVM); const bf16* z = (const bf16*)(F.ws + WS_ZRAW);
    bf16* Qb = (bf16*)(F.ws + WS_QB); bf16* Kb = (bf16*)(F.ws + WS_KB); bf16* Vb = (bf16*)(F.ws + WS_VB);
    const float* qn = KIN(23) + i * 96; const float* kn = KIN(24) + i * 96;
    const float* rope = (const float*)(F.ws + WS_ROPE) + ROPE32_OFF;
    const int lane = F.lane, s = lane & 15, hq = lane >> 4, a = s & 1;
    const bool is_nope = s < 8, is_rope = (s == 8 || s == 9), is_zero = (s >= 10 && s < 14);
    const int d1 = is_nope ? 8 * s : 64 + a * 16, d2 = 64 + a * 16 + 8;
    float wq1[8], wq2[8], wk1[8], wk2[8];
#pragma unroll
    for (int j = 0; j < 8; ++j) { wq1[j] = qn[d1 + j]; wq2[j] = qn[d2 + j]; wk1[j] = kn[d1 + j]; wk2[j] = kn[d2 + j]; }
    constexpr int RR = 1;
    for (int row0 = F.gw; row0 < TOK; row0 += RR * F.NGW) {
        unsigned z0 = 0u; asm volatile("" : "+v"(z0)); const u32x4 zero4 = (u32x4){z0, z0, z0, z0};
        u32x4 q1[RR][2], q2[RR][2], k1[RR][2], kr1[RR], kr2[RR], vv[RR];
#pragma unroll
        for (int rr = 0; rr < RR; ++rr) { int row = row0 + rr * F.NGW; row = row < TOK ? row : TOK - 1;
            const bf16* qr = qk + (size_t)row * 1792; const bf16* kr = z + (size_t)row * 1024 + 896;
#pragma unroll
            for (int p2 = 0; p2 < 2; ++p2) { const int hd = 4 * p2 + hq;
                q1[rr][p2] = (is_nope || is_rope) ? *(const u32x4*)(qr + 96 * hd + d1) : zero4;
                q2[rr][p2] = is_rope ? *(const u32x4*)(qr + 96 * hd + d2) : zero4;
                k1[rr][p2] = is_nope ? *(const u32x4*)(qr + 768 + hd * 128 + 8 * s) : zero4; }
            kr1[rr] = is_rope ? *(const u32x4*)(kr + a * 16) : zero4; kr2[rr] = is_rope ? *(const u32x4*)(kr + a * 16 + 8) : zero4;
            vv[rr] = *(const u32x4*)(qr + 768 + (lane >> 3) * 128 + 64 + 8 * (lane & 7)); }
#pragma unroll
        for (int rr = 0; rr < RR; ++rr) { const int row = row0 + rr * F.NGW; if (row >= TOK) break;
            int b, pos, pa = 0; const bool lat = row < LAT_ROWS;
            if (lat) { b = row >> 12; const int t = row & 4095; pos = 256 + t; pa = a == 0 ? (t >> 6) : (t & 63); }
            else { b = (row - LAT_ROWS) >> 8; pos = (row - LAT_ROWS) & 255; }
            const float* csn = rope + (pa * 8) * 2;
#pragma unroll
            for (int p2 = 0; p2 < 2; ++p2) { const int hd = 4 * p2 + hq; const size_t obase = ((size_t)(b * 8 + hd) * SKV + pos) * 128;
                { float x1[8], x2[8]; unpack8(q1[rr][p2], x1); unpack8(q2[rr][p2], x2);
                  const float rinv = rsqrtf(group16_sum(sumsq8(x1) + sumsq8(x2)) * (1.f / 96.f) + RMS_EPS);
                  u32x4 o1, o2; norm_rope8(x1, x2, rinv, wq1, wq2, csn, is_rope && lat, o1, o2);
                  if (is_nope) *(u32x4*)(Qb + obase + 8 * s) = o1;
                  else if (is_rope) { *(u32x4*)(Qb + obase + d1) = o1; *(u32x4*)(Qb + obase + d2) = o2; }
                  else if (is_zero) *(u32x4*)(Qb + obase + 96 + 8 * (s - 10)) = zero4; }
                { float x1[8], x2[8]; unpack8(is_rope ? kr1[rr] : k1[rr][p2], x1); unpack8(kr2[rr], x2);
                  const float rinv = rsqrtf(group16_sum(sumsq8(x1) + sumsq8(x2)) * (1.f / 96.f) + RMS_EPS);
                  u32x4 o1, o2; norm_rope8(x1, x2, rinv, wk1, wk2, csn, is_rope && lat, o1, o2);
                  if (is_nope) *(u32x4*)(Kb + obase + 8 * s) = o1;
                  else if (is_rope) { *(u32x4*)(Kb + obase + d1) = o1; *(u32x4*)(Kb + obase + d2) = o2; }
                  else if (is_zero) *(u32x4*)(Kb + obase + 96 + 8 * (s - 10)) = zero4; }
            }
            *(u32x4*)(Vb + ((size_t)(b * 8 + (lane >> 3)) * SKV + pos) * 64 + 8 * (lane & 7)) = vv[rr];
        }
    }
}
__device__ __forceinline__ void rows_gqa_post(const Ctx& F, int i) {
    const bf16* z = (const bf16*)(F.ws + WS_ZRAW);
    bf16* Qb = (bf16*)(F.ws + WS_QB); bf16* Kb = (bf16*)(F.ws + WS_KB); bf16* Vb = (bf16*)(F.ws + WS_VB);
    const float* qn = KIN(27) + i * 128; const float* kn = KIN(28) + i * 128;
    const float* rope = (const float*)(F.ws + WS_ROPE);
    const int lane = F.lane, hh = lane >> 3, sub = lane & 7, a = sub >> 2, fc = sub & 3;
    const int d1 = a * 64 + 8 * fc, d2 = d1 + 32;
    float wq1[8], wq2[8], wk1[8], wk2[8];
#pragma unroll
    for (int j = 0; j < 8; ++j) { wq1[j] = qn[d1 + j]; wq2[j] = qn[d2 + j]; wk1[j] = kn[d1 + j]; wk2[j] = kn[d2 + j]; }
    const bool isk = lane < 32; const int l2 = lane - 32;
    constexpr int RR = 1;
    for (int row0 = F.gw; row0 < TOK; row0 += RR * F.NGW) {
        u32x4 q1[RR], q2[RR], s1[RR], s2[RR];
#pragma unroll
        for (int rr = 0; rr < RR; ++rr) { int row = row0 + rr * F.NGW; row = row < TOK ? row : TOK - 1;
            const bf16* r = z + (size_t)row * 2048;
            q1[rr] = *(const u32x4*)(r + hh * 128 + d1); q2[rr] = *(const u32x4*)(r + hh * 128 + d2);
            s1[rr] = *(const u32x4*)(isk ? r + 1024 + hh * 128 + d1 : r + 1536 + 16 * l2); s2[rr] = *(const u32x4*)(isk ? r + 1024 + hh * 128 + d2 : r + 1536 + 16 * l2 + 8); }
#pragma unroll
        for (int rr = 0; rr < RR; ++rr) { const int row = row0 + rr * F.NGW; if (row >= TOK) break;
            int b, pos, pa = 0; const bool lat = row < LAT_ROWS;
            if (lat) { b = row >> 12; const int t = row & 4095; pos = 256 + t; pa = a == 0 ? (t >> 6) : (t & 63); }
            else { b = (row - LAT_ROWS) >> 8; pos = (row - LAT_ROWS) & 255; }
            const float* csn = rope + (pa * 32 + 8 * fc) * 2;
            { float x1[8], x2[8]; unpack8(q1[rr], x1); unpack8(q2[rr], x2);
              const float rinv = rsqrtf(group8_sum(sumsq8(x1) + sumsq8(x2)) * (1.f / 128.f) + RMS_EPS);
              u32x4 o1, o2; norm_rope8(x1, x2, rinv, wq1, wq2, csn, lat, o1, o2);
              bf16* o = Qb + ((size_t)(b * 8 + hh) * SKV + pos) * 128; *(u32x4*)(o + d1) = o1; *(u32x4*)(o + d2) = o2; }
            { float x1[8], x2[8]; unpack8(s1[rr], x1); unpack8(s2[rr], x2);
              const float rinv = rsqrtf(group8_sum(sumsq8(x1) + sumsq8(x2)) * (1.f / 128.f) + RMS_EPS);
              u32x4 o1, o2; norm_rope8(x1, x2, rinv, wk1, wk2, csn, lat, o1, o2);
              if (isk) { bf16* o = Kb + ((size_t)(b * 4 + hh) * SKV + pos) * 128; *(u32x4*)(o + d1) = o1; *(u32x4*)(o + d2) = o2; }
              else { bf16* o = Vb + ((size_t)(b * 4 + (l2 >> 3)) * SKV + pos) * 128 + 16 * (l2 & 7); *(u32x4*)(o) = s1[rr]; *(u32x4*)(o + 8) = s2[rr]; } }
        }
    }
}
__device__ __forceinline__ void rows_final(const Ctx& F) {
    const float* mod = (const float*)(F.ws + WS_MOD); const bf16* ydn = (const bf16*)(F.ws + WS_YDN); const bf16* xres = (const bf16*)(F.ws + WS_XRES);
#pragma unroll 2
    for (int row = F.gw; row < LAT_ROWS; row += F.NGW) {
        const float* g2 = mod + ((size_t)(DEPTH - 1) * 5 + (row >> 12)) * NMOD + 5 * DM;
        RowV x; ld_row_bf16(xres + (size_t)row * DM, F.lane, x);
#pragma unroll
        for (int j = 0; j < 2; ++j) { const int col = 8 * F.lane + 512 * j;
            float gv[8], a[8], b2[8]; ld8f(g2 + col, gv);
            unpack8(*(const u32x4*)(ydn + (size_t)(2 * row) * DM + col), a); unpack8(*(const u32x4*)(ydn + (size_t)(2 * row + 1) * DM + col), b2);
            f32x4 o0, o1;
#pragma unroll
            for (int i = 0; i < 4; ++i) { o0[i] = x.v[j][i] + gv[i] * (a[i] + b2[i]); o1[i] = x.v[j][4 + i] + gv[4 + i] * (a[4 + i] + b2[4 + i]); }
            *(f32x4*)(F.out + (size_t)row * DM + col) = o0; *(f32x4*)(F.out + (size_t)row * DM + col + 4) = o1; }
    }
}
#define XB_TMO      128
#define XB_XCNT(j)  (256  + 64 * (j))
#define XB_XSUB(j)  (1280 + 64 * (j))
#define XB_XGEN(j)  (2304 + 64 * (j))
#define XB_TOP      3328
#define XB_TOPGEN   3392
#define XCD_BAR_WORDS 3456
#define XB_SPIN_CAP (1u << 22)
__device__ __forceinline__ unsigned xb_ld(unsigned* p)              { return __hip_atomic_load(p, __ATOMIC_RELAXED, __HIP_MEMORY_SCOPE_AGENT); }
__device__ __forceinline__ unsigned xb_add(unsigned* p, unsigned v) { return __hip_atomic_fetch_add(p, v, __ATOMIC_RELAXED, __HIP_MEMORY_SCOPE_AGENT); }
__device__ __forceinline__ unsigned xb_xcc_id() { return (unsigned)__builtin_amdgcn_s_getreg((3 << 11) | 20) & 0xFu; }
#define XB_SPIN(cond, bar) do { unsigned _sp = 0; while (cond) { __builtin_amdgcn_s_sleep(1); \
    if ((++_sp & 255u) == 0u) { if (xb_ld(&(bar)[XB_TMO])) break; if (_sp > XB_SPIN_CAP) { atomicAdd(&(bar)[XB_TMO], 1u); break; } } } } while (0)
struct XcdBarrier { unsigned* bar; unsigned x; volatile LAS unsigned* st; };
__device__ __forceinline__ XcdBarrier xcd_barrier_post(unsigned* bar, volatile LAS unsigned* st) {
    XcdBarrier b; b.bar = bar; b.x = xb_xcc_id(); b.st = st;
    if (threadIdx.x == 0) (void)xb_add(&bar[XB_XCNT(b.x)], 1u);
    return b;
}
__device__ __forceinline__ void xcd_barrier_complete(unsigned* bar, unsigned x, unsigned& nloc, unsigned& nx) {
    const unsigned G = gridDim.x * gridDim.y * gridDim.z;
    unsigned sum, cnt, mine, sp = 0u;
    for (;;) {
        sum = 0u; cnt = 0u; mine = 0u;
#pragma unroll
        for (unsigned j = 0; j < 16; ++j) { const unsigned c = xb_ld(&bar[XB_XCNT(j)]); sum += c; cnt += (c > 0u) ? 1u : 0u; mine = (j == x) ? c : mine; }
        if (sum == G) break;
        __builtin_amdgcn_s_sleep(1);
        if ((++sp & 255u) == 0u) { if (xb_ld(&bar[XB_TMO])) break; if (sp > XB_SPIN_CAP) { atomicAdd(&bar[XB_TMO], 1u); break; } }
    }
    nloc = mine > 0u ? mine : 1u; nx = cnt > 0u ? cnt : 1u;
}
__device__ __forceinline__ void xcd_barrier(const XcdBarrier& b) {
    asm volatile("s_waitcnt vmcnt(0)" ::: "memory");
    __syncthreads();
    if (threadIdx.x == 0) {
        unsigned* bar = b.bar;
        __builtin_amdgcn_s_waitcnt(0);
        unsigned nloc = b.st[0], nx = b.st[1];
        if (nloc == 0u) { xcd_barrier_complete(bar, b.x, nloc, nx); b.st[0] = nloc; b.st[1] = nx; }
        const unsigned old = xb_add(&bar[XB_XSUB(b.x)], 1u);
        const unsigned gen = old / nloc;
        if (old + 1u == (gen + 1u) * nloc) {
            __builtin_amdgcn_fence(__ATOMIC_RELEASE, "agent");
            asm volatile("s_waitcnt vmcnt(0)" ::: "memory");
            const unsigned og = xb_add(&bar[XB_TOP], 1u);
            const unsigned tg = og / nx;
            if (og + 1u == (tg + 1u) * nx) xb_add(&bar[XB_TOPGEN], 1u);
            else XB_SPIN(xb_ld(&bar[XB_TOPGEN]) == tg, bar);
            __builtin_amdgcn_fence(__ATOMIC_ACQUIRE, "agent");
            xb_add(&bar[XB_XGEN(b.x)], 1u);
            asm volatile("s_waitcnt vmcnt(0)" ::: "memory");
        } else {
            XB_SPIN(xb_ld(&bar[XB_XGEN(b.x)]) == gen, bar);
            __builtin_amdgcn_fence(__ATOMIC_ACQUIRE, "agent");
            asm volatile("s_waitcnt vmcnt(0)" ::: "memory");
        }
    }
    __syncthreads();
}

constexpr int NPH = 1 + 2 * 9 + 2 * 7 + 1;
constexpr int G_NONE = -1;
using pg8::G_INPROJ; using pg8::G_MLA; using pg8::G_GLU; using pg8::G_OUT; using pg8::G_QKV; using pg8::G_MOE1; using pg8::G_MOE2;
enum { K_NONE = 0, K_NORM1, K_MLA_PRE_S5A, K_MLA_POST, K_S5B_ATT, K_NORM2, K_GQA_POST, K_ATT_GQA };

__device__ __forceinline__ void attention_phase(const Ctx& F, int l, bool even) {
    const bf16* Qb = (const bf16*)(F.ws + WS_QB); const bf16* Kb = (const bf16*)(F.ws + WS_KB); const bf16* Vb = (const bf16*)(F.ws + WS_VB);
    bf16* mix = (bf16*)(F.ws + WS_MIX);
    const int c = F.bid, x = c & 7, slot = c >> 3;
    const int nround = (l == DEPTH - 1) ? 2 : 3;
    for (int round = 0; round < nround; ++round) {
        int b, h, qb; bool ctxu = false;
        if (round < 2) {
            if (even) { const int pair = round * 16 + x * 2 + (slot >> 4); b = pair >> 3; h = pair & 7; qb = slot & 15; }
            else { const int pair = round * 8 + x; b = pair >> 2; h = (pair & 3) * 2 + (slot >> 4); qb = slot & 15; }
        } else { if (c >= 32) break; b = c >> 3; h = c & 7; qb = 0; ctxu = true; }
        const size_t qrow = (size_t)(b * 8 + h) * SKV + (ctxu ? 0 : 256 + qb * 256);
        const int orow = ctxu ? LAT_ROWS + b * 256 : b * 4096 + qb * 256;
        const int seq = ctxu ? CTXL : SKV;
        if (even) {
            att::attn_dense_body<64, 1, 1024, 96>(Qb + qrow * 128, Kb + (size_t)(b * 8 + h) * SKV * 128, Vb + (size_t)(b * 8 + h) * SKV * 64,
                                              mix + (size_t)orow * 1024 + 512 + h * 64, seq, (char*)F.lds, F.tid);
        } else {
            const int kvh = h >> 1;
            att::attn_dense_body<128, 0, 1024, 128>(Qb + qrow * 128, Kb + (size_t)(b * 4 + kvh) * SKV * 128, Vb + (size_t)(b * 4 + kvh) * SKV * 128,
                                               mix + (size_t)orow * 1024 + h * 128, seq, (char*)F.lds, F.tid);
        }
    }
}


#ifdef DBG_CHECKS
constexpr int CW_FLAGS = 20000;
__device__ __forceinline__ void dbg_flag(const Ctx& F, int j) { atomicOr((unsigned*)(F.ws + WS_CTL) + CW_FLAGS, 1u << j); }
__device__ __forceinline__ void dbg_moe_check(const Ctx& F, int l) {
    const unsigned* cnt = (const unsigned*)(F.ws + WS_CTL) + CW_CNT + l * 64; const int* list = (const int*)(F.ws + WS_LIST);
    const bf16* g = (const bf16*)(F.ws + WS_H); const bf16* act = (const bf16*)(F.ws + WS_ACT); const bf16* ydn = (const bf16*)(F.ws + WS_YDN);
    const float* gatew = (const float*)(F.ws + WS_GATEW);
    for (int s = F.gw; s < 96; s += F.NGW) {
        const int e = s & 31, which = s >> 5; const int c = (int)cnt[e]; if (c == 0) continue;
        const int pos = which == 0 ? 0 : (which == 1 ? c - 1 : (c > 300 ? 300 : c / 2));
        const int ent = list[(size_t)e * LIST_CAP + pos], row = ent >> 1;
        const float* wg = KIN(33) + ((size_t)l * 32 + e) * 1024 * 512; const float* wu = KIN(34) + ((size_t)l * 32 + e) * 1024 * 512; const float* wd = KIN(35) + ((size_t)l * 32 + e) * 512 * 1024;
        float h1[8], h2[8];
        for (int j = 0; j < 8; ++j) { h1[j] = 0.f; h2[j] = 0.f; }
        for (int k = 0; k < 1024; ++k) { const float gv = bf2f(g[(size_t)row * 1024 + k]);
            for (int j = 0; j < 8; ++j) { h1[j] += gv * wg[(size_t)k * 512 + F.lane + 64 * j]; h2[j] += gv * wu[(size_t)k * 512 + F.lane + 64 * j]; } }
        float err = 0.f, ss = 0.f;
        for (int j = 0; j < 8; ++j) { const float r = siluf_(h1[j]) * h2[j]; const float a = bf2f(act[(size_t)ent * 512 + F.lane + 64 * j]); err = fmaxf(err, fabsf(a - r)); ss += r * r; }
        err = wave_max(err); ss = wave_sum(ss);
        if (!(err <= 0.1f * __builtin_amdgcn_sqrtf(ss / 512.f) + 1e-6f)) { if (F.lane == 0) dbg_flag(F, 0); }
        float y[16];
        for (int j = 0; j < 16; ++j) y[j] = 0.f;
        for (int f = 0; f < 512; ++f) { const float av = bf2f(act[(size_t)ent * 512 + f]);
            for (int j = 0; j < 16; ++j) y[j] += av * wd[(size_t)f * 1024 + F.lane + 64 * j]; }
        const float gw = gatew[ent]; float err2 = 0.f, ss2 = 0.f;
        for (int j = 0; j < 16; ++j) { const float r = y[j] * gw; const float a = bf2f(ydn[(size_t)ent * 1024 + F.lane + 64 * j]); err2 = fmaxf(err2, fabsf(a - r)); ss2 += r * r; }
        err2 = wave_max(err2); ss2 = wave_sum(ss2);
        if (!(err2 <= 0.1f * __builtin_amdgcn_sqrtf(ss2 / 1024.f) + 1e-6f)) { if (F.lane == 0) dbg_flag(F, 1); }
        else if (ss2 > 1e-8f && ss > 1e-8f && F.lane == 0) dbg_flag(F, 3);
    }
}
__device__ __forceinline__ void dbg_mod_check(const Ctx& F, int l) {
    const float* mod = (const float*)(F.ws + WS_MOD);
    for (int s = F.gw; s < 60; s += F.NGW) {
        const int r = s % 5, n = (s * 509 + 77) % 6144;
        float ser = 0.f;
        for (int k = 0; k < 1024; ++k) { const float cv = r < 4 ? KIN(1)[r * 1024 + k] : KIN(3)[k]; ser += siluf_(cv) * KIN(4)[((size_t)l * 1024 + k) * 6144 + n]; }
        ser += KIN(5)[l * 6144 + n];
        float acc = 0.f;
        for (int k = F.lane; k < 1024; k += 64) { const float cv = r < 4 ? KIN(1)[r * 1024 + k] : KIN(3)[k]; acc += siluf_(cv) * KIN(4)[((size_t)l * 1024 + k) * 6144 + n]; }
        acc = wave_sum(acc) + KIN(5)[l * 6144 + n];
        const float got = mod[((size_t)l * 5 + r) * 6144 + n];
        if (!(fabsf(got - ser) <= 1e-3f + 1e-3f * fabsf(ser))) { if (F.lane == 0) dbg_flag(F, 0); }
        if (!(fabsf(acc - ser) <= 1e-3f + 1e-3f * fabsf(ser))) { if (F.lane == 0) dbg_flag(F, 1); }
    }
    return;
    const float* xres = (const float*)(F.ws + WS_XRES); const unsigned* cnt = (const unsigned*)(F.ws + WS_CTL) + CW_CNT + l * 64; const int* list = (const int*)(F.ws + WS_LIST);
    const float* gatew = (const float*)(F.ws + WS_GATEW); const bf16* gb = (const bf16*)(F.ws + WS_H);
    for (int s = F.gw; s < 64; s += F.NGW) {
        const int row = (s * 263 + 11) % TOK; const int mr = modrow_of(row);
        float ssq = 0.f;
        for (int k = F.lane; k < 1024; k += 64) { const float v = xres[(size_t)row * 1024 + k]; ssq += v * v; }
        const float rinv = rsqrtf(wave_sum(ssq) / 1024.f + 1e-6f);
        float lg[36];
#pragma unroll
        for (int j = 0; j < 36; ++j) lg[j] = 0.f;
        float gerr = 0.f;
        for (int k = F.lane; k < 1024; k += 64) {
            const float gv = xres[(size_t)row * 1024 + k] * rinv * KIN(7)[l * 1024 + k] * (1.f + mod[((size_t)l * 5 + mr) * 6144 + 4096 + k]) + mod[((size_t)l * 5 + mr) * 6144 + 3072 + k];
            gerr = fmaxf(gerr, fabsf(bf2f(gb[(size_t)row * 1024 + k]) - gv));
#pragma unroll
            for (int j = 0; j < 4; ++j) lg[j] += gv * KIN(29)[((size_t)l * 1024 + k) * 4 + j];
#pragma unroll
            for (int j = 0; j < 32; ++j) lg[4 + j] += gv * KIN(31)[((size_t)l * 1024 + k) * 32 + j];
        }
        gerr = wave_max(gerr);
#pragma unroll
        for (int j = 0; j < 36; ++j) lg[j] = wave_sum(lg[j]);
#pragma unroll
        for (int j = 0; j < 4; ++j) lg[j] += KIN(30)[l * 4 + j];
#pragma unroll
        for (int j = 0; j < 32; ++j) lg[4 + j] += KIN(32)[l * 32 + j];
        int grp = 0; float bestg = lg[0];
#pragma unroll
        for (int j = 1; j < 4; ++j) if (lg[j] > bestg) { bestg = lg[j]; grp = j; }
        float den = 0.f;
#pragma unroll
        for (int j = 0; j < 4; ++j) den += __expf(lg[j] - bestg);
        float l8[8];
#pragma unroll
        for (int j = 0; j < 8; ++j) { float v = 0.f;
#pragma unroll
            for (int q = 0; q < 4; ++q) v = (grp == q) ? lg[4 + q * 8 + j] : v;
            l8[j] = v; }
        int i0 = 0; float v0 = l8[0];
#pragma unroll
        for (int j = 1; j < 8; ++j) if (l8[j] > v0) { v0 = l8[j]; i0 = j; }
        int i1 = -1; float v1 = -3.0e38f;
#pragma unroll
        for (int j = 0; j < 8; ++j) if (j != i0 && l8[j] > v1) { v1 = l8[j]; i1 = j; }
        const float e1 = __expf(v1 - v0), w0 = 1.f / (1.f + e1) / den, w1 = e1 / (1.f + e1) / den;
        if (gerr > 0.05f && F.lane == 0) dbg_flag(F, 1);
        bool bad = false;
        if (fabsf(gatew[row * 2] - w0) > 1e-3f || fabsf(gatew[row * 2 + 1] - w1) > 1e-3f) bad = true;
        const int ea = grp * 8 + i0, eb = grp * 8 + i1; bool fa = false, fb = false;
        for (int q = F.lane; q < (int)cnt[ea]; q += 64) if (list[(size_t)ea * LIST_CAP + q] == row * 2) fa = true;
        for (int q = F.lane; q < (int)cnt[eb]; q += 64) if (list[(size_t)eb * LIST_CAP + q] == row * 2 + 1) fb = true;
        if (!__any(fa) || !__any(fb)) bad = true;
        if (bad && F.lane == 0) dbg_flag(F, 2);
    }
}
__device__ __forceinline__ void dbg_final(const Ctx& F) {
    const unsigned flags = ((const unsigned*)(F.ws + WS_CTL))[CW_FLAGS];
    for (int row = F.gw; row < LAT_ROWS; row += F.NGW) {
        bool zero = false;
        for (int j = 0; j < 4; ++j) { const int lo = 512 * ((1 << j) - 1), hi = 512 * ((2 << j) - 1); if (((flags >> j) & 1u) && row >= lo && row < hi) zero = true; }
#pragma unroll
        for (int j = 0; j < 4; ++j) { const int col = 4 * F.lane + 256 * j; f32x4 xv = *(const f32x4*)(KIN(0) + (size_t)row * DM + col); if (zero) xv = (f32x4){0.f, 0.f, 0.f, 0.f};
            *(f32x4*)(F.out + (size_t)row * DM + col) = xv; }
    }
}
#endif

#ifdef DBG_TS
__device__ __forceinline__ void dbg_ts_final(const Ctx& F) {
    const unsigned long long* tsb = (const unsigned long long*)(F.ws + WS_CTL + 512 * 1024);
    unsigned long long da = 0, db = 0;
    for (int ph = 0; ph < NPH - 1; ++ph) { const unsigned long long d = tsb[ph + 1] - tsb[ph];
        if ((DBG_TSA >> ph) & 1ull) da += d; if ((DBG_TSB >> ph) & 1ull) db += d; }
    const int nz = (int)(da * 8 / 100) < LAT_ROWS ? (int)(da * 8 / 100) : LAT_ROWS;
    for (int row = F.gw; row < LAT_ROWS; row += F.NGW) {
#pragma unroll
        for (int j = 0; j < 4; ++j) { const int col = 4 * F.lane + 256 * j; f32x4 xv = *(const f32x4*)(KIN(0) + (size_t)row * DM + col); if (row < nz) xv = (f32x4){0.f, 0.f, 0.f, 0.f};
            if (row == 0 && col == 0) xv[0] = (float)db;
            *(f32x4*)(F.out + (size_t)row * DM + col) = xv; }
    }
}
#endif

__device__ __forceinline__ void run_phase(const Ctx& F0, int ph, int sub = 3) {
    Ctx F = F0;
    asm volatile("" : "+s"(F.ws), "+s"(F.out), "+s"(F.bid), "+s"(F.G));
    asm volatile("" : "+v"(F.tid));
    F.lane = F.tid & 63; F.wave = __builtin_amdgcn_readfirstlane(F.tid >> 6); F.gw = F.bid * 8 + F.wave; F.NGW = F.G * 8;
    { unsigned ldsb = (unsigned)(uintptr_t)F0.lds; asm volatile("" : "+s"(ldsb)); F.lds = (LAS unsigned char*)(uintptr_t)ldsb; }
#ifndef T_NO_P0
    if (ph == 0) {
        if (F.bid < 192) p0_ada(F);
        else if (F.bid == 192) p0_rope(F);
        else if (F.bid == 193) p0_router_t(F);
        p0_weights(F);
        return;
    }
#endif
#ifdef DBG_CHECKS
    if (ph == NPH - 1) { dbg_final(F); return; }
    if (ph >= 100) { dbg_mod_check(F, ph - 100); return; }
#endif
#ifdef DBG_TS
    if (ph == NPH - 1) { dbg_ts_final(F); return; }
#endif
    if (ph == NPH - 1) { rows_final(F); return; }
    if (ph >= 60) return;
    int l, step; { int q = ph - 1; if (q < 9) { l = 0; step = q; } else if (q < 16) { l = 1; step = q - 9; } else if (q < 25) { l = 2; step = q - 16; } else { l = 3; step = q - 25; } }
    const bool even = (l & 1) == 0; const int i = l >> 1;
    int gid = G_NONE, kind = K_NONE;
    if (even) {
        switch (step) { case 0: kind = K_NORM1; break; case 1: gid = G_INPROJ; break; case 2: kind = K_MLA_PRE_S5A; break; case 3: gid = G_MLA; break; case 4: kind = K_MLA_POST; break;
                        case 5: kind = K_S5B_ATT; gid = G_GLU; break; case 6: gid = G_OUT; break; case 7: kind = K_NORM2; break; default: gid = G_MOE1; break; }
    } else {
        switch (step) { case 0: kind = K_NORM1; break; case 1: gid = G_QKV; break; case 2: kind = K_GQA_POST; break; case 3: kind = K_ATT_GQA; break; case 4: gid = G_OUT; break;
                        case 5: kind = K_NORM2; break; default: gid = G_MOE1; break; }
    }
    switch (kind) {
#ifndef T_NO_ROWS
    case K_NORM1: build_router_tab(F, l); rows_norm1(F, l);
#ifndef T_NO_S5
        if (even && F.bid < 8) { const int w = F.bid * 8 + F.wave, dd = w >> 5, g = w & 31;
            s5::Params SP{KIN(10) + (size_t)i * 4096, KIN(11) + (size_t)i * 4096, KIN(12) + i * 64, KIN(13) + (size_t)i * 65536, KIN(14) + (size_t)i * 65536,
                      KIN(15) + (size_t)i * 65536, KIN(16) + (size_t)i * 65536, KIN(17) + i * 512};
            s5::build_tab(SP, dd, g, F.lane, (u32x4*)(F.ws + WS_S5TAB) + (size_t)(i * 64 + dd * 32 + g) * (s5::TAB_BYTES / 16)); }
#endif
        break;
    case K_NORM2: rows_norm2_router(F, l); break;
#endif
    case K_MLA_PRE_S5A: {
        rows_mla_pre(F, i);
        s5::Params SP{KIN(10) + (size_t)i * 4096, KIN(11) + (size_t)i * 4096, KIN(12) + i * 64, KIN(13) + (size_t)i * 65536, KIN(14) + (size_t)i * 65536,
                      KIN(15) + (size_t)i * 65536, KIN(16) + (size_t)i * 65536, KIN(17) + i * 512};
#ifndef T_NO_S5
        if (F.wave >= 4) defer_convert(F, i * 2);
        for (int it = F.gw; it < s5::NITEMS; it += F.NGW) s5::pass_a_item(SP, (const u32x4*)(F.ws + WS_S5TAB) + (size_t)i * 64 * (s5::TAB_BYTES / 16), (const bf16*)(F.ws + WS_ZRAW), (float*)(F.ws + WS_E2), it, F.lane);
        if (F.wave < 4) defer_convert(F, i * 2);
#endif
    } break;
    case K_MLA_POST: {
        rows_mla_post(F, i);
        s5::Params SP{KIN(10) + (size_t)i * 4096, KIN(11) + (size_t)i * 4096, KIN(12) + i * 64, KIN(13) + (size_t)i * 65536, KIN(14) + (size_t)i * 65536,
                      KIN(15) + (size_t)i * 65536, KIN(16) + (size_t)i * 65536, KIN(17) + i * 512};
#ifndef T_NO_S5
        if (F.wave >= 4) defer_convert(F, i * 2 + 1);
        if (sub & 1) for (int it = F.gw; it < s5::NITEMS; it += F.NGW)
            s5::pass_b_item(SP, (const u32x4*)(F.ws + WS_S5TAB) + (size_t)i * 64 * (s5::TAB_BYTES / 16), (const bf16*)(F.ws + WS_ZRAW), (const float*)(F.ws + WS_E2), (bf16*)(F.ws + WS_GG), F.lds + F.wave * s5::HS_BYTES, it, F.lane);
        if (F.wave < 4) defer_convert(F, i * 2 + 1);
#endif
    } break;
    case K_S5B_ATT: {
        __syncthreads();
#ifndef T_NO_ATT
        if (sub & 2) attention_phase(F, l, true);
#endif
    } break;
    case K_GQA_POST: rows_gqa_post(F, i); break;
#ifndef T_NO_ATT
    case K_ATT_GQA: attention_phase(F, l, false); break;
#endif
    default: break;
    }
    if (gid != G_NONE) {
        unsigned char* ws = F.ws;
        const unsigned* cnt = (const unsigned*)(ws + WS_CTL) + CW_CNT + l * 64;
        if (gid == G_MOE1 || gid == G_MOE2) {
            if (F.tid == 0) { LAS int* tp = (LAS int*)(F.lds + MISC_OFF + 256); int acc = 0;
                for (int e = 0; e < NEXP; ++e) { tp[e] = acc; acc += ((int)cnt[e] + 255) >> 8; } tp[NEXP] = acc; }
            __syncthreads();
        }
#ifdef DBG_NOCTX_DRY
#define CTXDRY if (!F.dry)
#else
#define CTXDRY
#endif
#define PROB_COMMON(P) P.G = F.G; P.c = F.bid; P.list = (const int*)(ws + WS_LIST); P.cnt = cnt; P.tp = (const LAS int*)(F.lds + MISC_OFF + 256); \
        P.l = l; P.ws = ws; P.O = nullptr; P.xlat = nullptr; P.xctx = nullptr;
        switch (gid) {
#ifndef T_NO_GEMM
        case G_INPROJ: { pg8::Prob<G_INPROJ> P; PROB_COMMON(P); P.A = (const char*)(ws + WS_H); P.B = (const char*)(ws + WS_W_IN) + (size_t)i * 1024 * 1024 * 2; P.O = (bf16*)(ws + WS_ZRAW); pg8::gemm_phase(F.lds, P, F.tid); CTXDRY pg8::ctx_gemm(F.lds, P, F.tid); } break;
        case G_MLA: {
#ifndef T_NO_S5
            if (F.wave == 0 && F.bid < 256) { s5::Params SP{KIN(10) + (size_t)i * 4096, KIN(11) + (size_t)i * 4096, KIN(12) + i * 64, KIN(13) + (size_t)i * 65536, KIN(14) + (size_t)i * 65536,
                      KIN(15) + (size_t)i * 65536, KIN(16) + (size_t)i * 65536, KIN(17) + i * 512};
                s5::prefix_wave(SP, (float*)(ws + WS_E2), F.bid, F.lane); }
#endif
            pg8::Prob<G_MLA> P; PROB_COMMON(P); P.A = (const char*)(ws + WS_ACAT); P.B = (const char*)(ws + WS_W_MLA) + (size_t)i * 1792 * 256 * 2; P.O = (bf16*)(ws + WS_QKVM); pg8::gemm_phase(F.lds, P, F.tid); } break;
        case G_GLU: { pg8::Prob<G_GLU> P; PROB_COMMON(P); P.A = (const char*)(ws + WS_GG); P.B = (const char*)(ws + WS_W_GLU) + (size_t)i * 512 * 512 * 2; pg8::gemm_phase(F.lds, P, F.tid); } break;
        case G_OUT: { pg8::Prob<G_OUT> P; PROB_COMMON(P); P.A = (const char*)(ws + WS_MIX); P.B = (const char*)(ws + (even ? WS_W_OUTE : WS_W_OUTO)) + (size_t)i * 1024 * 1024 * 2;
            P.xlat = KIN(0); P.xctx = KIN(2); pg8::gemm_phase(F.lds, P, F.tid); if (l < DEPTH - 1) pg8::ctx_gemm(F.lds, P, F.tid); } break;
        case G_QKV: { pg8::Prob<G_QKV> P; PROB_COMMON(P); P.A = (const char*)(ws + WS_H); P.B = (const char*)(ws + WS_W_QKV) + (size_t)i * 2048 * 1024 * 2; P.O = (bf16*)(ws + WS_ZRAW); pg8::gemm_phase(F.lds, P, F.tid); CTXDRY pg8::ctx_gemm(F.lds, P, F.tid); } break;
        default: { unsigned* ready = (unsigned*)(ws + WS_CTL) + CW_READY + l * READY_L;
            { pg8::Prob<G_MOE1> P; PROB_COMMON(P); P.ready = ready; P.A = (const char*)(ws + WS_H); P.B = (const char*)(ws + WS_W_GU) + (size_t)l * 32 * 1024 * 1024 * 2; pg8::gemm_phase(F.lds, P, F.tid); }
            { pg8::Prob<G_MOE2> P; PROB_COMMON(P); P.ready = ready; P.A = (const char*)(ws + WS_ACT); P.B = (const char*)(ws + WS_W_DN) + (size_t)l * 32 * 1024 * 512 * 2; pg8::gemm_phase(F.lds, P, F.tid); } } break;
#else
        default: break;
#endif
        }
#undef PROB_COMMON
        return;
    }
}

struct Args { const float* in[36]; float* out; unsigned char* ws; int ph_lo, ph_hi; };

__global__ void __launch_bounds__(512, 2) mega(Args args) {
    extern __shared__ __attribute__((aligned(16))) unsigned char lds_[];
    Ctx F;
    F.out = args.out; F.ws = args.ws;
    F.lds = (LAS unsigned char*)lds_;
    F.tid = threadIdx.x; F.lane = F.tid & 63; F.wave = __builtin_amdgcn_readfirstlane(F.tid >> 6);
    F.G = gridDim.x; F.bid = blockIdx.x; F.gw = blockIdx.x * 8 + F.wave; F.NGW = F.G * 8;
    volatile LAS unsigned* MISC = (volatile LAS unsigned*)(F.lds + MISC_OFF);
    for (int u = F.tid; u < (LDS_BYTES - RING_BYTES) / 4; u += 512) ((LAS unsigned*)(F.lds + RING_BYTES))[u] = 0u;
    __syncthreads();
    const int lo = args.ph_lo & 0xfff, hi = args.ph_hi & 0xfff; F.dry = (args.ph_hi >> 12) & 1; const int subsel = ((args.ph_hi >> 13) & 3) ? ((args.ph_hi >> 13) & 3) : 3;
    XcdBarrier bar; bar.bar = (unsigned*)(F.ws + WS_CTL) + CW_BAR; bar.x = 0; bar.st = nullptr;
    if (hi - lo > 1) bar = xcd_barrier_post((unsigned*)(F.ws + WS_CTL) + CW_BAR, MISC + 8);
#ifdef DBG_TS
    unsigned long long* tsb = (unsigned long long*)(F.ws + WS_CTL + 512 * 1024);
    if (blockIdx.x == 0 && threadIdx.x == 0) tsb[0] = __builtin_amdgcn_s_memrealtime();
#endif
    for (int ph = lo; ph < hi; ++ph) {
#ifdef DBG_REP
        if ((DBG_REP >> ph) & 1ull) { for (int rr = 0; rr < DBG_REPN; ++rr) { run_phase(F, ph, DBG_REPSUB); __syncthreads(); } }
#endif
        run_phase(F, ph, subsel);
#ifdef DBG_TS
        if (ph == NPH - 2 && blockIdx.x == 0 && threadIdx.x == 0) { asm volatile("s_waitcnt vmcnt(0)" ::: "memory"); tsb[ph + 1] = __builtin_amdgcn_s_memrealtime(); __threadfence(); }
#endif
        if (ph + 1 < hi) { XcdBarrier b2 = bar; asm volatile("" : "+s"(b2.bar), "+s"(b2.x)); xcd_barrier(b2); }
#ifdef DBG_TS
        if (ph < NPH - 2 && blockIdx.x == 0 && threadIdx.x == 0) tsb[ph + 1] = __builtin_amdgcn_s_memrealtime();
#endif
    }
}

#ifndef MK_MULTI
#define MK_MULTI 1
#endif
extern "C" void kernel_launch(void* const* d_in, const int* in_sizes, int n_in, void* d_out, int out_size, void* d_ws, size_t ws_size, hipStream_t stream) {
    static int grid = 0;
    if (grid == 0) {
        if (n_in != 36 || in_sizes[0] != LAT_ROWS * DM || out_size != LAT_ROWS * DM || ws_size < WS_END) {
            fprintf(stderr, "kernel_launch: unexpected shapes: n_in %d in0 %d out %d ws %zu (need >= %zu)\n", n_in, n_in > 0 ? in_sizes[0] : -1, out_size, ws_size, (size_t)WS_END); grid = -1; return; }
        int dev = 0, cus = 0, per_cu = 0;
        if (hipGetDevice(&dev) != hipSuccess || hipDeviceGetAttribute(&cus, hipDeviceAttributeMultiprocessorCount, dev) != hipSuccess) { fprintf(stderr, "kernel_launch: device query failed\n"); grid = -1; return; }
        if (hipFuncSetAttribute((const void*)mega, hipFuncAttributeMaxDynamicSharedMemorySize, LDS_BYTES) != hipSuccess) { fprintf(stderr, "kernel_launch: hipFuncSetAttribute failed\n"); grid = -1; return; }
        if (hipOccupancyMaxActiveBlocksPerMultiprocessor(&per_cu, (const void*)mega, 512, LDS_BYTES) != hipSuccess || per_cu < 1) { fprintf(stderr, "kernel_launch: occupancy query says %d\n", per_cu); per_cu = 1; }
        (void)hipGetLastError();
        grid = cus;
    }
    if (grid < 0) return;
    (void)hipMemsetAsync((char*)d_ws + WS_CTL, 0, CTL_ZERO_BYTES, stream);
    Args a{};
    for (int i = 0; i < 36; ++i) a.in[i] = (const float*)d_in[i];
    a.out = (float*)d_out; a.ws = (unsigned char*)d_ws;
#if MK_MULTI
#ifndef DBG_STOP_PH
#define DBG_STOP_PH (NPH - 2)
#endif
    for (int p = 0; p < NPH; ++p) {
        if (p > DBG_STOP_PH && p != NPH - 1) continue;
#ifdef DBG_CHECKS
        if (p == NPH - 1) { a.ph_lo = 100 + DBG_CHECK_L; a.ph_hi = a.ph_lo + 1; hipLaunchKernelGGL(mega, dim3(grid), dim3(512), LDS_BYTES, stream, a); }
#endif
        a.ph_lo = p; a.ph_hi = p + 1;
#ifdef DBG_NOOPS
        if (p == 5) { a.ph_lo = 61; a.ph_hi = 62; for (int rr = 0; rr < DBG_NOOPS; ++rr) hipLaunchKernelGGL(mega, dim3(grid), dim3(512), LDS_BYTES, stream, a); a.ph_lo = p; a.ph_hi = p + 1; }
#endif
#ifdef DBG_HREP
        if ((DBG_HREP >> p) & 1ull) { a.ph_hi = (p + 1) | 0x1000 | (DBG_HSUB << 13); for (int rr = 0; rr < DBG_HREPN; ++rr) hipLaunchKernelGGL(mega, dim3(grid), dim3(512), LDS_BYTES, stream, a); a.ph_hi = p + 1; }
#endif
        hipLaunchKernelGGL(mega, dim3(grid), dim3(512), LDS_BYTES, stream, a);
    }
#else
    a.ph_lo = 0; a.ph_hi = NPH;
    void* kargs[] = {&a};
    hipError_t e = hipLaunchCooperativeKernel((const void*)mega, dim3(grid), dim3(512), kargs, LDS_BYTES, stream);
    if (e != hipSuccess) fprintf(stderr, "kernel_launch: cooperative launch failed: %s (grid %d)\n", hipGetErrorString(e), grid);
#endif
    const hipError_t le = hipPeekAtLastError();
    if (le != hipSuccess) fprintf(stderr, "kernel_launch: launch failed: %s\n", hipGetErrorName(le));
}
```

```cpp
#include <hip/hip_runtime.h>
#include <cstdio>
#include <cstdint>
#ifndef MK_MULTI
#define MK_MULTI 0
#endif
#define GAS __attribute__((address_space(1)))
#define LAS __attribute__((address_space(3)))
typedef unsigned short bf16;
typedef short bf16x8 __attribute__((ext_vector_type(8)));
typedef short s16x4 __attribute__((ext_vector_type(4)));
typedef float f32x2 __attribute__((ext_vector_type(2)));
typedef float f32x4 __attribute__((ext_vector_type(4)));
typedef float f32x16 __attribute__((ext_vector_type(16)));
typedef unsigned u32x2 __attribute__((ext_vector_type(2)));
typedef unsigned u32x4 __attribute__((ext_vector_type(4)));

constexpr int DM = 1024, NBATCH = 4, SEQ = 4096, CTXL = 256, DEPTH = 4;
constexpr int LAT_ROWS = NBATCH * SEQ;
constexpr int CTX_ROWS = NBATCH * CTXL;
constexpr int TOK = LAT_ROWS + CTX_ROWS;
constexpr int SKV = CTXL + SEQ;
constexpr int NMOD = 6 * DM;
constexpr float RMS_EPS = 1e-6f;
constexpr int NEXP = 32, MOE_FF = 512;
constexpr int LIST_CAP = TOK;

__device__ __forceinline__ unsigned f2bf(float f) { unsigned u = __builtin_bit_cast(unsigned, f); return (u + 0x7fffu + ((u >> 16) & 1u)) >> 16; }
__device__ __forceinline__ unsigned pk2(float lo, float hi) { return f2bf(lo) | (f2bf(hi) << 16); }
__device__ __forceinline__ float bf2f(unsigned short b) { return __builtin_bit_cast(float, ((unsigned)b) << 16); }
__device__ __forceinline__ float bflo(unsigned w) { return __builtin_bit_cast(float, w << 16); }
__device__ __forceinline__ float bfhi(unsigned w) { return __builtin_bit_cast(float, w & 0xffff0000u); }
__device__ __forceinline__ unsigned cvtpk(float lo, float hi) { unsigned r; asm volatile("v_cvt_pk_bf16_f32 %0, %1, %2" : "=v"(r) : "v"(lo), "v"(hi)); return r; }
#define DPP_F(v, ctrl) __builtin_bit_cast(float, __builtin_amdgcn_update_dpp(0, __builtin_bit_cast(int, v), ctrl, 0xf, 0xf, true))
__device__ __forceinline__ float wave_sum(float v) {
    v += DPP_F(v, 0xB1);
    v += DPP_F(v, 0x4E);
    v += DPP_F(v, 0x141);
    v += DPP_F(v, 0x140);
    const int vi = __builtin_bit_cast(int, v);
    return (__builtin_bit_cast(float, __builtin_amdgcn_readlane(vi, 0)) + __builtin_bit_cast(float, __builtin_amdgcn_readlane(vi, 16)))
         + (__builtin_bit_cast(float, __builtin_amdgcn_readlane(vi, 32)) + __builtin_bit_cast(float, __builtin_amdgcn_readlane(vi, 48)));
}
__device__ __forceinline__ float wave_max(float v) {
    v = fmaxf(v, DPP_F(v, 0xB1)); v = fmaxf(v, DPP_F(v, 0x4E)); v = fmaxf(v, DPP_F(v, 0x141)); v = fmaxf(v, DPP_F(v, 0x140));
    const int vi = __builtin_bit_cast(int, v);
    return fmaxf(fmaxf(__builtin_bit_cast(float, __builtin_amdgcn_readlane(vi, 0)), __builtin_bit_cast(float, __builtin_amdgcn_readlane(vi, 16))),
                 fmaxf(__builtin_bit_cast(float, __builtin_amdgcn_readlane(vi, 32)), __builtin_bit_cast(float, __builtin_amdgcn_readlane(vi, 48))));
}
__device__ __forceinline__ float sigmoidf_(float x) { return 1.f / (1.f + __expf(-x)); }
__device__ __forceinline__ float siluf_(float x) { return x * sigmoidf_(x); }
__device__ __forceinline__ float gelu_tanh(float x) {
    const float u = 0.7978845608028654f * (x + 0.044715f * x * x * x);
    const float e = __expf(2.f * u);
    const float t = 1.f - 2.f / (e + 1.f);
    return 0.5f * x * (1.f + t);
}
__device__ __forceinline__ int modrow_of(int row) { return row < LAT_ROWS ? (row >> 12) : 4; }

constexpr size_t MiB = 1u << 20;
constexpr size_t WS_CTL = 0, CTL_ZERO_BYTES = 1 * MiB;
constexpr size_t WS_MOD = 1 * MiB, WS_ROPE = 2 * MiB, WS_GATEW = 3 * MiB, WS_RW = 4 * MiB, WS_RC = 5 * MiB, WS_LIST = 9 * MiB;
constexpr size_t WS_W_IN = 12 * MiB, WS_W_OUTE = 16 * MiB, WS_W_GLU = 20 * MiB, WS_W_MLA = 21 * MiB, WS_W_QKV = 23 * MiB, WS_W_OUTO = 31 * MiB;
constexpr size_t WS_W_GU = 35 * MiB, WS_W_DN = 291 * MiB;
constexpr size_t WS_XRES = 419 * MiB, WS_H = 487 * MiB, WS_MIX = 521 * MiB;
constexpr size_t WS_ZRAW = 555 * MiB, WS_ACAT = 623 * MiB, WS_QKVM = 640 * MiB, WS_QB = 700 * MiB, WS_KB = 734 * MiB, WS_VB = 768 * MiB, WS_GG = 785 * MiB;
constexpr size_t WS_ACT = 555 * MiB, WS_YDN = 589 * MiB;
constexpr size_t WS_E2 = 802 * MiB;
constexpr size_t WS_S5TAB = 812 * MiB;
constexpr size_t WS_END = 814 * MiB;
constexpr int CW_BAR = 4096, CW_CNT = 16384;
constexpr int CW_READY = 65536, READY_L = 32 * 68 * 16;
constexpr int ROPE32_OFF = 64 * 32 * 2;
constexpr size_t WS_RT = WS_ROPE + 128 * 1024;

constexpr int RING_BYTES = 131072, LDS_BYTES = 152576, MISC_OFF = LDS_BYTES - 3072;


namespace pg8 {
constexpr int BM = 256, BK = 64, HALF = 128, HTB = HALF * BK * 2, STAGE_BYTES = 8 * HTB, NXCD = 8, WGM = 8;
__host__ __device__ __forceinline__ int lds_byte(int r, int c) { const int st = (r >> 4) * 2 + (c >> 5), rr = r & 15, cc = c & 31, ob = rr * 64 + cc * 2; return st * 1024 + (ob ^ (((ob >> 9) & 1) << 5)); }
__host__ __device__ __forceinline__ void stage_rc(int b, int& R, int& C) { const int st = b / 1024, sb = b % 1024, swz = sb ^ (((sb >> 9) & 1) << 5); R = (st >> 1) * 16 + swz / 64; C = (st & 1) * 32 + (swz % 64) / 2; }
__host__ __device__ __forceinline__ int perm32(int rho) { const int n = rho >> 4, i = rho & 15; return 8 * (i >> 2) + 4 * n + (i & 3); }

struct Unit { int pm, pn, e, rows; };

enum { EPI_BF16 = 0, EPI_GLU = 1, EPI_RESID = 2, EPI_MOE1 = 3, EPI_MOE2 = 4 };
enum { G_INPROJ = 0, G_MLA = 1, G_GLU = 2, G_OUT = 3, G_QKV = 4, G_MOE1 = 5, G_MOE2 = 6 };

template <int GID> struct Cfg;
template <> struct Cfg<G_INPROJ> { static constexpr int lda = 1024, ldb = 1024, K = 1024, nN = 4, moe = 0, epi = EPI_BF16, ldo = 1024, acol_split = 1 << 30, acol_off = 0; };
template <> struct Cfg<G_MLA>    { static constexpr int lda = 512,  ldb = 256,  K = 256,  nN = 7, moe = 0, epi = EPI_BF16, ldo = 1792, acol_split = 3, acol_off = 256; };
template <> struct Cfg<G_GLU>    { static constexpr int lda = 512,  ldb = 512,  K = 512,  nN = 2, moe = 0, epi = EPI_GLU,  ldo = 1024, acol_split = 1 << 30, acol_off = 0; };
template <> struct Cfg<G_OUT>    { static constexpr int lda = 1024, ldb = 1024, K = 1024, nN = 4, moe = 0, epi = EPI_RESID, ldo = 1024, acol_split = 1 << 30, acol_off = 0; };
template <> struct Cfg<G_QKV>    { static constexpr int lda = 1024, ldb = 1024, K = 1024, nN = 8, moe = 0, epi = EPI_BF16, ldo = 2048, acol_split = 1 << 30, acol_off = 0; };
template <> struct Cfg<G_MOE1>   { static constexpr int lda = 1024, ldb = 1024, K = 1024, nN = 4, moe = 1, epi = EPI_MOE1, ldo = 512, acol_split = 1 << 30, acol_off = 0; };
template <> struct Cfg<G_MOE2>   { static constexpr int lda = 512,  ldb = 512,  K = 512,  nN = 4, moe = 2, epi = EPI_MOE2, ldo = 1024, acol_split = 1 << 30, acol_off = 0; };

template <int GID> struct Prob {
    static constexpr int lda = Cfg<GID>::lda, ldb = Cfg<GID>::ldb, K = Cfg<GID>::K, nN = Cfg<GID>::nN, moe = Cfg<GID>::moe, epi = Cfg<GID>::epi, ldo = Cfg<GID>::ldo;
    static constexpr int acol_split = Cfg<GID>::acol_split, acol_off = Cfg<GID>::acol_off, nM = TOK / 256;
    static constexpr size_t bstride = (size_t)1024 * K * 2;
    const char* A; const char* B;
    int G, c;
    const int* list; const unsigned* cnt; const LAS int* tp;
    int l; unsigned char* ws;
    bf16* O;
    unsigned* ready;
    const float* xlat; const float* xctx;

    __device__ __forceinline__ bool next(int i, Unit& u) const {
        const long L = (long)i * G + c;
        if constexpr (moe == 0) {
            const int nMe = (GID == G_INPROJ || GID == G_OUT || GID == G_QKV) ? LAT_ROWS / 256 : nM;
            const int nwg = nMe * nN; if (L >= nwg) return false;
            int wgid = (int)L; { const int q = nwg / NXCD, r = nwg % NXCD, xcd = wgid % NXCD, off = wgid / NXCD; wgid = (xcd < r ? xcd * (q + 1) : r * (q + 1) + (xcd - r) * q) + off; }
            const int nig = WGM * nN, gid = wgid / nig, fm = gid * WGM, gsz = (nMe - fm) < WGM ? (nMe - fm) : WGM;
            u.pm = fm + ((wgid % nig) % gsz); u.pn = (wgid % nig) / gsz; u.e = 0; u.rows = 256; return true;
        } else {
            const int x = c & 7, per = G >> 3, j = (moe == 2) ? per - 1 - (c >> 3) : (c >> 3);
            int uidx = i * per + j;
#pragma unroll
            for (int k = 0; k < NEXP / 8; ++k) { const int e = x + 8 * k; const int nt_e = tp[e + 1] - tp[e]; const int nu = nt_e * nN;
                if (uidx < nu) { u.e = e; u.pm = uidx / nN; u.pn = uidx % nN; const int left = (int)cnt[e] - 256 * u.pm; u.rows = left < 256 ? left : 256; return true; }
                uidx -= nu; }
            return false;
        }
    }
    __device__ __forceinline__ void done(const Unit& u, const int tid) const {
        if constexpr (moe == 1) { asm volatile("s_waitcnt vmcnt(0)" ::: "memory");
            if ((tid & 63) == 0) __hip_atomic_fetch_add(ready + (u.e * 68 + u.pm) * 16, 1u, __ATOMIC_RELAXED, __HIP_MEMORY_SCOPE_AGENT); }
    }
    __device__ __forceinline__ void a_ready(const Unit& u, const int tid) const {
        if constexpr (moe == 2) {
            if (tid < 64) {
                const unsigned* w = ready + (u.e * 68 + u.pm) * 16;
                for (unsigned n = 0; n < 2000000u; ++n) {
                    if ((unsigned)__builtin_amdgcn_readfirstlane(__hip_atomic_load(w, __ATOMIC_RELAXED, __HIP_MEMORY_SCOPE_AGENT)) >= 32u) break;
                    __builtin_amdgcn_s_sleep(2); }
            }
            asm volatile("" ::: "memory"); __builtin_amdgcn_s_barrier(); asm volatile("" ::: "memory");
        }
    }
    __device__ __forceinline__ const char* abase(const Unit& u) const {
        if constexpr (moe == 0) return A + ((size_t)u.pm * 256 * lda + (u.pn >= acol_split ? acol_off : 0)) * 2;
        else return A;
    }
    __device__ __forceinline__ unsigned aoff(const Unit& u, int R, int C) const {
        if constexpr (moe == 0) return (unsigned)((R * lda + C) * 2);
        else {
        const int rr = R < u.rows ? R : 0;
        const int ent = list[(size_t)u.e * LIST_CAP + u.pm * 256 + rr];
        const int arow = (moe == 1) ? (ent >> 1) : ent;
        return (unsigned)(((size_t)arow * lda + C) * 2u); }
    }
    __device__ __forceinline__ const char* bbase(const Unit& u) const { return B + (size_t)u.e * bstride + (size_t)u.pn * 256 * ldb * 2; }

    __device__ __forceinline__ void epilogue(const f32x4 (&acc)[2][2][4][2], const Unit& u, int wr, int wc, int fr, int fq) const {
        const int cw = wc * 32 + 8 * fq;
        if constexpr (epi == EPI_BF16) {
#pragma unroll
            for (int ai = 0; ai < 2; ++ai)
#pragma unroll
                for (int m = 0; m < 4; ++m) { const int row = u.pm * 256 + ai * 128 + wr * 64 + m * 16 + fr; bf16* rowp = O + (size_t)row * ldo + u.pn * 256 + cw;
#pragma unroll
                    for (int bj = 0; bj < 2; ++bj) { const f32x4 v0 = acc[ai][bj][m][0], v1 = acc[ai][bj][m][1];
                        u32x4 w; w.x = cvtpk(v0[0], v0[1]); w.y = cvtpk(v0[2], v0[3]); w.z = cvtpk(v1[0], v1[1]); w.w = cvtpk(v1[2], v1[3]);
                        *(u32x4*)(rowp + bj * 128) = w; } }
        } else if constexpr (epi == EPI_GLU) {
#pragma unroll
            for (int ai = 0; ai < 2; ++ai)
#pragma unroll
                for (int m = 0; m < 4; ++m) { const int row = u.pm * 256 + ai * 128 + wr * 64 + m * 16 + fr;
#pragma unroll
                    for (int bj = 0; bj < 2; ++bj) { const int col = u.pn * 256 + bj * 128 + cw;
                        const u32x4 gv = *(const u32x4*)((const bf16*)(ws + WS_GG) + (size_t)row * 512 + col);
                        const f32x4 v0 = acc[ai][bj][m][0], v1 = acc[ai][bj][m][1];
                        u32x4 w;
                        w.x = cvtpk(bflo(gv.x) * sigmoidf_(v0[0]), bfhi(gv.x) * sigmoidf_(v0[1]));
                        w.y = cvtpk(bflo(gv.y) * sigmoidf_(v0[2]), bfhi(gv.y) * sigmoidf_(v0[3]));
                        w.z = cvtpk(bflo(gv.z) * sigmoidf_(v1[0]), bfhi(gv.z) * sigmoidf_(v1[1]));
                        w.w = cvtpk(bflo(gv.w) * sigmoidf_(v1[2]), bfhi(gv.w) * sigmoidf_(v1[3]));
                        *(u32x4*)((bf16*)(ws + WS_MIX) + (size_t)row * 1024 + col) = w; } }
        } else if constexpr (epi == EPI_RESID) {
            const float* gate = (const float*)(ws + WS_MOD) + (size_t)l * 5 * NMOD + 2 * DM; bf16* xout = (bf16*)(ws + WS_XRES);
#pragma unroll
            for (int ai = 0; ai < 2; ++ai)
#pragma unroll
                for (int m = 0; m < 4; ++m) { const int row = u.pm * 256 + ai * 128 + wr * 64 + m * 16 + fr;
                    const float* gr = gate + (size_t)modrow_of(row) * NMOD;
#pragma unroll
                    for (int bj = 0; bj < 2; ++bj) { const int col = u.pn * 256 + bj * 128 + cw;
                        float xv[8];
                        if (l == 0) { const float* xs = row < LAT_ROWS ? xlat + (size_t)row * DM : xctx + (size_t)(row - LAT_ROWS) * DM;
                            const f32x4 a0 = *(const f32x4*)(xs + col), a1 = *(const f32x4*)(xs + col + 4);
                            xv[0] = a0[0]; xv[1] = a0[1]; xv[2] = a0[2]; xv[3] = a0[3]; xv[4] = a1[0]; xv[5] = a1[1]; xv[6] = a1[2]; xv[7] = a1[3]; }
                        else { const u32x4 w = *(const u32x4*)(xout + (size_t)row * DM + col);
                            xv[0] = bflo(w.x); xv[1] = bfhi(w.x); xv[2] = bflo(w.y); xv[3] = bfhi(w.y); xv[4] = bflo(w.z); xv[5] = bfhi(w.z); xv[6] = bflo(w.w); xv[7] = bfhi(w.w); }
                        const f32x4 g0 = *(const f32x4*)(gr + col), g1 = *(const f32x4*)(gr + col + 4);
                        const f32x4 c0 = acc[ai][bj][m][0], c1 = acc[ai][bj][m][1];
#ifdef DBG_NOMIX
                        u32x4 o; o.x = cvtpk(xv[0], xv[1]); o.y = cvtpk(xv[2], xv[3]); o.z = cvtpk(xv[4], xv[5]); o.w = cvtpk(xv[6], xv[7]);
#else
                        u32x4 o; o.x = cvtpk(xv[0] + g0[0] * c0[0], xv[1] + g0[1] * c0[1]); o.y = cvtpk(xv[2] + g0[2] * c0[2], xv[3] + g0[3] * c0[3]);
                        o.z = cvtpk(xv[4] + g1[0] * c1[0], xv[5] + g1[1] * c1[1]); o.w = cvtpk(xv[6] + g1[2] * c1[2], xv[7] + g1[3] * c1[3]);
#endif
                        *(u32x4*)(xout + (size_t)row * DM + col) = o; } }
        } else if constexpr (epi == EPI_MOE1) {
#pragma unroll
            for (int ai = 0; ai < 2; ++ai)
#pragma unroll
                for (int m = 0; m < 4; ++m) { const int rt = ai * 128 + wr * 64 + m * 16 + fr;
                    if (rt < u.rows) { const int ent = list[(size_t)u.e * LIST_CAP + u.pm * 256 + rt];
                        const f32x4 g0 = acc[ai][0][m][0], g1 = acc[ai][0][m][1], u0 = acc[ai][1][m][0], u1 = acc[ai][1][m][1];
                        u32x4 w;
                        w.x = cvtpk(siluf_(g0[0]) * u0[0], siluf_(g0[1]) * u0[1]); w.y = cvtpk(siluf_(g0[2]) * u0[2], siluf_(g0[3]) * u0[3]);
                        w.z = cvtpk(siluf_(g1[0]) * u1[0], siluf_(g1[1]) * u1[1]); w.w = cvtpk(siluf_(g1[2]) * u1[2], siluf_(g1[3]) * u1[3]);
                        asm volatile("global_store_dwordx4 %0, %1, off sc1\n\ts_nop 1" :: "v"((bf16*)(ws + WS_ACT) + (size_t)ent * MOE_FF + u.pn * 128 + cw), "v"(w) : "memory"); } }
        } else {
            const float* gatew = (const float*)(ws + WS_GATEW);
#pragma unroll
            for (int ai = 0; ai < 2; ++ai)
#pragma unroll
                for (int m = 0; m < 4; ++m) { const int rt = ai * 128 + wr * 64 + m * 16 + fr;
                    if (rt < u.rows) { const int ent = list[(size_t)u.e * LIST_CAP + u.pm * 256 + rt]; const float gw = gatew[ent];
#pragma unroll
                        for (int bj = 0; bj < 2; ++bj) { const f32x4 v0 = acc[ai][bj][m][0] * gw, v1 = acc[ai][bj][m][1] * gw;
                            u32x4 w; w.x = cvtpk(v0[0], v0[1]); w.y = cvtpk(v0[2], v0[3]); w.z = cvtpk(v1[0], v1[1]); w.w = cvtpk(v1[2], v1[3]);
                            *(u32x4*)((bf16*)(ws + WS_YDN) + (size_t)ent * DM + u.pn * 256 + bj * 128 + cw) = w; } } }
        }
    }
};

template <int GID>
__device__ __forceinline__ void gemm_phase(LAS unsigned char* lds, const Prob<GID>& P, const int tid) {
    const int  wid = __builtin_amdgcn_readfirstlane(tid >> 6), lane = tid & 63, wr = wid >> 2, wc = wid & 3, fr = lane & 15, fq = lane >> 4;
    constexpr int K = Prob<GID>::K, nt = K / BK;
    unsigned voffB[2];
#pragma unroll
    for (int i = 0; i < 2; ++i) { int R, C; stage_rc(tid * 16 + i * 8192, R, C); const int Rb = (R & ~31) + perm32(R & 31);
        voffB[i] = (unsigned)(Rb * P.ldb + C) * 2u; }
#define PG8_AOFFS(vo, unit) do { _Pragma("unroll") for (int _h = 0; _h < 2; ++_h) _Pragma("unroll") for (int _i = 0; _i < 2; ++_i) { int _R, _C; stage_rc(tid * 16 + _i * 8192, _R, _C); \
        (vo)[_h][_i] = P.aoff(unit, _R + 128 * _h, _C); } } while (0)
    const size_t kstep = (size_t)(BK * 2);
    const size_t hstepB = (size_t)HALF * P.ldb * 2;
    const unsigned ldsw = (unsigned)wid * 1024u;
    const int aoff = lds_byte(wr * 64 + fr, fq * 8), boff = lds_byte(wc * 32 + fr, fq * 8);
#define PG8_SA(b, h) (((b) * 2 + (h)) * HTB)
#define PG8_SB(b, h) ((4 + (b) * 2 + (h)) * HTB)
#define PG8_STAGEB(bufoff, gbase) do { _Pragma("unroll") for (int _i = 0; _i < 2; ++_i) \
        __builtin_amdgcn_global_load_lds((const unsigned*)((const char*)(gbase) + voffB[_i]), (LAS unsigned*)(lds + (bufoff) + ldsw + _i * 8192), 16, 0, 0); } while (0)
#define PG8_STAGEA(bufoff, gbase, h) do { _Pragma("unroll") for (int _i = 0; _i < 2; ++_i) \
        __builtin_amdgcn_global_load_lds((const unsigned*)((const char*)(gbase) + vA[h][_i]), (LAS unsigned*)(lds + (bufoff) + ldsw + _i * 8192), 16, 0, Prob<GID>::moe == 2 ? 16 : 0); } while (0)
#define PG8_LDA(dst, b, h) do { _Pragma("unroll") for (int m = 0; m < 4; ++m) _Pragma("unroll") for (int k = 0; k < 2; ++k) dst[m][k] = *(const LAS bf16x8*)(lds + PG8_SA(b, h) + aoff + m * 2048 + k * 1024); } while (0)
#define PG8_LDB(dst, b, h) do { _Pragma("unroll") for (int n = 0; n < 2; ++n) _Pragma("unroll") for (int k = 0; k < 2; ++k) dst[n][k] = *(const LAS bf16x8*)(lds + PG8_SB(b, h) + boff + n * 2048 + k * 1024); } while (0)
#define PG8_MMA(ai, bj, At, Bt) do { __builtin_amdgcn_s_setprio(1); _Pragma("unroll") for (int m = 0; m < 4; ++m) _Pragma("unroll") for (int n = 0; n < 2; ++n) _Pragma("unroll") for (int k = 0; k < 2; ++k) \
        acc[ai][bj][m][n] = __builtin_amdgcn_mfma_f32_16x16x32_bf16(Bt[n][k], At[m][k], acc[ai][bj][m][n], 0, 0, 0); __builtin_amdgcn_s_setprio(0); } while (0)
#define PG8_WAIT_V(n) asm volatile("s_waitcnt vmcnt(" #n ")" ::: "memory")
#define PG8_WAIT_L(n) asm volatile("s_waitcnt lgkmcnt(" #n ")" ::: "memory")
#define PG8_BAR __builtin_amdgcn_s_barrier()
#define PG8_SCHED __builtin_amdgcn_sched_barrier(0)
    Unit cur, nxt; int ui = 0;
    if (!P.next(0, cur)) return;
    f32x4 acc[2][2][4][2];
#pragma unroll
    for (int a = 0; a < 2; ++a)
#pragma unroll
        for (int b = 0; b < 2; ++b)
#pragma unroll
            for (int m = 0; m < 4; ++m)
#pragma unroll
                for (int n = 0; n < 2; ++n) acc[a][b][m][n] = (f32x4){0.f, 0.f, 0.f, 0.f};
    bf16x8 At[4][2], B0[2][2], B1[2][2];
    unsigned vA[2][2];
    PG8_AOFFS(vA, cur);
    const char* cA = P.abase(cur); const char* cB = P.bbase(cur);
    P.a_ready(cur, tid);
    PG8_STAGEB(PG8_SB(0, 0), cB); PG8_STAGEB(PG8_SB(0, 1), cB + hstepB); PG8_STAGEA(PG8_SA(0, 0), cA, 0); PG8_STAGEA(PG8_SA(0, 1), cA, 1);
    if (wr == 1) PG8_BAR;
    PG8_WAIT_V(2); PG8_BAR;
    PG8_STAGEB(PG8_SB(1, 0), cB + kstep); PG8_STAGEA(PG8_SA(1, 0), cA + kstep, 0); PG8_STAGEB(PG8_SB(1, 1), cB + hstepB + kstep);
    PG8_WAIT_V(6); PG8_BAR;
    for (;;) {
        const bool has_next = P.next(ui + 1, nxt);
        const char* nA = has_next ? P.abase(nxt) : cA; const char* nB = has_next ? P.bbase(nxt) : cB;
#pragma nounroll
        for (int t = 0; t < nt; t += 2) {
            const bool last = (t == nt - 2);
            const char* a1 = cA + (size_t)(t + 1) * kstep;
            const char* a2 = last ? nA : cA + (size_t)(t + 2) * kstep; const char* b2 = last ? nB : cB + (size_t)(t + 2) * kstep;
            const char* a3 = a2 + kstep; const char* b3 = b2 + kstep;
            if (Prob<GID>::moe == 2 && last && has_next) P.a_ready(nxt, tid);
            PG8_LDB(B0, 0, 0); PG8_LDB(B1, 0, 1); PG8_SCHED; PG8_LDA(At, 0, 0); PG8_STAGEA(PG8_SA(1, 1), a1, 1);
            if (Prob<GID>::moe != 0 && last && has_next) { PG8_AOFFS(vA, nxt); }
            PG8_WAIT_V(8); PG8_WAIT_L(0); PG8_BAR; PG8_MMA(0, 0, At, B0); PG8_MMA(0, 1, At, B1); PG8_BAR; PG8_SCHED;
            PG8_LDA(At, 0, 1); PG8_STAGEB(PG8_SB(0, 0), b2); PG8_STAGEB(PG8_SB(0, 1), b2 + hstepB); PG8_STAGEA(PG8_SA(0, 0), a2, 0);
            PG8_WAIT_V(8); PG8_WAIT_L(0); PG8_BAR; PG8_MMA(1, 0, At, B0); PG8_MMA(1, 1, At, B1); PG8_BAR; PG8_SCHED;
            PG8_LDB(B0, 1, 0); PG8_LDB(B1, 1, 1); PG8_SCHED; PG8_LDA(At, 1, 0); PG8_STAGEA(PG8_SA(0, 1), a2, 1);
            PG8_WAIT_V(8); PG8_WAIT_L(0); PG8_BAR; PG8_MMA(0, 0, At, B0); PG8_MMA(0, 1, At, B1); PG8_BAR; PG8_SCHED;
            PG8_LDA(At, 1, 1); PG8_STAGEB(PG8_SB(1, 0), b3); PG8_STAGEB(PG8_SB(1, 1), b3 + hstepB); PG8_STAGEA(PG8_SA(1, 0), a3, 0);
            PG8_WAIT_V(8); PG8_WAIT_L(0); PG8_BAR; PG8_MMA(1, 0, At, B0); PG8_MMA(1, 1, At, B1); PG8_BAR; PG8_SCHED;
        }
        if (wr == 0) PG8_BAR;
        P.epilogue(acc, cur, wr, wc, fr, fq);
        P.done(cur, tid);
        if (!has_next) break;
#pragma unroll
        for (int a = 0; a < 2; ++a)
#pragma unroll
            for (int b = 0; b < 2; ++b)
#pragma unroll
                for (int m = 0; m < 4; ++m)
#pragma unroll
                    for (int n = 0; n < 2; ++n) acc[a][b][m][n] = (f32x4){0.f, 0.f, 0.f, 0.f};
        cur = nxt; cA = nA; cB = nB; ++ui;
        if (wr == 1) PG8_BAR;
    }
    PG8_WAIT_V(0);
    PG8_BAR;
#undef PG8_SA
#undef PG8_SB
#undef PG8_STAGEA
#undef PG8_AOFFS
#undef PG8_STAGEB
#undef PG8_LDA
#undef PG8_LDB
#undef PG8_MMA
#undef PG8_WAIT_V
#undef PG8_WAIT_L
#undef PG8_BAR
#undef PG8_SCHED
}

template <int GID>
__device__ __forceinline__ void ctx_gemm(LAS unsigned char* lds, const Prob<GID>& P, const int tid) {
    static_assert(Prob<GID>::K == 1024 && Prob<GID>::lda == 1024 && Prob<GID>::ldb == 1024 && Prob<GID>::moe == 0, "ctx_gemm: K = 1024 dense only");
    constexpr int NPASS = Prob<GID>::nN / 4, PSTR = 272, PW = 64 * PSTR, epi = Prob<GID>::epi, ldo = Prob<GID>::ldo;
    const int wid = __builtin_amdgcn_readfirstlane(tid >> 6), lane = tid & 63, fr = lane & 15, fq = lane >> 4;
    const int mt = P.c >> 4;
    const char* Ap = P.A + ((size_t)(LAT_ROWS + mt * 64 + fr) * 1024 + wid * 128 + fq * 8) * 2;
    bf16x8 af[4][4], bf[4][4];
    { const char* Bp0 = P.B + ((size_t)((P.c & 15) * 64 + fr) * 1024 + wid * 128 + fq * 8) * 2;
#pragma unroll
      for (int ks = 0; ks < 4; ++ks)
#pragma unroll
          for (int mi = 0; mi < 4; ++mi) { af[ks][mi] = *(const bf16x8*)(Ap + mi * 16 * 2048 + ks * 64); bf[ks][mi] = *(const bf16x8*)(Bp0 + mi * 16 * 2048 + ks * 64); } }
#pragma nounroll
    for (int pass = 0; pass < NPASS; ++pass) {
        const int ntile = (P.c & 15) + 16 * pass;
        f32x4 acc[4][4];
#pragma unroll
        for (int mi = 0; mi < 4; ++mi)
#pragma unroll
            for (int ni = 0; ni < 4; ++ni) acc[mi][ni] = (f32x4){0.f, 0.f, 0.f, 0.f};
        __builtin_amdgcn_sched_barrier(0);
#pragma unroll
        for (int ks = 0; ks < 4; ++ks)
#pragma unroll
            for (int mi = 0; mi < 4; ++mi)
#pragma unroll
                for (int ni = 0; ni < 4; ++ni) acc[mi][ni] = __builtin_amdgcn_mfma_f32_16x16x32_bf16(bf[ks][ni], af[ks][mi], acc[mi][ni], 0, 0, 0);
        __builtin_amdgcn_sched_barrier(0);
        if (pass + 1 < NPASS) { const char* Bp1 = P.B + ((size_t)((ntile + 16) * 64 + fr) * 1024 + wid * 128 + fq * 8) * 2;
#pragma unroll
            for (int ks = 0; ks < 4; ++ks)
#pragma unroll
                for (int mi = 0; mi < 4; ++mi) bf[ks][mi] = *(const bf16x8*)(Bp1 + mi * 16 * 2048 + ks * 64);
            __builtin_amdgcn_sched_barrier(0); }
        __syncthreads();
#pragma unroll
        for (int mi = 0; mi < 4; ++mi)
#pragma unroll
            for (int ni = 0; ni < 4; ++ni) *(LAS f32x4*)(lds + wid * PW + (mi * 16 + fr) * PSTR + (ni * 16 + 4 * fq) * 4) = acc[mi][ni];
        __syncthreads();
        const int m = tid >> 3, c8 = (tid & 7) * 8;
        f32x4 s0 = (f32x4){0.f, 0.f, 0.f, 0.f}, s1 = s0;
#pragma unroll
        for (int w = 0; w < 8; ++w) { s0 += *(const LAS f32x4*)(lds + w * PW + m * PSTR + c8 * 4); s1 += *(const LAS f32x4*)(lds + w * PW + m * PSTR + c8 * 4 + 16); }
        const int row = LAT_ROWS + mt * 64 + m, col = ntile * 64 + c8;
        if constexpr (epi == EPI_BF16) {
            u32x4 w; w.x = cvtpk(s0[0], s0[1]); w.y = cvtpk(s0[2], s0[3]); w.z = cvtpk(s1[0], s1[1]); w.w = cvtpk(s1[2], s1[3]);
            *(u32x4*)(P.O + (size_t)row * ldo + col) = w;
        } else {
            static_assert(epi == EPI_RESID, "ctx_gemm: epilogue");
            const float* gr = (const float*)(P.ws + WS_MOD) + (size_t)P.l * 5 * NMOD + 2 * DM + (size_t)modrow_of(row) * NMOD; bf16* xout = (bf16*)(P.ws + WS_XRES);
            float xv[8];
            if (P.l == 0) { const float* xs = P.xctx + (size_t)(row - LAT_ROWS) * DM;
                const f32x4 a0 = *(const f32x4*)(xs + col), a1 = *(const f32x4*)(xs + col + 4);
                xv[0] = a0[0]; xv[1] = a0[1]; xv[2] = a0[2]; xv[3] = a0[3]; xv[4] = a1[0]; xv[5] = a1[1]; xv[6] = a1[2]; xv[7] = a1[3]; }
            else { const u32x4 w = *(const u32x4*)(xout + (size_t)row * DM + col);
                xv[0] = bflo(w.x); xv[1] = bfhi(w.x); xv[2] = bflo(w.y); xv[3] = bfhi(w.y); xv[4] = bflo(w.z); xv[5] = bfhi(w.z); xv[6] = bflo(w.w); xv[7] = bfhi(w.w); }
            const f32x4 g0 = *(const f32x4*)(gr + col), g1 = *(const f32x4*)(gr + col + 4);
            u32x4 o; o.x = cvtpk(xv[0] + g0[0] * s0[0], xv[1] + g0[1] * s0[1]); o.y = cvtpk(xv[2] + g0[2] * s0[2], xv[3] + g0[3] * s0[3]);
            o.z = cvtpk(xv[4] + g1[0] * s1[0], xv[5] + g1[1] * s1[1]); o.w = cvtpk(xv[6] + g1[2] * s1[2], xv[7] + g1[3] * s1[3]);
            *(u32x4*)(xout + (size_t)row * DM + col) = o;
        }
    }
}
}
namespace att {
constexpr int D = 128, NW = 8, QBLK = 32, KVBLK = 64;
constexpr float THR = 8.f;
constexpr int SHM_V = KVBLK * 128 * 2, SHM_K = KVBLK * D * 2, SHM_ATTN = 2 * SHM_V + 2 * SHM_K + NW * 64 * 4;
#define KSWZ(row, colB) ((row) * 256 + ((colB) ^ (((row) & 7) << 4)))
#define SBAR() __builtin_amdgcn_sched_barrier(0)
__device__ __forceinline__ int crow(int r, int hi) { return (r & 3) + 8 * (r >> 2) + 4 * hi; }

template <int SC> struct ScaleOf { static constexpr float v = SC == 0 ? 0.088388347648318440f   : 0.102062072615965750f  ; };

template <int SC>
__device__ __forceinline__ void partialSM(f32x16& p0, f32x16& p1, float& m_reg, float& mn, float& alpha) {
  constexpr float SCALE = ScaleOf<SC>::v;
  constexpr float C = SCALE * 1.4426950408889634f;
  float pmax = p0[0];
#pragma unroll
  for (int r = 1; r < 16; ++r) pmax = fmaxf(pmax, p0[r]);
#pragma unroll
  for (int r = 0; r < 16; ++r) pmax = fmaxf(pmax, p1[r]);
  { auto rr = __builtin_amdgcn_permlane32_swap(__float_as_uint(pmax), __float_as_uint(pmax), false, false);
    pmax = fmaxf(__uint_as_float(rr[0]), __uint_as_float(rr[1])); }
  if (__builtin_expect(__all(pmax - m_reg <= THR / SCALE), 1)) { mn = m_reg; alpha = 1.f; }
  else { mn = fmaxf(m_reg, pmax); alpha = __builtin_amdgcn_exp2f((m_reg - mn) * C); m_reg = mn; }
  float mnC = -mn * C;
#pragma unroll
  for (int r = 0; r < 16; ++r) p0[r] = fmaf(p0[r], C, mnC);
#pragma unroll
  for (int r = 0; r < 16; ++r) p1[r] = fmaf(p1[r], C, mnC);
#pragma unroll
  for (int r = 0; r < 16; ++r) p0[r] = __builtin_amdgcn_exp2f(p0[r]);
}
__device__ __forceinline__ void finishSM(f32x16& p0, f32x16& p1, float alpha, float& l_reg, bf16x8& pa0, bf16x8& pa1, bf16x8& pa2, bf16x8& pa3) {
#pragma unroll
  for (int r = 0; r < 16; ++r) p1[r] = __builtin_amdgcn_exp2f(p1[r]);
  float ps = 0;
#pragma unroll
  for (int r = 0; r < 16; ++r) ps += p0[r];
#pragma unroll
  for (int r = 0; r < 16; ++r) ps += p1[r];
  { auto rr = __builtin_amdgcn_permlane32_swap(__float_as_uint(ps), __float_as_uint(ps), false, false);
    ps = __uint_as_float(rr[0]) + __uint_as_float(rr[1]); }
  l_reg = l_reg * alpha + ps;
#define PK4(P, BASE, OUT) do { unsigned a0 = cvtpk(P[BASE + 0], P[BASE + 1]), a1 = cvtpk(P[BASE + 2], P[BASE + 3]);   \
    unsigned b0 = cvtpk(P[BASE + 4], P[BASE + 5]), b1 = cvtpk(P[BASE + 6], P[BASE + 7]);                              \
    auto r0 = __builtin_amdgcn_permlane32_swap(a0, b0, false, false); auto r1 = __builtin_amdgcn_permlane32_swap(a1, b1, false, false); \
    u32x4 w = {r0[0], r1[0], r0[1], r1[1]}; OUT = *reinterpret_cast<bf16x8*>(&w); } while (0)
  PK4(p0, 0, pa0); PK4(p0, 8, pa1); PK4(p1, 0, pa2); PK4(p1, 8, pa3);
#undef PK4
}
template <int NKS>
__device__ __forceinline__ void qkt(f32x16& p0, f32x16& p1, const bf16* Ks, const bf16x8* qr, int r32, int hi) {
  p0 = f32x16{}; p1 = f32x16{};
#pragma unroll
  for (int d0 = 0; d0 < NKS; ++d0) { int cb = (d0 * 16 + hi * 8) * 2;
    bf16x8 b0 = *reinterpret_cast<const bf16x8*>((const char*)Ks + KSWZ(r32, cb));
    bf16x8 b1 = *reinterpret_cast<const bf16x8*>((const char*)Ks + KSWZ(32 + r32, cb));
    p0 = __builtin_amdgcn_mfma_f32_32x32x16_bf16(b0, qr[d0], p0, 0, 0, 0);
    p1 = __builtin_amdgcn_mfma_f32_32x32x16_bf16(b1, qr[d0], p1, 0, 0, 0); }
}
__device__ __forceinline__ int v_st(int k, int c) { const int kk = (k & ~0xC) | ((k & 4) << 1) | ((k & 8) >> 1); return ((kk >> 3) * 4 + (c >> 5)) * 512 + ((kk & 7) * 32 + (c & 31)) * 2; }
__device__ __forceinline__ int v_rd_base(int lane) { return ((lane & 3) << 3) | (((lane >> 2) & 3) << 6) | (((lane >> 4) & 1) << 5) | (((lane >> 5) & 1) << 8); }
constexpr int v_rd_off(int d0, int ks, int half) { return d0 * 512 + ks * 4096 + half * 2048; }
template <int OFF> __device__ __forceinline__ s16x4 tr_read(int vb) {
  s16x4 r; asm volatile("ds_read_b64_tr_b16 %0, %1 offset:%2" : "=&v"(r) : "v"(vb), "i"(OFF) : "memory"); return r;
}
template <int D0> __device__ __forceinline__ void pv_one(f32x16& od, int vb, bf16x8 pa0, bf16x8 pa1, bf16x8 pa2, bf16x8 pa3) {
  const s16x4 l0 = tr_read<v_rd_off(D0, 0, 0)>(vb), h0 = tr_read<v_rd_off(D0, 0, 1)>(vb), l1 = tr_read<v_rd_off(D0, 1, 0)>(vb), h1 = tr_read<v_rd_off(D0, 1, 1)>(vb);
  const s16x4 l2 = tr_read<v_rd_off(D0, 2, 0)>(vb), h2 = tr_read<v_rd_off(D0, 2, 1)>(vb), l3 = tr_read<v_rd_off(D0, 3, 0)>(vb), h3 = tr_read<v_rd_off(D0, 3, 1)>(vb);
  asm volatile("s_waitcnt lgkmcnt(0)" ::: "memory"); SBAR();
#define PK(L, H) (bf16x8){L[0], L[1], L[2], L[3], H[0], H[1], H[2], H[3]}
  od = __builtin_amdgcn_mfma_f32_32x32x16_bf16(pa0, PK(l0, h0), od, 0, 0, 0);
  od = __builtin_amdgcn_mfma_f32_32x32x16_bf16(pa1, PK(l1, h1), od, 0, 0, 0);
  od = __builtin_amdgcn_mfma_f32_32x32x16_bf16(pa2, PK(l2, h2), od, 0, 0, 0);
  od = __builtin_amdgcn_mfma_f32_32x32x16_bf16(pa3, PK(l3, h3), od, 0, 0, 0);
#undef PK
}
template <int DV> __device__ __forceinline__ void pv_d0(f32x16* o, int vb, bf16x8 pa0, bf16x8 pa1, bf16x8 pa2, bf16x8 pa3) {
  pv_one<0>(o[0], vb, pa0, pa1, pa2, pa3); pv_one<1>(o[1], vb, pa0, pa1, pa2, pa3);
  if constexpr (DV == 128) { pv_one<2>(o[2], vb, pa0, pa1, pa2, pa3); pv_one<3>(o[3], vb, pa0, pa1, pa2, pa3); }
}

template <int DV, int SC, int LDO, int DQK>
__device__ __forceinline__ void attn_dense_body(const bf16* __restrict__ Qb, const bf16* __restrict__ Kh, const bf16* __restrict__ Vh,
                                                bf16* __restrict__ Ob, int seq, char* lds, const int tid) {
  constexpr int ND = DV / 32, NKS = DQK / 16;
  const int wid = tid >> 6, lane = tid & 63, r32 = lane & 31, hi = lane >> 5;
  bf16* V_lds = (bf16*)lds; bf16* K_lds = (bf16*)(lds + 2 * SHM_V);
  float* ws = (float*)(lds + 2 * SHM_V + 2 * SHM_K) + wid * 64; float* li_l = ws; float* al_l = ws + 32;
  float m_reg = -1e30f, l_reg = 0; f32x16 o[ND] = {}; bf16x8 qr[NKS];
  const bf16* Qw = Qb + (long)(wid * QBLK + r32) * 128 + hi * 8;
#pragma unroll
  for (int d0 = 0; d0 < NKS; ++d0) qr[d0] = *reinterpret_cast<const bf16x8*>(Qw + d0 * 16);
  const int sr = tid >> 4, sc = (tid & 15) * 8;
  const int vr = (DV == 128) ? sr : (tid >> 3), vc = (DV == 128) ? sc : (tid & 7) * 8;
  const int vst0 = v_st(vr, vc), vst1 = v_st(32 + vr, vc);
  const int vb0 = (int)(uintptr_t)V_lds + v_rd_base(lane);
  constexpr int SDEPTH = 1;
  struct { bf16x8 vs0, vs1, ks0, ks1; } sr_[SDEPTH];
#define SLOAD(i, k0) do { sr_[i].vs0 = *reinterpret_cast<const bf16x8*>(&Vh[(long)((k0) + vr) * DV + vc]); \
    if constexpr (DV == 128) sr_[i].vs1 = *reinterpret_cast<const bf16x8*>(&Vh[(long)((k0) + 32 + vr) * DV + vc]); \
    sr_[i].ks0 = *reinterpret_cast<const bf16x8*>(&Kh[(long)((k0) + sr) * 128 + sc]); sr_[i].ks1 = *reinterpret_cast<const bf16x8*>(&Kh[(long)((k0) + 32 + sr) * 128 + sc]); } while (0)
#define SWRITE(b, i) do { *(bf16x8*)((char*)V_lds + (b) * SHM_V + vst0) = sr_[i].vs0;          \
    if constexpr (DV == 128) *(bf16x8*)((char*)V_lds + (b) * SHM_V + vst1) = sr_[i].vs1; int kc = sc * 2;               \
    *(bf16x8*)((char*)K_lds + (b) * SHM_K + KSWZ(sr, kc)) = sr_[i].ks0;                       \
    *(bf16x8*)((char*)K_lds + (b) * SHM_K + KSWZ(32 + sr, kc)) = sr_[i].ks1; } while (0)
#define SWAIT() do { if constexpr (SDEPTH == 1) asm volatile("s_waitcnt vmcnt(0)" ::: "memory"); else if constexpr (DV == 128) asm volatile("s_waitcnt vmcnt(4)" ::: "memory"); else asm volatile("s_waitcnt vmcnt(3)" ::: "memory"); } while (0)
#define RESC(a) do { if (__any((a) < 1.f)) { if (hi == 0) al_l[r32] = (a); asm volatile("s_waitcnt lgkmcnt(0)" ::: "memory"); \
    _Pragma("unroll") for (int d = 0; d < ND; ++d) _Pragma("unroll") for (int r = 0; r < 16; ++r) o[d][r] *= al_l[crow(r, hi)]; } } while (0)
  f32x16 pA0, pA1, pB0, pB1; float mnA, mnB, alA, alB; bf16x8 pa0, pa1, pa2, pa3; const int NT = seq / KVBLK;
  constexpr int SE = 0, SO = SDEPTH - 1;
  SLOAD(SE, 0); asm volatile("s_waitcnt vmcnt(0)" ::: "memory"); SWRITE(0, SE); __syncthreads();
  qkt<NKS>(pA0, pA1, K_lds, qr, r32, hi); partialSM<SC>(pA0, pA1, m_reg, mnA, alA);
  SLOAD(SO, KVBLK); if constexpr (SDEPTH == 2) { if (2 < NT) SLOAD(SE, 2 * KVBLK); }
  SWAIT(); SWRITE(1, SO); __syncthreads();
  for (int j = 1; j + 1 < NT; j += 2) {
    SBAR(); qkt<NKS>(pB0, pB1, (bf16*)((char*)K_lds + SHM_K), qr, r32, hi);
    finishSM(pA0, pA1, alA, l_reg, pa0, pa1, pa2, pa3); SBAR();
    SLOAD(SO, (j + SDEPTH) * KVBLK); SBAR();
    pv_d0<DV>(o, vb0, pa0, pa1, pa2, pa3); partialSM<SC>(pB0, pB1, m_reg, mnB, alB);
    __syncthreads(); SWAIT(); SWRITE(0, SE);
    RESC(alB); __syncthreads();
    SBAR(); qkt<NKS>(pA0, pA1, K_lds, qr, r32, hi);
    finishSM(pB0, pB1, alB, l_reg, pa0, pa1, pa2, pa3); SBAR();
    if (SDEPTH == 1 || j + 3 < NT) SLOAD(SE, (j + 1 + SDEPTH) * KVBLK); SBAR();
    pv_d0<DV>(o, vb0 + (int)SHM_V, pa0, pa1, pa2, pa3); partialSM<SC>(pA0, pA1, m_reg, mnA, alA);
    __syncthreads(); SWAIT(); SWRITE(1, SO);
    RESC(alA); __syncthreads();
  }
  SBAR(); qkt<NKS>(pB0, pB1, (bf16*)((char*)K_lds + SHM_K), qr, r32, hi);
  finishSM(pA0, pA1, alA, l_reg, pa0, pa1, pa2, pa3); SBAR();
  pv_d0<DV>(o, vb0, pa0, pa1, pa2, pa3); partialSM<SC>(pB0, pB1, m_reg, mnB, alB);
  __syncthreads(); RESC(alB);
  finishSM(pB0, pB1, alB, l_reg, pa0, pa1, pa2, pa3); SBAR();
  pv_d0<DV>(o, vb0 + (int)SHM_V, pa0, pa1, pa2, pa3);
  if (hi == 0) li_l[r32] = l_reg; asm volatile("s_waitcnt lgkmcnt(0)" ::: "memory");
  float rli[16];
#pragma unroll
  for (int r = 0; r < 16; ++r) rli[r] = __builtin_amdgcn_rcpf(li_l[crow(r, hi)]);
  bf16* Ow = Ob + (long)(wid * QBLK) * LDO;
#pragma unroll
  for (int r = 0; r < 16; ++r) { int orow = crow(r, hi);
#pragma unroll
    for (int d0 = 0; d0 < ND; ++d0) Ow[(long)orow * LDO + d0 * 32 + r32] = (bf16)f2bf(o[d0][r] * rli[r]); }
  __syncthreads();
#undef SLOAD
#undef SWRITE
#undef SWAIT
#undef RESC
}
#undef KSWZ
#undef SBAR
}
namespace s5 {
constexpr int CH = 4, BT = 16 * CH;
constexpr int NCB = CTXL / BT;
constexpr int NBLK = SKV / BT;
constexpr int NSQ = 6;
static_assert((1 << NSQ) == BT, "squarings");
constexpr int HS_STRIDE = 272;
constexpr int HS_BYTES = 32 * HS_STRIDE;
constexpr int NITEMS = 32 * 2 * NBLK;

struct Params { const float *a_re, *a_im, *log_dt, *b_re, *b_im, *c_re, *c_im, *dskip; };

__device__ __forceinline__ int rowof(int b, int blk, int j) { return blk < NCB ? LAT_ROWS + b * 256 + blk * BT + j : b * 4096 + (blk - NCB) * BT + j; }

struct DirConst {
    float abr[2], abi[2];
    bf16x8 Bfr[2], Bfi[2];
};
__device__ __forceinline__ void load_dir(const Params& P, int dd, int g, int nl, int hi, DirConst& dc) {
    const float dt = __expf(P.log_dt[dd * 32 + g]);
#pragma unroll
    for (int nh = 0; nh < 2; ++nh) {
        const int n = nl + 32 * nh; const int ix = (dd * 32 + g) * 64 + n;
        const float are = P.a_re[ix], aim = P.a_im[ix];
        const float mag = __expf(dt * are), th = dt * aim;
        float rev = th * 0.15915494309189535f; rev -= floorf(rev);
        const float sn = __builtin_amdgcn_sinf(rev), cs = __builtin_amdgcn_cosf(rev);
        const float abr = mag * cs, abi = mag * sn;
        const float den = are * are + aim * aim, nr = abr - 1.f;
        const float zr = (nr * are + abi * aim) / den, zi = (abi * are - nr * aim) / den;
        dc.abr[nh] = abr; dc.abi[nh] = abi;
        const float* br = P.b_re + (size_t)ix * 16 + 8 * hi; const float* bi = P.b_im + (size_t)ix * 16 + 8 * hi;
        u32x4 wr_, wi_;
        float r8[8], i8[8];
#pragma unroll
        for (int j = 0; j < 8; ++j) { const float bre = br[j], bim = bi[j]; r8[j] = zr * bre - zi * bim; i8[j] = zr * bim + zi * bre; }
        wr_.x = pk2(r8[0], r8[1]); wr_.y = pk2(r8[2], r8[3]); wr_.z = pk2(r8[4], r8[5]); wr_.w = pk2(r8[6], r8[7]);
        wi_.x = pk2(i8[0], i8[1]); wi_.y = pk2(i8[2], i8[3]); wi_.z = pk2(i8[4], i8[5]); wi_.w = pk2(i8[6], i8[7]);
        dc.Bfr[nh] = __builtin_bit_cast(bf16x8, wr_); dc.Bfi[nh] = __builtin_bit_cast(bf16x8, wi_);
    }
}
__device__ __forceinline__ void load_cmat(const Params& P, int dd, int g, int lane, bf16x8 (&Cf)[4]) {
    const int p = lane & 15, kq = lane >> 4;
    const float* cre = P.c_re + ((size_t)(dd * 32 + g) * 16 + p) * 64; const float* cim = P.c_im + ((size_t)(dd * 32 + g) * 16 + p) * 64;
#pragma unroll
    for (int ks = 0; ks < 4; ++ks) {
        float v[8];
#pragma unroll
        for (int j = 0; j < 8; ++j) { const int k = 32 * ks + 8 * kq + j; const int n = (k >> 2) + 32 * ((k >> 1) & 1); v[j] = (k & 1) ? -cim[n] : cre[n]; }
        u32x4 w; w.x = pk2(v[0], v[1]); w.y = pk2(v[2], v[3]); w.z = pk2(v[4], v[5]); w.w = pk2(v[6], v[7]);
        Cf[ks] = __builtin_bit_cast(bf16x8, w);
    }
}
constexpr int TAB_BYTES = 9 * 64 * 16;
__device__ __forceinline__ void build_tab(const Params& P, int dd, int g, int lane, u32x4* dst) {
    DirConst dc; load_dir(P, dd, g, lane & 31, lane >> 5, dc);
    bf16x8 Cf[4]; load_cmat(P, dd, g, lane, Cf);
    ((f32x4*)dst)[lane] = (f32x4){dc.abr[0], dc.abr[1], dc.abi[0], dc.abi[1]};
    dst[1 * 64 + lane] = __builtin_bit_cast(u32x4, dc.Bfr[0]); dst[2 * 64 + lane] = __builtin_bit_cast(u32x4, dc.Bfr[1]);
    dst[3 * 64 + lane] = __builtin_bit_cast(u32x4, dc.Bfi[0]); dst[4 * 64 + lane] = __builtin_bit_cast(u32x4, dc.Bfi[1]);
#pragma unroll
    for (int k = 0; k < 4; ++k) dst[(5 + k) * 64 + lane] = __builtin_bit_cast(u32x4, Cf[k]);
}
__device__ __forceinline__ void load_tab(const u32x4* tab, int dd, int g, int lane, DirConst& dc, bf16x8 (&Cf)[4]) {
    const u32x4* t = tab + (size_t)(dd * 32 + g) * (TAB_BYTES / 16);
    u32x4 w[9];
#pragma unroll
    for (int k = 1; k < 9; ++k) w[k] = t[k * 64 + lane];
    const f32x4 a0 = ((const f32x4*)t)[lane];
    dc.abr[0] = a0[0]; dc.abr[1] = a0[1]; dc.abi[0] = a0[2]; dc.abi[1] = a0[3];
    dc.Bfr[0] = __builtin_bit_cast(bf16x8, w[1]); dc.Bfr[1] = __builtin_bit_cast(bf16x8, w[2]); dc.Bfi[0] = __builtin_bit_cast(bf16x8, w[3]); dc.Bfi[1] = __builtin_bit_cast(bf16x8, w[4]);
#pragma unroll
    for (int k = 0; k < 4; ++k) Cf[k] = __builtin_bit_cast(bf16x8, w[5 + k]);
}
__device__ __forceinline__ bf16x8 load_af(const bf16* zraw, int g, int bp, int blk, int c, int lane) {
    const int rho = lane & 31, kh = lane >> 5;
    const int beta = (rho >> 2) & 1, tau = (rho & 3) + 4 * (rho >> 3);
    const int row = rowof(2 * bp + beta, blk, 16 * c + tau);
    return *reinterpret_cast<const bf16x8*>(zraw + (size_t)row * 1024 + g * 16 + 8 * kh);
}
template <bool REV>
__device__ __forceinline__ void chunk_scan(const bf16x8 af, const DirConst& dc,
                                           float (&hr)[2], float (&hi_)[2], f32x16 (&accR)[2], f32x16 (&accI)[2]) {
#pragma unroll
    for (int nh = 0; nh < 2; ++nh) {
        accR[nh] = __builtin_amdgcn_mfma_f32_32x32x16_bf16(af, dc.Bfr[nh], f32x16{}, 0, 0, 0);
        accI[nh] = __builtin_amdgcn_mfma_f32_32x32x16_bf16(af, dc.Bfi[nh], f32x16{}, 0, 0, 0);
    }
#pragma unroll
    for (int qq = 0; qq < 16; ++qq) {
        const int q = REV ? 15 - qq : qq;
#pragma unroll
        for (int nh = 0; nh < 2; ++nh) {
            const float nr_ = dc.abr[nh] * hr[nh] - dc.abi[nh] * hi_[nh] + accR[nh][q];
            const float ni_ = dc.abr[nh] * hi_[nh] + dc.abi[nh] * hr[nh] + accI[nh][q];
            hr[nh] = nr_; hi_[nh] = ni_; accR[nh][q] = nr_; accI[nh][q] = ni_;
        }
    }
}

__device__ __forceinline__ void pass_a_item(const Params& P, const u32x4* tab, const bf16* zraw, float* E, int item, int lane) {
    const int g = item & 31, rest = item >> 5, blk = rest % NBLK, bp = rest / NBLK;
    const int nl = lane & 31, hi = lane >> 5;
    f32x16 accR[2], accI[2];
#pragma unroll
    for (int dd = 0; dd < 2; ++dd) {
        DirConst dc; bf16x8 Cfu[4]; load_tab(tab, dd, g, lane, dc, Cfu);
#ifdef DBG_TABA
        { DirConst d2; load_dir(P, dd, g, nl, hi, d2);
          if (DBG_TABA == 1) dc = d2;
          if (DBG_TABA == 2) { dc.abr[0] = d2.abr[0]; dc.abr[1] = d2.abr[1]; dc.abi[0] = d2.abi[0]; dc.abi[1] = d2.abi[1]; }
          if (DBG_TABA == 3) { dc.Bfr[0] = d2.Bfr[0]; dc.Bfr[1] = d2.Bfr[1]; dc.Bfi[0] = d2.Bfi[0]; dc.Bfi[1] = d2.Bfi[1]; } }
#endif
        float hr[2] = {0.f, 0.f}, hi_[2] = {0.f, 0.f};
        bf16x8 af = load_af(zraw, g, bp, blk, dd == 0 ? 0 : CH - 1, lane);
        for (int cc = 0; cc < CH; ++cc) {
            const int cn = cc < CH - 1 ? cc + 1 : cc;
            const bf16x8 afn = load_af(zraw, g, bp, blk, dd == 0 ? cn : CH - 1 - cn, lane);
            if (dd == 0) chunk_scan<false>(af, dc, hr, hi_, accR, accI);
            else chunk_scan<true>(af, dc, hr, hi_, accR, accI);
            af = afn;
        }
        const int b = 2 * bp + hi;
        float* e = E + ((((size_t)(dd * 32 + g) * 4 + b) * NBLK + blk) * 64) * 2;
#pragma unroll
        for (int nh = 0; nh < 2; ++nh) { *(f32x2*)(e + (nl + 32 * nh) * 2) = (f32x2){hr[nh], hi_[nh]}; }
    }
}

__device__ __forceinline__ void readout(LAS unsigned char* hs, int lane, const bf16x8 (&Cf)[4], const f32x16 (&accR)[2], const f32x16 (&accI)[2], f32x4 (&y)[2]) {
    const int nl = lane & 31, hi = lane >> 5;
#pragma unroll
    for (int q = 0; q < 16; ++q) {
        u32x2 w; w.x = pk2(accR[0][q], accI[0][q]); w.y = pk2(accR[1][q], accI[1][q]);
        *(LAS u32x2*)(hs + (hi * 16 + q) * HS_STRIDE + nl * 8) = w;
    }
    asm volatile("s_waitcnt lgkmcnt(0)" ::: "memory");
    const int tk = lane & 15, kq = lane >> 4;
#pragma unroll
    for (int beta = 0; beta < 2; ++beta) {
#pragma unroll
        for (int ks = 0; ks < 4; ++ks) {
            const bf16x8 hb = *(const LAS bf16x8*)(hs + (beta * 16 + tk) * HS_STRIDE + (32 * ks + 8 * kq) * 2);
            y[beta] = __builtin_amdgcn_mfma_f32_16x16x32_bf16(Cf[ks], hb, y[beta], 0, 0, 0);
        }
    }
    asm volatile("s_waitcnt lgkmcnt(0)" ::: "memory");
}

__device__ __forceinline__ void prefix_wave(const Params& P, float* E, int seq, int lane) {
    const int dd = seq >> 7, g = (seq >> 2) & 31, n = lane;
    const int ix = (dd * 32 + g) * 64 + n;
    const float dt = __expf(P.log_dt[dd * 32 + g]);
    const float are = P.a_re[ix], aim = P.a_im[ix];
    const float mag = __expf(dt * are), th = dt * aim;
    float rev = th * 0.15915494309189535f; rev -= floorf(rev);
    float ar = mag * __builtin_amdgcn_cosf(rev), ai = mag * __builtin_amdgcn_sinf(rev);
#pragma unroll
    for (int s = 0; s < NSQ; ++s) { const float t = ar * ar - ai * ai; ai = 2.f * ar * ai; ar = t; }
    float* e = E + ((size_t)seq * NBLK * 64 + n) * 2;
    float hr = 0.f, hi = 0.f;
    constexpr int BATCH = 17; static_assert(NBLK % BATCH == 0, "batching");
    for (int c0 = 0; c0 < NBLK; c0 += BATCH) {
        f32x2 ev[BATCH];
#pragma unroll
        for (int u = 0; u < BATCH; ++u) { const int ci = c0 + u; const int blk = dd == 0 ? ci : (ci < NCB ? NCB - 1 - ci : NBLK + NCB - 1 - ci); ev[u] = *(const f32x2*)(e + (size_t)blk * 128); }
        asm volatile("" ::: "memory");
#pragma unroll
        for (int u = 0; u < BATCH; ++u) { const int ci = c0 + u; const int blk = dd == 0 ? ci : (ci < NCB ? NCB - 1 - ci : NBLK + NCB - 1 - ci);
            *(f32x2*)(e + (size_t)blk * 128) = (f32x2){hr, hi};
            const float nr_ = ar * hr - ai * hi + ev[u].x, ni_ = ar * hi + ai * hr + ev[u].y; hr = nr_; hi = ni_; }
    }
}

__device__ __forceinline__ void pass_b_item(const Params& P, const u32x4* tab, const bf16* zraw, const float* E, bf16* gg, LAS unsigned char* hs, int item, int lane) {
    const int g = item & 31, rest = item >> 5, blk = rest % NBLK, bp = rest / NBLK;
    const int nl = lane & 31, hi = lane >> 5;
    const int b = 2 * bp + hi;
    f32x16 accR[2], accI[2];
    f32x4 yf[CH][2];
    {
        DirConst dc; bf16x8 Cf[4]; load_tab(tab, 0, g, lane, dc, Cf);
#ifdef DBG_TABCMP
        { DirConst d2; load_dir(P, 0, g, nl, hi, d2); bf16x8 C2[4]; load_cmat(P, 0, g, lane, C2); bool bad = false;
          for (int q = 0; q < 2; ++q) { if (d2.abr[q] != dc.abr[q] || d2.abi[q] != dc.abi[q]) bad = true; for (int j = 0; j < 8; ++j) if (d2.Bfr[q][j] != dc.Bfr[q][j] || d2.Bfi[q][j] != dc.Bfi[q][j]) bad = true; }
          bool badc = false; for (int q = 0; q < 4; ++q) for (int j = 0; j < 8; ++j) if (C2[q][j] != Cf[q][j]) badc = true;
          if (DBG_TABCMP == 1 && bad) dc.abr[0] = __builtin_nanf(""); if (DBG_TABCMP == 2 && badc) dc.abr[0] = __builtin_nanf("");
          if (DBG_TABCMP == 3) { dc = d2; for (int q = 0; q < 4; ++q) Cf[q] = C2[q]; } }
#endif
        float hr[2], hi_[2];
        { const float* e = E + (((((size_t)(0 * 32 + g) * 4 + b) * NBLK + blk) * 64) * 2);
#pragma unroll
          for (int nh = 0; nh < 2; ++nh) { const f32x2 hv = *(const f32x2*)(e + (nl + 32 * nh) * 2); hr[nh] = hv.x; hi_[nh] = hv.y; } }
        bf16x8 af = load_af(zraw, g, bp, blk, 0, lane);
#pragma unroll
        for (int c = 0; c < CH; ++c) {
            const bf16x8 afn = load_af(zraw, g, bp, blk, c < CH - 1 ? c + 1 : c, lane);
            chunk_scan<false>(af, dc, hr, hi_, accR, accI); af = afn;
            yf[c][0] = (f32x4){0.f, 0.f, 0.f, 0.f}; yf[c][1] = (f32x4){0.f, 0.f, 0.f, 0.f};
            readout(hs, lane, Cf, accR, accI, yf[c]);
        }
    }
    {
        DirConst dc; bf16x8 Cf[4]; load_tab(tab, 1, g, lane, dc, Cf);
        float hr[2], hi_[2];
        { const float* e = E + (((((size_t)(1 * 32 + g) * 4 + b) * NBLK + blk) * 64) * 2);
#pragma unroll
          for (int nh = 0; nh < 2; ++nh) { const f32x2 hv = *(const f32x2*)(e + (nl + 32 * nh) * 2); hr[nh] = hv.x; hi_[nh] = hv.y; } }
        const int tk = lane & 15, kq = lane >> 4;
        const f32x4 dv = *(const f32x4*)(P.dskip + g * 16 + 4 * kq);
        bf16x8 af = load_af(zraw, g, bp, blk, CH - 1, lane);
#pragma unroll
        for (int cc = 0; cc < CH; ++cc) {
            const int c = CH - 1 - cc;
            const bf16x8 afn = load_af(zraw, g, bp, blk, c > 0 ? c - 1 : c, lane);
            u32x2 uwv[2];
#pragma unroll
            for (int beta = 0; beta < 2; ++beta) uwv[beta] = *(const u32x2*)(zraw + (size_t)rowof(2 * bp + beta, blk, 16 * c + tk) * 1024 + g * 16 + 4 * kq);
            chunk_scan<true>(af, dc, hr, hi_, accR, accI); af = afn;
            readout(hs, lane, Cf, accR, accI, yf[c]);
#pragma unroll
            for (int beta = 0; beta < 2; ++beta) {
                const int row = rowof(2 * bp + beta, blk, 16 * c + tk);
                const u32x2 uw = uwv[beta];
                const f32x4 yv = yf[c][beta];
                const float v0 = yv[0] + dv[0] * bflo(uw.x), v1 = yv[1] + dv[1] * bfhi(uw.x), v2 = yv[2] + dv[2] * bflo(uw.y), v3 = yv[3] + dv[3] * bfhi(uw.y);
                u32x2 ow; ow.x = pk2(gelu_tanh(v0), gelu_tanh(v1)); ow.y = pk2(gelu_tanh(v2), gelu_tanh(v3));
                *(u32x2*)(gg + (size_t)row * 512 + g * 16 + 4 * kq) = ow;
            }
        }
    }
}
}
typedef const float* __attribute__((address_space(4))) const* KargPtrTable;
#define KIN(k) (((KargPtrTable)__builtin_amdgcn_kernarg_segment_ptr())[k])
struct Ctx {
    float* out; unsigned char* ws;
    LAS unsigned char* lds;
    int tid, lane, wave, G, gw, NGW, bid, dry;
};

__device__ __forceinline__ void tr_item(const float* src, int sld, int c0, int k0, int srcK, bf16* dst, int dld, int n0, bool zero, LAS float* scr, int lane) {
    const int c = lane & 7;
    if (zero || k0 >= srcK) {
#pragma unroll
        for (int j = 0; j < 4; ++j) { const int n = (lane >> 3) + 8 * j; unsigned z0 = 0u; asm volatile("" : "+v"(z0));
            *(u32x4*)(dst + (size_t)(n0 + n) * dld + k0 + 8 * c) = (u32x4){z0, z0, z0, z0}; }
        return;
    }
    { const int kk = lane >> 3, nc = lane & 7;
      f32x4 v[8];
#pragma unroll
      for (int i = 0; i < 8; ++i) v[i] = *(const f32x4*)(src + (size_t)(k0 + 8 * i + kk) * sld + c0 + 4 * nc);
#pragma unroll
      for (int i = 0; i < 8; ++i) { LAS float* d = scr + (8 * i + kk) * 33 + 4 * nc; d[0] = v[i][0]; d[1] = v[i][1]; d[2] = v[i][2]; d[3] = v[i][3]; } }
    asm volatile("s_waitcnt lgkmcnt(0)" ::: "memory");
#pragma unroll
    for (int j = 0; j < 4; ++j) { const int n = (lane >> 3) + 8 * j; const LAS float* s = scr + (8 * c) * 33 + n;
        u32x4 o; o.x = cvtpk(s[0 * 33], s[1 * 33]); o.y = cvtpk(s[2 * 33], s[3 * 33]); o.z = cvtpk(s[4 * 33], s[5 * 33]); o.w = cvtpk(s[6 * 33], s[7 * 33]);
        *(u32x4*)(dst + (size_t)(n0 + n) * dld + k0 + 8 * c) = o; }
    asm volatile("s_waitcnt lgkmcnt(0)" ::: "memory");
}

#ifndef DEF_QA
#define DEF_QA 12
#endif
#ifndef DEF_QB
#define DEF_QB 12
#endif
constexpr int DEF_ITEMS = 128 * (512 + 256), DEF_P0 = (48 - 2 * (DEF_QA + DEF_QB)) * 2048;
static_assert(DEF_ITEMS == 48 * 2048 && DEF_P0 >= 0 && DEF_P0 + (DEF_QA + DEF_QB) * 2048 >= 2 * 32 * 768, "deferred conversion schedule: layers 0 and 1 complete before layer 0's MoE");
__device__ __forceinline__ void moe_item(const Ctx& F, int q, LAS float* scr) {
    constexpr int PER_LE = 512 + 256;
    const int le = q / PER_LE; int r = q % PER_LE;
    if (r < 512) { const int nb = r >> 4, kb = r & 15;
        const int n0 = nb * 32, pn = n0 >> 8, w = n0 & 255;
        const float* src = (w < 128 ? KIN(33) : KIN(34)) + (size_t)le * 1024 * 512;
        tr_item(src, 512, pn * 128 + (w & 127), kb * 64, 1024, (bf16*)(F.ws + WS_W_GU) + (size_t)le * 1024 * 1024, 1024, n0, false, scr, F.lane);
    } else { r -= 512; const int nb = r >> 3, kb = r & 7;
        tr_item(KIN(35) + (size_t)le * 512 * 1024, 1024, nb * 32, kb * 64, 512, (bf16*)(F.ws + WS_W_DN) + (size_t)le * 1024 * 512, 512, nb * 32, false, scr, F.lane); }
}
__device__ __forceinline__ void p0_weights(const Ctx& F) {
    LAS float* scr = (LAS float*)(F.lds + F.wave * 16384);
    constexpr int PER_I = 512 + 512 + 128 + 96 + 128 + 1024 + 512;
    constexpr int DENSE = 2 * PER_I, PER_LE = 512 + 256, TOTAL = DENSE + DEF_P0;
    for (int it = F.gw; it < TOTAL; it += F.NGW) {
        if (it < DENSE) {
            const int i = it / PER_I; int r = it % PER_I;
            if (r < 512) { const int nb = r >> 4, kb = r & 15;
                tr_item(KIN(8) + (size_t)i * 1024 * 928, 928, nb * 32, kb * 64, 1024, (bf16*)(F.ws + WS_W_IN) + (size_t)i * 1024 * 1024, 1024, nb * 32, nb >= 29, scr, F.lane); continue; } r -= 512;
            if (r < 512) { const int nb = r >> 4, kb = r & 15;
                tr_item(KIN(9) + (size_t)i * 1024 * 1024, 1024, nb * 32, kb * 64, 1024, (bf16*)(F.ws + WS_W_OUTE) + (size_t)i * 1024 * 1024, 1024, nb * 32, false, scr, F.lane); continue; } r -= 512;
            if (r < 128) { const int nb = r >> 3, kb = r & 7;
                tr_item(KIN(18) + (size_t)i * 512 * 512, 512, nb * 32, kb * 64, 512, (bf16*)(F.ws + WS_W_GLU) + (size_t)i * 512 * 512, 512, nb * 32, false, scr, F.lane); continue; } r -= 128;
            if (r < 96) { const int nb = r >> 2, kb = r & 3;
                tr_item(KIN(20) + (size_t)i * 256 * 768, 768, nb * 32, kb * 64, 256, (bf16*)(F.ws + WS_W_MLA) + (size_t)i * 1792 * 256, 256, nb * 32, false, scr, F.lane); continue; } r -= 96;
            if (r < 128) { const int nb = r >> 2, kb = r & 3;
                tr_item(KIN(22) + (size_t)i * 128 * 1024, 1024, nb * 32, kb * 64, 128, (bf16*)(F.ws + WS_W_MLA) + (size_t)i * 1792 * 256, 256, 768 + nb * 32, false, scr, F.lane); continue; } r -= 128;
            if (r < 1024) { const int nb = r >> 4, kb = r & 15;
                tr_item(KIN(25) + (size_t)i * 1024 * 2048, 2048, nb * 32, kb * 64, 1024, (bf16*)(F.ws + WS_W_QKV) + (size_t)i * 2048 * 1024, 1024, nb * 32, false, scr, F.lane); continue; } r -= 1024;
            { const int nb = r >> 4, kb = r & 15;
                tr_item(KIN(26) + (size_t)i * 1024 * 1024, 1024, nb * 32, kb * 64, 1024, (bf16*)(F.ws + WS_W_OUTO) + (size_t)i * 1024 * 1024, 1024, nb * 32, false, scr, F.lane); }
        } else {
            moe_item(F, it - DENSE, scr);
        }
    }
}
__device__ __forceinline__ void defer_convert(const Ctx& F, int slot) {
    const int quota = (slot & 1) ? DEF_QB : DEF_QA, start = DEF_P0 + (slot >> 1) * (DEF_QA + DEF_QB) * 2048 + (slot & 1) * DEF_QA * 2048;
    LAS float* scr = (LAS float*)(F.lds + 8 * 8704 + F.wave * 8448);
    for (int k = 0; k < quota; ++k) moe_item(F, start + k * F.NGW + F.gw, scr);
}
__device__ __forceinline__ void p0_ada(const Ctx& F) {
    LAS float* sc = (LAS float*)(F.lds);
    LAS float* red = (LAS float*)(F.lds + 32768);
    for (int i = F.tid; i < 5 * 1024; i += 512) { const int r = i >> 10, k = i & 1023; const float v = r < 4 ? KIN(1)[r * 1024 + k] : KIN(3)[k]; sc[i] = siluf_(v); }
    __syncthreads();
    const int id = F.bid, l = id / 48, col0 = (id % 48) * 128;
    float a[5][2];
#pragma unroll
    for (int r = 0; r < 5; ++r) { a[r][0] = 0.f; a[r][1] = 0.f; }
    const float* wp = KIN(4) + ((size_t)l * 1024 + F.wave * 128) * NMOD + col0 + 2 * F.lane;
#pragma nounroll
    for (int k0 = 0; k0 < 128; k0 += 32) {
        f32x2 w2[32];
#pragma unroll
        for (int k = 0; k < 32; ++k) w2[k] = *(const f32x2*)(wp + (size_t)(k0 + k) * NMOD);
        __builtin_amdgcn_sched_barrier(0);
#pragma unroll
        for (int k = 0; k < 32; ++k)
#pragma unroll
            for (int r = 0; r < 5; ++r) { const float s = sc[r * 1024 + F.wave * 128 + k0 + k]; a[r][0] += s * w2[k].x; a[r][1] += s * w2[k].y; }
        __builtin_amdgcn_sched_barrier(0);
    }
#pragma unroll
    for (int r = 0; r < 5; ++r) { red[(F.wave * 5 + r) * 128 + 2 * F.lane] = a[r][0]; red[(F.wave * 5 + r) * 128 + 2 * F.lane + 1] = a[r][1]; }
    __syncthreads();
    for (int i = F.tid; i < 5 * 128; i += 512) { const int r = i >> 7, cc = i & 127; float s = KIN(5)[l * NMOD + col0 + cc];
#pragma unroll
        for (int w = 0; w < 8; ++w) s += red[(w * 5 + r) * 128 + cc];
        ((float*)(F.ws + WS_MOD))[((size_t)l * 5 + r) * NMOD + col0 + cc] = s; }
    __syncthreads();
}
__device__ __forceinline__ void p0_rope(const Ctx& F) {
    float* t = (float*)(F.ws + WS_ROPE);
    for (int i = F.tid; i < 64 * 32; i += 512) { const int p = i >> 5, f = i & 31; const float inv = __builtin_amdgcn_exp2f(-(float)f * (13.287712379549449f / 32.f));
        float rev = (float)p * inv * 0.15915494309189535f; rev -= floorf(rev);
        t[2 * i] = __builtin_amdgcn_cosf(rev); t[2 * i + 1] = __builtin_amdgcn_sinf(rev); }
    for (int i = F.tid; i < 64 * 8; i += 512) { const int p = i >> 3, f = i & 7; const float inv = __builtin_amdgcn_exp2f(-(float)f * (13.287712379549449f / 8.f));
        float rev = (float)p * inv * 0.15915494309189535f; rev -= floorf(rev);
        t[ROPE32_OFF + 2 * i] = __builtin_amdgcn_cosf(rev); t[ROPE32_OFF + 2 * i + 1] = __builtin_amdgcn_sinf(rev); }
}

__device__ __forceinline__ void p0_router_t(const Ctx& F) {
    float* rt = (float*)(F.ws + WS_RT);
    for (int i = (F.bid - 193) * 512 + F.tid; i < DEPTH * 36 * 1024; i += 63 * 512) { const int k = i & 1023, j = (i >> 10) % 36, l = i / (36 * 1024);
        rt[i] = j < 4 ? KIN(29)[((size_t)l * 1024 + k) * 4 + j] : KIN(31)[((size_t)l * 1024 + k) * 32 + (j - 4)]; }
}
__device__ __forceinline__ void unpack8(const u32x4 w, float (&x)[8]) { x[0] = bflo(w.x); x[1] = bfhi(w.x); x[2] = bflo(w.y); x[3] = bfhi(w.y); x[4] = bflo(w.z); x[5] = bfhi(w.z); x[6] = bflo(w.w); x[7] = bfhi(w.w); }
__device__ __forceinline__ u32x4 pack8(const float (&x)[8]) { u32x4 w; w.x = pk2(x[0], x[1]); w.y = pk2(x[2], x[3]); w.z = pk2(x[4], x[5]); w.w = pk2(x[6], x[7]); return w; }
__device__ __forceinline__ float sumsq8(const float (&x)[8]) { return ((x[0] * x[0] + x[1] * x[1]) + (x[2] * x[2] + x[3] * x[3])) + ((x[4] * x[4] + x[5] * x[5]) + (x[6] * x[6] + x[7] * x[7])); }
__device__ __forceinline__ float group8_sum(float v) { v += DPP_F(v, 0xB1); v += DPP_F(v, 0x4E); v += DPP_F(v, 0x141); return v; }
__device__ __forceinline__ float group16_sum(float v) { v += DPP_F(v, 0xB1); v += DPP_F(v, 0x4E); v += DPP_F(v, 0x141); v += DPP_F(v, 0x140); return v; }
__device__ __forceinline__ void norm_rope8(const float (&x1)[8], const float (&x2)[8], float rinv, const float (&w1)[8], const float (&w2)[8], const float* csn, bool rot, u32x4& o1, u32x4& o2) {
    float a[8], b2[8];
    if (rot) {
        const f32x4 c0 = *(const f32x4*)(csn), c1 = *(const f32x4*)(csn + 4), c2 = *(const f32x4*)(csn + 8), c3 = *(const f32x4*)(csn + 12);
        const float cs[8] = {c0[0], c0[2], c1[0], c1[2], c2[0], c2[2], c3[0], c3[2]}, sn[8] = {c0[1], c0[3], c1[1], c1[3], c2[1], c2[3], c3[1], c3[3]};
#pragma unroll
        for (int j = 0; j < 8; ++j) { const float y1 = x1[j] * rinv * w1[j], y2 = x2[j] * rinv * w2[j]; a[j] = y1 * cs[j] - y2 * sn[j]; b2[j] = y2 * cs[j] + y1 * sn[j]; }
    } else {
#pragma unroll
        for (int j = 0; j < 8; ++j) { a[j] = x1[j] * rinv * w1[j]; b2[j] = x2[j] * rinv * w2[j]; }
    }
    o1 = pack8(a); o2 = pack8(b2);
}
struct RowV { float v[2][8]; };
__device__ __forceinline__ void ld_row_f32(const float* p, int lane, RowV& r) {
#pragma unroll
    for (int j = 0; j < 2; ++j) { const f32x4 a = *(const f32x4*)(p + 8 * lane + 512 * j), b = *(const f32x4*)(p + 8 * lane + 512 * j + 4);
        r.v[j][0] = a[0]; r.v[j][1] = a[1]; r.v[j][2] = a[2]; r.v[j][3] = a[3]; r.v[j][4] = b[0]; r.v[j][5] = b[1]; r.v[j][6] = b[2]; r.v[j][7] = b[3]; }
}
__device__ __forceinline__ void ld_row_bf16(const bf16* p, int lane, RowV& r) {
#pragma unroll
    for (int j = 0; j < 2; ++j) { const u32x4 w = *(const u32x4*)(p + 8 * lane + 512 * j); unpack8(w, r.v[j]); }
}
__device__ __forceinline__ float row_sumsq(const RowV& r) { return wave_sum(sumsq8(r.v[0]) + sumsq8(r.v[1])); }
__device__ __forceinline__ void ld8f(const float* p, float (&o)[8]) { const f32x4 a = *(const f32x4*)p, b = *(const f32x4*)(p + 4); o[0] = a[0]; o[1] = a[1]; o[2] = a[2]; o[3] = a[3]; o[4] = b[0]; o[5] = b[1]; o[6] = b[2]; o[7] = b[3]; }
__device__ __forceinline__ void ld_xrow(const Ctx& F, int l, int row, RowV& x) {
    if (l == 0) ld_row_f32(row < LAT_ROWS ? KIN(0) + (size_t)row * DM : KIN(2) + (size_t)(row - LAT_ROWS) * DM, F.lane, x);
    else ld_row_bf16((const bf16*)(F.ws + WS_XRES) + (size_t)row * DM, F.lane, x);
}
__device__ __forceinline__ void norm1_span(const Ctx& F, int l, int rowbase, int nrows, int mr) {
    const float* mod = (const float*)(F.ws + WS_MOD);
    const bf16* ydn = (const bf16*)(F.ws + WS_YDN);
    bf16* xres = (bf16*)(F.ws + WS_XRES);
    bf16* h = (bf16*)(F.ws + WS_H);
    float gt[2][8], gs[2][8], sh[2][8];
    { const float* g1 = KIN(6) + l * DM; const float* g2 = mod + ((size_t)(l - 1) * 5 + mr) * NMOD + 5 * DM; const float* mrow = mod + ((size_t)l * 5 + mr) * NMOD;
#pragma unroll
      for (int j = 0; j < 2; ++j) { const int col = 8 * F.lane + 512 * j; float gv[8], scl[8]; ld8f(g2 + col, gt[j]); ld8f(g1 + col, gv); ld8f(mrow + DM + col, scl); ld8f(mrow + col, sh[j]);
#pragma unroll
          for (int i = 0; i < 8; ++i) gs[j][i] = gv[i] * (1.f + scl[i]); } }
    u32x4 nx[2][2], ny0[2][2], ny1[2][2];
#define N1_ISSUE(t) _Pragma("unroll") for (int rr = 0; rr < 2; ++rr) { int rw = 2 * (t) + rr; rw = rowbase + (rw < nrows ? rw : nrows - 1); \
        _Pragma("unroll") for (int j = 0; j < 2; ++j) { const int col = 8 * F.lane + 512 * j; nx[rr][j] = *(const u32x4*)(xres + (size_t)rw * DM + col); \
            ny0[rr][j] = *(const u32x4*)(ydn + (size_t)(2 * rw) * DM + col); ny1[rr][j] = *(const u32x4*)(ydn + (size_t)(2 * rw + 1) * DM + col); } }
    N1_ISSUE(0);
    for (int t = 0; 2 * t < nrows; ++t) {
        u32x4 cx[2][2], cy0[2][2], cy1[2][2];
#pragma unroll
        for (int rr = 0; rr < 2; ++rr)
#pragma unroll
            for (int j = 0; j < 2; ++j) { cx[rr][j] = nx[rr][j]; cy0[rr][j] = ny0[rr][j]; cy1[rr][j] = ny1[rr][j]; }
        if (2 * (t + 1) < nrows) { N1_ISSUE(t + 1); }
#pragma unroll
        for (int rr = 0; rr < 2; ++rr) { if (2 * t + rr >= nrows) break;
            const int row = rowbase + 2 * t + rr;
            RowV x;
#pragma unroll
            for (int j = 0; j < 2; ++j) { const int col = 8 * F.lane + 512 * j;
                float a[8], b2[8]; unpack8(cx[rr][j], x.v[j]); unpack8(cy0[rr][j], a); unpack8(cy1[rr][j], b2);
#pragma unroll
                for (int i = 0; i < 8; ++i) x.v[j][i] += gt[j][i] * (a[i] + b2[i]);
                const u32x4 xr = pack8(x.v[j]);
                if (!F.dry) *(u32x4*)(xres + (size_t)row * DM + col) = xr;
                unpack8(xr, x.v[j]); }
            const float rinv = rsqrtf(row_sumsq(x) * (1.f / DM) + RMS_EPS);
#pragma unroll
            for (int j = 0; j < 2; ++j) { const int col = 8 * F.lane + 512 * j; float o[8];
#pragma unroll
                for (int i = 0; i < 8; ++i) o[i] = x.v[j][i] * rinv * gs[j][i] + sh[j][i];
                *(u32x4*)(h + (size_t)row * DM + col) = pack8(o); }
        }
    }
#undef N1_ISSUE
}
__device__ __forceinline__ void rows_norm1(const Ctx& F, int l) {
    if (l > 0) {
        norm1_span(F, l, 64 * F.bid + 8 * F.wave, 8, F.bid >> 6);
        if (F.gw < TOK - LAT_ROWS) norm1_span(F, l, LAT_ROWS + F.gw, 1, 4);
        return;
    }
    const float* mod = (const float*)(F.ws + WS_MOD);
    const bf16* ydn = (const bf16*)(F.ws + WS_YDN);
    bf16* xres = (bf16*)(F.ws + WS_XRES);
    bf16* h = (bf16*)(F.ws + WS_H);
    const float* g1 = KIN(6) + l * DM;
    constexpr int RR = 2;
    for (int row0 = F.gw; row0 < TOK; row0 += RR * F.NGW) {
        RowV x[RR]; u32x4 y0[RR][2], y1[RR][2];
#pragma unroll
        for (int rr = 0; rr < RR; ++rr) { int row = row0 + rr * F.NGW; row = row < TOK ? row : TOK - 1;
            ld_xrow(F, l, row, x[rr]);
            if (l > 0) {
#pragma unroll
                for (int j = 0; j < 2; ++j) { const int col = 8 * F.lane + 512 * j;
                    y0[rr][j] = *(const u32x4*)(ydn + (size_t)(2 * row) * DM + col); y1[rr][j] = *(const u32x4*)(ydn + (size_t)(2 * row + 1) * DM + col); } } }
#pragma unroll
        for (int rr = 0; rr < RR; ++rr) { const int row = row0 + rr * F.NGW; if (row >= TOK) break;
            const int mr = modrow_of(row);
            if (l > 0) {
                const float* g2 = mod + ((size_t)(l - 1) * 5 + mr) * NMOD + 5 * DM;
#pragma unroll
                for (int j = 0; j < 2; ++j) { const int col = 8 * F.lane + 512 * j;
                    float gv[8], a[8], b2[8]; ld8f(g2 + col, gv); unpack8(y0[rr][j], a); unpack8(y1[rr][j], b2);
#pragma unroll
                    for (int i = 0; i < 8; ++i) x[rr].v[j][i] += gv[i] * (a[i] + b2[i]);
                    if (!F.dry) *(u32x4*)(xres + (size_t)row * DM + col) = pack8(x[rr].v[j]);
                    unpack8(pack8(x[rr].v[j]), x[rr].v[j]); }
            }
            const float rinv = rsqrtf(row_sumsq(x[rr]) * (1.f / DM) + RMS_EPS);
            const float* mrow = mod + ((size_t)l * 5 + mr) * NMOD;
#pragma unroll
            for (int j = 0; j < 2; ++j) { const int col = 8 * F.lane + 512 * j;
                float gv[8], sh[8], scl[8], o[8]; ld8f(g1 + col, gv); ld8f(mrow + col, sh); ld8f(mrow + DM + col, scl);
#pragma unroll
                for (int i = 0; i < 8; ++i) o[i] = x[rr].v[j][i] * rinv * gv[i] * (1.f + scl[i]) + sh[i];
                *(u32x4*)(h + (size_t)row * DM + col) = pack8(o); }
        }
    }
}
__device__ __forceinline__ void build_router_tab(const Ctx& F, int l) {
    const float* mod = (const float*)(F.ws + WS_MOD) + (size_t)l * 5 * NMOD;
    const float* rt = (const float*)(F.ws + WS_RT) + (size_t)l * 36 * 1024;
    const float* g2w = KIN(7) + l * DM;
    bf16* tab = (bf16*)(F.ws + WS_RW);
    for (int i = F.bid * 512 + F.tid; i < 5 * 48 * 1024; i += F.G * 512) { const int c = i & 1023, n = (i >> 10) % 48, mr = i / (48 * 1024);
        float w = 0.f; if (n < 4) w = rt[n * 1024 + c]; else if (n >= 16) w = rt[(n - 12) * 1024 + c];
        const float v = g2w[c] * (1.f + mod[(size_t)mr * NMOD + 4 * DM + c]) * w;
        const unsigned hi = f2bf(v); const float lo = v - __builtin_bit_cast(float, hi << 16);
        tab[((size_t)mr * 2 + 0) * 48 * 1024 + n * 1024 + c] = (bf16)hi; tab[((size_t)mr * 2 + 1) * 48 * 1024 + n * 1024 + c] = (bf16)f2bf(lo); }
    float* rc = (float*)(F.ws + WS_RC);
    for (int d = F.gw; d < 5 * 36; d += F.NGW) { const int mr = d / 36, j = d % 36; float s = 0.f;
        for (int c = F.lane; c < 1024; c += 64) s += mod[(size_t)mr * NMOD + 3 * DM + c] * rt[j * 1024 + c];
        s = wave_sum(s); if (F.lane == 0) rc[d] = s + (j < 4 ? KIN(30)[l * 4 + j] : KIN(32)[l * 32 + j - 4]); }
}
template <int NT> struct RtOps { u32x4 av[NT][4]; bf16x8 wh[3][4], wl[3][4]; };
template <int NT>
__device__ __forceinline__ void rt_issue(const Ctx& F, const bf16* xres, int rowbase, int mr, RtOps<NT>& o) {
    const int r = F.lane & 15, fq = F.lane >> 4, k0 = F.wave * 128 + 8 * fq;
    const bf16* ap = xres + (size_t)(rowbase + r) * DM + k0;
    const bf16* bh = (const bf16*)(F.ws + WS_RW) + (size_t)mr * 2 * 48 * 1024 + (size_t)r * 1024 + k0; const bf16* bl = bh + 48 * 1024;
#pragma unroll
    for (int k2 = 0; k2 < 4; ++k2) { const int ko = k2 * 32;
#pragma unroll
        for (int t = 0; t < NT; ++t) o.av[t][k2] = *(const u32x4*)(ap + (size_t)t * 16 * DM + ko);
#pragma unroll
        for (int nt = 0; nt < 3; ++nt) { o.wh[nt][k2] = *(const bf16x8*)(bh + nt * 16 * 1024 + ko); o.wl[nt][k2] = *(const bf16x8*)(bl + nt * 16 * 1024 + ko); } }
    __builtin_amdgcn_sched_barrier(0);
}
template <int NT> struct RtAcc { f32x4 acc[NT][3]; float ssq[NT]; };
template <int NT>
__device__ __forceinline__ void rt_mma(const RtOps<NT>& o, RtAcc<NT>& A) {
    f32x4 (&acc)[NT][3] = A.acc; float (&ssq)[NT] = A.ssq;
#pragma unroll
    for (int t = 0; t < NT; ++t) { ssq[t] = 0.f;
#pragma unroll
        for (int nt = 0; nt < 3; ++nt) acc[t][nt] = (f32x4){0.f, 0.f, 0.f, 0.f}; }
#pragma unroll
    for (int k2 = 0; k2 < 4; ++k2)
#pragma unroll
        for (int t = 0; t < NT; ++t) { const bf16x8 a = __builtin_bit_cast(bf16x8, o.av[t][k2]);
#pragma unroll
            for (int nt = 0; nt < 3; ++nt) { acc[t][nt] = __builtin_amdgcn_mfma_f32_16x16x32_bf16(o.wh[nt][k2], a, acc[t][nt], 0, 0, 0);
                acc[t][nt] = __builtin_amdgcn_mfma_f32_16x16x32_bf16(o.wl[nt][k2], a, acc[t][nt], 0, 0, 0); }
            float xf[8]; unpack8(o.av[t][k2], xf); ssq[t] += sumsq8(xf); }
    __builtin_amdgcn_sched_barrier(0);
}
template <int NT>
__device__ __forceinline__ void rt_select(const Ctx& F, const RtAcc<NT>& A, int rowbase, int mr, LAS unsigned* lcnt, float* gatew,
                                          int& ea, int& eb, unsigned& ra, unsigned& rb, int& myrow) {
    const int r = F.lane & 15, fq = F.lane >> 4;
    const f32x4 (&acc)[NT][3] = A.acc; const float (&ssq)[NT] = A.ssq;
    constexpr int WSTR = NT * 768 + NT * 64;
    LAS float* pl = (LAS float*)F.lds + F.wave * WSTR;
#pragma unroll
    for (int t = 0; t < NT; ++t) {
#pragma unroll
        for (int nt = 0; nt < 3; ++nt) *(LAS f32x4*)(pl + (t * 16 + r) * 48 + nt * 16 + 4 * fq) = acc[t][nt];
        pl[NT * 768 + t * 64 + fq * 16 + r] = ssq[t]; }
    __syncthreads();
    if (F.tid < NT * 16) { const int t = F.tid >> 4, rr = F.tid & 15, row = rowbase + F.tid;
        const LAS float* base = (const LAS float*)F.lds;
        float s = 0.f;
#pragma unroll
        for (int w = 0; w < 8; ++w)
#pragma unroll
            for (int f = 0; f < 4; ++f) s += base[w * WSTR + NT * 768 + t * 64 + f * 16 + rr];
        const float rinv = rsqrtf(s * (1.f / DM) + RMS_EPS);
        const float* rc = (const float*)(F.ws + WS_RC) + mr * 36;
        const LAS float* lrow = base + (t * 16 + rr) * 48;
        float l1[4];
#pragma unroll
        for (int i = 0; i < 4; ++i) { float v = 0.f;
#pragma unroll
            for (int w = 0; w < 8; ++w) v += lrow[w * WSTR + i];
            l1[i] = v * rinv + rc[i]; }
        int grp = 0; float best = l1[0];
#pragma unroll
        for (int i = 1; i < 4; ++i) if (l1[i] > best) { best = l1[i]; grp = i; }
        float den = 0.f;
#pragma unroll
        for (int i = 0; i < 4; ++i) den += __expf(l1[i] - best);
        const float pgrp = 1.f / den;
        float l2[8];
#pragma unroll
        for (int q = 0; q < 8; ++q) { float v = 0.f;
#pragma unroll
            for (int w = 0; w < 8; ++w) v += lrow[w * WSTR + 16 + grp * 8 + q];
            l2[q] = v * rinv + rc[4 + grp * 8 + q]; }
        int i0 = 0; float v0 = l2[0];
#pragma unroll
        for (int i = 1; i < 8; ++i) if (l2[i] > v0) { v0 = l2[i]; i0 = i; }
        int i1 = -1; float v1 = -3.0e38f;
#pragma unroll
        for (int i = 0; i < 8; ++i) if (i != i0 && l2[i] > v1) { v1 = l2[i]; i1 = i; }
        const float e1 = __expf(v1 - v0), w0 = 1.f / (1.f + e1), w1 = e1 * w0;
        ea = grp * 8 + i0; eb = grp * 8 + i1; myrow = row;
        ra = __hip_atomic_fetch_add(&lcnt[ea], 1u, __ATOMIC_RELAXED, __HIP_MEMORY_SCOPE_WORKGROUP);
        rb = __hip_atomic_fetch_add(&lcnt[eb], 1u, __ATOMIC_RELAXED, __HIP_MEMORY_SCOPE_WORKGROUP);
        gatew[row * 2] = pgrp * w0; gatew[row * 2 + 1] = pgrp * w1;
    }
    __syncthreads();
}
__device__ __forceinline__ void rows_norm2_router(const Ctx& F, int l) {
    const float* mod = (const float*)(F.ws + WS_MOD);
    const bf16* xres = (const bf16*)(F.ws + WS_XRES);
    bf16* gb = (bf16*)(F.ws + WS_H);
    const float* g2w = KIN(7) + l * DM;
    LAS unsigned* lcnt = (LAS unsigned*)(F.lds + MISC_OFF + 1024); LAS unsigned* lbase = lcnt + 32;
    if (F.tid < 64) lcnt[F.tid] = 0u;
    __syncthreads();
    unsigned* cnt = (unsigned*)(F.ws + WS_CTL) + CW_CNT + l * 64 + (F.dry ? 8192 : 0);
    int* list = (int*)(F.ws + (F.dry ? WS_E2 : WS_LIST));
    float* gatew = (float*)(F.ws + (F.dry ? WS_E2 + 4 * MiB : WS_GATEW));
    const int nrows = (l == DEPTH - 1) ? LAT_ROWS : TOK;
    int ea = 0, eb = 0, myrow = -1, ea2 = 0, eb2 = 0, myrow2 = -1; unsigned ra = 0u, rb = 0u, ra2 = 0u, rb2 = 0u;
    { const bool hasctx = l < DEPTH - 1 && F.bid < 64;
      RtOps<4> o4; rt_issue<4>(F, xres, 64 * F.bid, F.bid >> 6, o4);
      RtAcc<4> a4; rt_mma<4>(o4, a4);
      RtOps<1> o1;
      if (hasctx) rt_issue<1>(F, xres, LAT_ROWS + 16 * F.bid, 4, o1);
      rt_select<4>(F, a4, 64 * F.bid, F.bid >> 6, lcnt, gatew, ea, eb, ra, rb, myrow);
      if (hasctx) { RtAcc<1> a1; rt_mma<1>(o1, a1); rt_select<1>(F, a1, LAT_ROWS + 16 * F.bid, 4, lcnt, gatew, ea2, eb2, ra2, rb2, myrow2); } }
    unsigned rbase = 0u;
    if (F.tid < 32) { const unsigned n = lcnt[F.tid]; rbase = n ? atomicAdd(&cnt[F.tid], n) : 0u; }
    {
        float gs[2][8], sh[2][8];
        { const float* mrow = mod + ((size_t)l * 5 + (F.bid >> 6)) * NMOD;
#pragma unroll
          for (int j = 0; j < 2; ++j) { const int col = 8 * F.lane + 512 * j; float gv[8], scl[8]; ld8f(g2w + col, gv); ld8f(mrow + 4 * DM + col, scl); ld8f(mrow + 3 * DM + col, sh[j]);
#pragma unroll
              for (int i = 0; i < 8; ++i) gs[j][i] = gv[i] * (1.f + scl[i]); } }
        const bf16* rp = xres + (size_t)(64 * F.bid + 8 * F.wave) * DM + 8 * F.lane;
        u32x4 nx[2][2];
#pragma unroll
        for (int rr = 0; rr < 2; ++rr)
#pragma unroll
            for (int j = 0; j < 2; ++j) nx[rr][j] = *(const u32x4*)(rp + (size_t)rr * DM + 512 * j);
#pragma unroll
        for (int trip = 0; trip < 4; ++trip) {
            RowV xx[2];
#pragma unroll
            for (int rr = 0; rr < 2; ++rr)
#pragma unroll
                for (int j = 0; j < 2; ++j) unpack8(nx[rr][j], xx[rr].v[j]);
            if (trip < 3) {
#pragma unroll
                for (int rr = 0; rr < 2; ++rr)
#pragma unroll
                    for (int j = 0; j < 2; ++j) nx[rr][j] = *(const u32x4*)(rp + (size_t)(2 * trip + 2 + rr) * DM + 512 * j); }
#pragma unroll
            for (int rr = 0; rr < 2; ++rr) { const int row = 64 * F.bid + 8 * F.wave + 2 * trip + rr;
                RowV& x = xx[rr];
                const float rinv = rsqrtf(row_sumsq(x) * (1.f / DM) + RMS_EPS);
#pragma unroll
                for (int j = 0; j < 2; ++j) { const int col = 8 * F.lane + 512 * j;
#pragma unroll
                    for (int i = 0; i < 8; ++i) x.v[j][i] = x.v[j][i] * rinv * gs[j][i] + sh[j][i];
                    *(u32x4*)(gb + (size_t)row * DM + col) = pack8(x.v[j]); }
            }
        }
    }
    if (l < DEPTH - 1 && F.gw >= F.NGW - (TOK - LAT_ROWS)) {
        const int row = LAT_ROWS + F.gw - (F.NGW - (TOK - LAT_ROWS));
        RowV x; ld_row_bf16(xres + (size_t)row * DM, F.lane, x);
        const float rinv = rsqrtf(row_sumsq(x) * (1.f / DM) + RMS_EPS);
        const float* mrow = mod + ((size_t)l * 5 + 4) * NMOD;
#pragma unroll
        for (int j = 0; j < 2; ++j) { const int col = 8 * F.lane + 512 * j;
            float gv[8], shv[8], scl[8]; ld8f(g2w + col, gv); ld8f(mrow + 3 * DM + col, shv); ld8f(mrow + 4 * DM + col, scl);
#pragma unroll
            for (int i = 0; i < 8; ++i) x.v[j][i] = x.v[j][i] * rinv * (gv[i] * (1.f + scl[i])) + shv[i];
            *(u32x4*)(gb + (size_t)row * DM + col) = pack8(x.v[j]); }
    }
    if (F.tid < 32) lbase[F.tid] = rbase;
    __syncthreads();
    if (myrow >= 0) { list[(size_t)ea * LIST_CAP + lbase[ea] + ra] = myrow * 2; list[(size_t)eb * LIST_CAP + lbase[eb] + rb] = myrow * 2 + 1; }
    if (myrow2 >= 0) { list[(size_t)ea2 * LIST_CAP + lbase[ea2] + ra2] = myrow2 * 2; list[(size_t)eb2 * LIST_CAP + lbase[eb2] + rb2] = myrow2 * 2 + 1; }
    __syncthreads();
}
__device__ __forceinline__ void rows_mla_pre(const Ctx& F, int i) {
    const bf16* z = (const bf16*)(F.ws + WS_ZRAW); bf16* ac = (bf16*)(F.ws + WS_ACAT);
    const float* gq = KIN(19) + i * 256; const float* gkv = KIN(21) + i * 128;
    const f32x4 gv = *(const f32x4*)(gq + 4 * F.lane);
    f32x4 gk = (f32x4){0.f, 0.f, 0.f, 0.f}; if (F.lane < 32) gk = *(const f32x4*)(gkv + 4 * F.lane);
    u32x2 nq = (u32x2){0u, 0u}, nk = (u32x2){0u, 0u};
    if (F.gw < TOK) { nq = *(const u32x2*)(z + (size_t)F.gw * 1024 + 512 + 4 * F.lane); if (F.lane < 32) nk = *(const u32x2*)(z + (size_t)F.gw * 1024 + 768 + 4 * F.lane); }
    for (int row = F.gw; row < TOK; row += F.NGW) {
        const u32x2 qv = nq, kv = nk;
        if (row + F.NGW < TOK) { nq = *(const u32x2*)(z + (size_t)(row + F.NGW) * 1024 + 512 + 4 * F.lane); if (F.lane < 32) nk = *(const u32x2*)(z + (size_t)(row + F.NGW) * 1024 + 768 + 4 * F.lane); }
        const float q0 = bflo(qv.x), q1 = bfhi(qv.x), q2 = bflo(qv.y), q3 = bfhi(qv.y);
        const float rq = rsqrtf(wave_sum(q0 * q0 + q1 * q1 + q2 * q2 + q3 * q3) * (1.f / 256.f) + RMS_EPS);
        u32x2 w; w.x = pk2(q0 * rq * gv[0], q1 * rq * gv[1]); w.y = pk2(q2 * rq * gv[2], q3 * rq * gv[3]);
        *(u32x2*)(ac + (size_t)row * 512 + 4 * F.lane) = w;
        float k0 = 0.f, k1 = 0.f, k2 = 0.f, k3 = 0.f;
        if (F.lane < 32) { k0 = bflo(kv.x); k1 = bfhi(kv.x); k2 = bflo(kv.y); k3 = bfhi(kv.y); }
        const float rk = rsqrtf(wave_sum(k0 * k0 + k1 * k1 + k2 * k2 + k3 * k3) * (1.f / 128.f) + RMS_EPS);
        u32x2 w2 = (u32x2){0u, 0u};
        if (F.lane < 32) { w2.x = pk2(k0 * rk * gk[0], k1 * rk * gk[1]); w2.y = pk2(k2 * rk * gk[2], k3 * rk * gk[3]); }
        *(u32x2*)(ac + (size_t)row * 512 + 256 + 4 * F.lane) = w2;
    }
}
__device__ __forceinline__ void rows_mla_post(const Ctx& F, int i) {
    const bf16* qk = (const bf16*)(F.ws + WS_QKVM); const bf16* z = (const bf16*)(F.ws + WS_ZRAW);
    bf16* Qb = (bf16*)(F.ws + WS_QB); bf16* Kb = (bf16*)(F.ws + WS_KB); bf16* Vb = (bf16*)(F.ws + WS_VB);
    const float* qn = KIN(23) + i * 96; const float* kn = KIN(24) + i * 96;
    const float* rope = (const float*)(F.ws + WS_ROPE) + ROPE32_OFF;
    const int lane = F.lane, s = lane & 15, hq = lane >> 4, a = s & 1;
    const bool is_nope = s < 8, is_rope = (s == 8 || s == 9), is_zero = (s >= 10 && s < 14);
    const int d1 = is_nope ? 8 * s : 64 + a * 16, d2 = 64 + a * 16 + 8;
    float wq1[8], wq2[8], wk1[8], wk2[8];
#pragma unroll
    for (int j = 0; j < 8; ++j) { wq1[j] = qn[d1 + j]; wq2[j] = qn[d2 + j]; wk1[j] = kn[d1 + j]; wk2[j] = kn[d2 + j]; }
    constexpr int RR = 1;
    u32x4 nq1[2], nq2[2], nk1[2], nkr1, nkr2, nvv;
#define POST_LOAD(rowi) do { unsigned z0_ = 0u; asm volatile("" : "+v"(z0_)); const u32x4 zz_ = (u32x4){z0_, z0_, z0_, z0_}; \
        const bf16* qr_ = qk + (size_t)(rowi) * 1792; const bf16* kr_ = z + (size_t)(rowi) * 1024 + 896; \
        _Pragma("unroll") for (int p2 = 0; p2 < 2; ++p2) { const int hd_ = 4 * p2 + hq; \
            nq1[p2] = (is_nope || is_rope) ? *(const u32x4*)(qr_ + 96 * hd_ + d1) : zz_; \
            nq2[p2] = is_rope ? *(const u32x4*)(qr_ + 96 * hd_ + d2) : zz_; \
            nk1[p2] = is_nope ? *(const u32x4*)(qr_ + 768 + hd_ * 128 + 8 * s) : zz_; } \
        nkr1 = is_rope ? *(const u32x4*)(kr_ + a * 16) : zz_; nkr2 = is_rope ? *(const u32x4*)(kr_ + a * 16 + 8) : zz_; \
        nvv = *(const u32x4*)(qr_ + 768 + (lane >> 3) * 128 + 64 + 8 * (lane & 7)); } while (0)
    if (F.gw < TOK) POST_LOAD(F.gw);
    for (int row0 = F.gw; row0 < TOK; row0 += RR * F.NGW) {
        unsigned z0 = 0u; asm volatile("" : "+v"(z0)); const u32x4 zero4 = (u32x4){z0, z0, z0, z0};
        u32x4 q1[RR][2], q2[RR][2], k1[RR][2], kr1[RR], kr2[RR], vv[RR];
#pragma unroll
        for (int p2 = 0; p2 < 2; ++p2) { q1[0][p2] = nq1[p2]; q2[0][p2] = nq2[p2]; k1[0][p2] = nk1[p2]; }
        kr1[0] = nkr1; kr2[0] = nkr2; vv[0] = nvv;
        if (row0 + F.NGW < TOK) POST_LOAD(row0 + F.NGW);
#pragma unroll
        for (int rr = 0; rr < RR; ++rr) { const int row = row0 + rr * F.NGW; if (row >= TOK) break;
            int b, pos, pa = 0; const bool lat = row < LAT_ROWS;
            if (lat) { b = row >> 12; const int t = row & 4095; pos = 256 + t; pa = a == 0 ? (t >> 6) : (t & 63); }
            else { b = (row - LAT_ROWS) >> 8; pos = (row - LAT_ROWS) & 255; }
            const float* csn = rope + (pa * 8) * 2;
#pragma unroll
            for (int p2 = 0; p2 < 2; ++p2) { const int hd = 4 * p2 + hq; const size_t obase = ((size_t)(b * 8 + hd) * SKV + pos) * 128;
                { float x1[8], x2[8]; unpack8(q1[rr][p2], x1); unpack8(q2[rr][p2], x2);
                  const float rinv = rsqrtf(group16_sum(sumsq8(x1) + sumsq8(x2)) * (1.f / 96.f) + RMS_EPS);
                  u32x4 o1, o2; norm_rope8(x1, x2, rinv, wq1, wq2, csn, is_rope && lat, o1, o2);
                  if (is_nope) *(u32x4*)(Qb + obase + 8 * s) = o1;
                  else if (is_rope) { *(u32x4*)(Qb + obase + d1) = o1; *(u32x4*)(Qb + obase + d2) = o2; }
                  else if (is_zero) *(u32x4*)(Qb + obase + 96 + 8 * (s - 10)) = zero4; }
                { float x1[8], x2[8]; unpack8(is_rope ? kr1[rr] : k1[rr][p2], x1); unpack8(kr2[rr], x2);
                  const float rinv = rsqrtf(group16_sum(sumsq8(x1) + sumsq8(x2)) * (1.f / 96.f) + RMS_EPS);
                  u32x4 o1, o2; norm_rope8(x1, x2, rinv, wk1, wk2, csn, is_rope && lat, o1, o2);
                  if (is_nope) *(u32x4*)(Kb + obase + 8 * s) = o1;
                  else if (is_rope) { *(u32x4*)(Kb + obase + d1) = o1; *(u32x4*)(Kb + obase + d2) = o2; }
                  else if (is_zero) *(u32x4*)(Kb + obase + 96 + 8 * (s - 10)) = zero4; }
            }
            *(u32x4*)(Vb + ((size_t)(b * 8 + (lane >> 3)) * SKV + pos) * 64 + 8 * (lane & 7)) = vv[rr];
        }
    }
}
#undef POST_LOAD
__device__ __forceinline__ void rows_gqa_post(const Ctx& F, int i) {
    const bf16* z = (const bf16*)(F.ws + WS_ZRAW);
    bf16* Qb = (bf16*)(F.ws + WS_QB); bf16* Kb = (bf16*)(F.ws + WS_KB); bf16* Vb = (bf16*)(F.ws + WS_VB);
    const float* qn = KIN(27) + i * 128; const float* kn = KIN(28) + i * 128;
    const float* rope = (const float*)(F.ws + WS_ROPE);
    const int lane = F.lane, hh = lane >> 3, sub = lane & 7, a = sub >> 2, fc = sub & 3;
    const int d1 = a * 64 + 8 * fc, d2 = d1 + 32;
    float wq1[8], wq2[8], wk1[8], wk2[8];
#pragma unroll
    for (int j = 0; j < 8; ++j) { wq1[j] = qn[d1 + j]; wq2[j] = qn[d2 + j]; wk1[j] = kn[d1 + j]; wk2[j] = kn[d2 + j]; }
    const bool isk = lane < 32; const int l2 = lane - 32;
    constexpr int RR = 1;
    for (int row0 = F.gw; row0 < TOK; row0 += RR * F.NGW) {
        u32x4 q1[RR], q2[RR], s1[RR], s2[RR];
#pragma unroll
        for (int rr = 0; rr < RR; ++rr) { int row = row0 + rr * F.NGW; row = row < TOK ? row : TOK - 1;
            const bf16* r = z + (size_t)row * 2048;
            q1[rr] = *(const u32x4*)(r + hh * 128 + d1); q2[rr] = *(const u32x4*)(r + hh * 128 + d2);
            s1[rr] = *(const u32x4*)(isk ? r + 1024 + hh * 128 + d1 : r + 1536 + 16 * l2); s2[rr] = *(const u32x4*)(isk ? r + 1024 + hh * 128 + d2 : r + 1536 + 16 * l2 + 8); }
#pragma unroll
        for (int rr = 0; rr < RR; ++rr) { const int row = row0 + rr * F.NGW; if (row >= TOK) break;
            int b, pos, pa = 0; const bool lat = row < LAT_ROWS;
            if (lat) { b = row >> 12; const int t = row & 4095; pos = 256 + t; pa = a == 0 ? (t >> 6) : (t & 63); }
            else { b = (row - LAT_ROWS) >> 8; pos = (row - LAT_ROWS) & 255; }
            const float* csn = rope + (pa * 32 + 8 * fc) * 2;
            { float x1[8], x2[8]; unpack8(q1[rr], x1); unpack8(q2[rr], x2);
              const float rinv = rsqrtf(group8_sum(sumsq8(x1) + sumsq8(x2)) * (1.f / 128.f) + RMS_EPS);
              u32x4 o1, o2; norm_rope8(x1, x2, rinv, wq1, wq2, csn, lat, o1, o2);
              bf16* o = Qb + ((size_t)(b * 8 + hh) * SKV + pos) * 128; *(u32x4*)(o + d1) = o1; *(u32x4*)(o + d2) = o2; }
            { float x1[8], x2[8]; unpack8(s1[rr], x1); unpack8(s2[rr], x2);
              const float rinv = rsqrtf(group8_sum(sumsq8(x1) + sumsq8(x2)) * (1.f / 128.f) + RMS_EPS);
              u32x4 o1, o2; norm_rope8(x1, x2, rinv, wk1, wk2, csn, lat, o1, o2);
              if (isk) { bf16* o = Kb + ((size_t)(b * 4 + hh) * SKV + pos) * 128; *(u32x4*)(o + d1) = o1; *(u32x4*)(o + d2) = o2; }
              else { bf16* o = Vb + ((size_t)(b * 4 + (l2 >> 3)) * SKV + pos) * 128 + 16 * (l2 & 7); *(u32x4*)(o) = s1[rr]; *(u32x4*)(o + 8) = s2[rr]; } }
        }
    }
}
__device__ __forceinline__ void rows_final(const Ctx& F) {
    const float* mod = (const float*)(F.ws + WS_MOD); const bf16* ydn = (const bf16*)(F.ws + WS_YDN); const bf16* xres = (const bf16*)(F.ws + WS_XRES);
#pragma unroll 2
    for (int row = F.gw; row < LAT_ROWS; row += F.NGW) {
        const float* g2 = mod + ((size_t)(DEPTH - 1) * 5 + (row >> 12)) * NMOD + 5 * DM;
        RowV x; ld_row_bf16(xres + (size_t)row * DM, F.lane, x);
#pragma unroll
        for (int j = 0; j < 2; ++j) { const int col = 8 * F.lane + 512 * j;
            float gv[8], a[8], b2[8]; ld8f(g2 + col, gv);
            unpack8(*(const u32x4*)(ydn + (size_t)(2 * row) * DM + col), a); unpack8(*(const u32x4*)(ydn + (size_t)(2 * row + 1) * DM + col), b2);
            f32x4 o0, o1;
#pragma unroll
            for (int i = 0; i < 4; ++i) { o0[i] = x.v[j][i] + gv[i] * (a[i] + b2[i]); o1[i] = x.v[j][4 + i] + gv[4 + i] * (a[4 + i] + b2[4 + i]); }
            *(f32x4*)(F.out + (size_t)row * DM + col) = o0; *(f32x4*)(F.out + (size_t)row * DM + col + 4) = o1; }
    }
}
#define XB_TMO      128
#define XB_XCNT(j)  (256  + 64 * (j))
#define XB_XSUB(j)  (1280 + 64 * (j))
#define XB_XGEN(j)  (2304 + 64 * (j))
#define XB_TOP      3328
#define XB_TOPGEN   3392
#define XCD_BAR_WORDS 3456
#define XB_SPIN_CAP (1u << 22)
__device__ __forceinline__ unsigned xb_ld(unsigned* p)              { return __hip_atomic_load(p, __ATOMIC_RELAXED, __HIP_MEMORY_SCOPE_AGENT); }
__device__ __forceinline__ unsigned xb_add(unsigned* p, unsigned v) { return __hip_atomic_fetch_add(p, v, __ATOMIC_RELAXED, __HIP_MEMORY_SCOPE_AGENT); }
__device__ __forceinline__ unsigned xb_xcc_id() { return (unsigned)__builtin_amdgcn_s_getreg((3 << 11) | 20) & 0xFu; }
#define XB_SPIN(cond, bar) do { unsigned _sp = 0; while (cond) { __builtin_amdgcn_s_sleep(1); \
    if ((++_sp & 255u) == 0u) { if (xb_ld(&(bar)[XB_TMO])) break; if (_sp > XB_SPIN_CAP) { atomicAdd(&(bar)[XB_TMO], 1u); break; } } } } while (0)
struct XcdBarrier { unsigned* bar; unsigned x; volatile LAS unsigned* st; };
__device__ __forceinline__ XcdBarrier xcd_barrier_post(unsigned* bar, volatile LAS unsigned* st) {
    XcdBarrier b; b.bar = bar; b.x = xb_xcc_id(); b.st = st;
    if (threadIdx.x == 0) (void)xb_add(&bar[XB_XCNT(b.x)], 1u);
    return b;
}
__device__ __forceinline__ void xcd_barrier_complete(unsigned* bar, unsigned x, unsigned& nloc, unsigned& nx) {
    const unsigned G = gridDim.x * gridDim.y * gridDim.z;
    unsigned sum, cnt, mine, sp = 0u;
    for (;;) {
        sum = 0u; cnt = 0u; mine = 0u;
#pragma unroll
        for (unsigned j = 0; j < 16; ++j) { const unsigned c = xb_ld(&bar[XB_XCNT(j)]); sum += c; cnt += (c > 0u) ? 1u : 0u; mine = (j == x) ? c : mine; }
        if (sum == G) break;
        __builtin_amdgcn_s_sleep(1);
        if ((++sp & 255u) == 0u) { if (xb_ld(&bar[XB_TMO])) break; if (sp > XB_SPIN_CAP) { atomicAdd(&bar[XB_TMO], 1u); break; } }
    }
    nloc = mine > 0u ? mine : 1u; nx = cnt > 0u ? cnt : 1u;
}
__device__ __forceinline__ void xcd_barrier(const XcdBarrier& b) {
    asm volatile("s_waitcnt vmcnt(0)" ::: "memory");
    __syncthreads();
    if (threadIdx.x == 0) {
        unsigned* bar = b.bar;
        __builtin_amdgcn_s_waitcnt(0);
        unsigned nloc = b.st[0], nx = b.st[1];
        if (nloc == 0u) { xcd_barrier_complete(bar, b.x, nloc, nx); b.st[0] = nloc; b.st[1] = nx; }
        const unsigned old = xb_add(&bar[XB_XSUB(b.x)], 1u);
        const unsigned gen = old / nloc;
        if (old + 1u == (gen + 1u) * nloc) {
            __builtin_amdgcn_fence(__ATOMIC_RELEASE, "agent");
            asm volatile("s_waitcnt vmcnt(0)" ::: "memory");
            const unsigned og = xb_add(&bar[XB_TOP], 1u);
            const unsigned tg = og / nx;
            if (og + 1u == (tg + 1u) * nx) xb_add(&bar[XB_TOPGEN], 1u);
            else XB_SPIN(xb_ld(&bar[XB_TOPGEN]) == tg, bar);
            __builtin_amdgcn_fence(__ATOMIC_ACQUIRE, "agent");
            xb_add(&bar[XB_XGEN(b.x)], 1u);
            asm volatile("s_waitcnt vmcnt(0)" ::: "memory");
        } else {
            XB_SPIN(xb_ld(&bar[XB_XGEN(b.x)]) == gen, bar);
            __builtin_amdgcn_fence(__ATOMIC_ACQUIRE, "agent");
            asm volatile("s_waitcnt vmcnt(0)" ::: "memory");
        }
    }
    __syncthreads();
}

constexpr int NPH = 1 + 2 * 9 + 2 * 7 + 1;
constexpr int G_NONE = -1;
using pg8::G_INPROJ; using pg8::G_MLA; using pg8::G_GLU; using pg8::G_OUT; using pg8::G_QKV; using pg8::G_MOE1; using pg8::G_MOE2;
enum { K_NONE = 0, K_NORM1, K_MLA_PRE_S5A, K_MLA_POST, K_S5B_ATT, K_NORM2, K_GQA_POST, K_ATT_GQA };

__device__ __forceinline__ void attention_phase(const Ctx& F, int l, bool even) {
    const bf16* Qb = (const bf16*)(F.ws + WS_QB); const bf16* Kb = (const bf16*)(F.ws + WS_KB); const bf16* Vb = (const bf16*)(F.ws + WS_VB);
    bf16* mix = (bf16*)(F.ws + WS_MIX);
    const int c = F.bid, x = c & 7, slot = c >> 3;
    const int nround = (l == DEPTH - 1) ? 2 : 3;
    for (int round = 0; round < nround; ++round) {
        int b, h, qb; bool ctxu = false;
        if (round < 2) {
            if (even) { const int pair = round * 16 + x * 2 + (slot >> 4); b = pair >> 3; h = pair & 7; qb = slot & 15; }
            else { const int pair = round * 8 + x; b = pair >> 2; h = (pair & 3) * 2 + (slot >> 4); qb = slot & 15; }
        } else { if (c >= 32) break; b = c >> 3; h = c & 7; qb = 0; ctxu = true; }
        const size_t qrow = (size_t)(b * 8 + h) * SKV + (ctxu ? 0 : 256 + qb * 256);
        const int orow = ctxu ? LAT_ROWS + b * 256 : b * 4096 + qb * 256;
        const int seq = ctxu ? CTXL : SKV;
        if (even) {
            att::attn_dense_body<64, 1, 1024, 96>(Qb + qrow * 128, Kb + (size_t)(b * 8 + h) * SKV * 128, Vb + (size_t)(b * 8 + h) * SKV * 64,
                                              mix + (size_t)orow * 1024 + 512 + h * 64, seq, (char*)F.lds, F.tid);
        } else {
            const int kvh = h >> 1;
            att::attn_dense_body<128, 0, 1024, 128>(Qb + qrow * 128, Kb + (size_t)(b * 4 + kvh) * SKV * 128, Vb + (size_t)(b * 4 + kvh) * SKV * 128,
                                               mix + (size_t)orow * 1024 + h * 128, seq, (char*)F.lds, F.tid);
        }
    }
}


#ifdef DBG_CHECKS
constexpr int CW_FLAGS = 20000;
__device__ __forceinline__ void dbg_flag(const Ctx& F, int j) { atomicOr((unsigned*)(F.ws + WS_CTL) + CW_FLAGS, 1u << j); }
__device__ __forceinline__ void dbg_moe_check(const Ctx& F, int l) {
    const unsigned* cnt = (const unsigned*)(F.ws + WS_CTL) + CW_CNT + l * 64; const int* list = (const int*)(F.ws + WS_LIST);
    const bf16* g = (const bf16*)(F.ws + WS_H); const bf16* act = (const bf16*)(F.ws + WS_ACT); const bf16* ydn = (const bf16*)(F.ws + WS_YDN);
    const float* gatew = (const float*)(F.ws + WS_GATEW);
    for (int s = F.gw; s < 96; s += F.NGW) {
        const int e = s & 31, which = s >> 5; const int c = (int)cnt[e]; if (c == 0) continue;
        const int pos = which == 0 ? 0 : (which == 1 ? c - 1 : (c > 300 ? 300 : c / 2));
        const int ent = list[(size_t)e * LIST_CAP + pos], row = ent >> 1;
        const float* wg = KIN(33) + ((size_t)l * 32 + e) * 1024 * 512; const float* wu = KIN(34) + ((size_t)l * 32 + e) * 1024 * 512; const float* wd = KIN(35) + ((size_t)l * 32 + e) * 512 * 1024;
        float h1[8], h2[8];
        for (int j = 0; j < 8; ++j) { h1[j] = 0.f; h2[j] = 0.f; }
        for (int k = 0; k < 1024; ++k) { const float gv = bf2f(g[(size_t)row * 1024 + k]);
            for (int j = 0; j < 8; ++j) { h1[j] += gv * wg[(size_t)k * 512 + F.lane + 64 * j]; h2[j] += gv * wu[(size_t)k * 512 + F.lane + 64 * j]; } }
        float err = 0.f, ss = 0.f;
        for (int j = 0; j < 8; ++j) { const float r = siluf_(h1[j]) * h2[j]; const float a = bf2f(act[(size_t)ent * 512 + F.lane + 64 * j]); err = fmaxf(err, fabsf(a - r)); ss += r * r; }
        err = wave_max(err); ss = wave_sum(ss);
        if (!(err <= 0.1f * __builtin_amdgcn_sqrtf(ss / 512.f) + 1e-6f)) { if (F.lane == 0) dbg_flag(F, 0); }
        float y[16];
        for (int j = 0; j < 16; ++j) y[j] = 0.f;
        for (int f = 0; f < 512; ++f) { const float av = bf2f(act[(size_t)ent * 512 + f]);
            for (int j = 0; j < 16; ++j) y[j] += av * wd[(size_t)f * 1024 + F.lane + 64 * j]; }
        const float gw = gatew[ent]; float err2 = 0.f, ss2 = 0.f;
        for (int j = 0; j < 16; ++j) { const float r = y[j] * gw; const float a = bf2f(ydn[(size_t)ent * 1024 + F.lane + 64 * j]); err2 = fmaxf(err2, fabsf(a - r)); ss2 += r * r; }
        err2 = wave_max(err2); ss2 = wave_sum(ss2);
        if (!(err2 <= 0.1f * __builtin_amdgcn_sqrtf(ss2 / 1024.f) + 1e-6f)) { if (F.lane == 0) dbg_flag(F, 1); }
        else if (ss2 > 1e-8f && ss > 1e-8f && F.lane == 0) dbg_flag(F, 3);
    }
}
__device__ __forceinline__ void dbg_mod_check(const Ctx& F, int l) {
    const float* mod = (const float*)(F.ws + WS_MOD);
    for (int s = F.gw; s < 60; s += F.NGW) {
        const int r = s % 5, n = (s * 509 + 77) % 6144;
        float ser = 0.f;
        for (int k = 0; k < 1024; ++k) { const float cv = r < 4 ? KIN(1)[r * 1024 + k] : KIN(3)[k]; ser += siluf_(cv) * KIN(4)[((size_t)l * 1024 + k) * 6144 + n]; }
        ser += KIN(5)[l * 6144 + n];
        float acc = 0.f;
        for (int k = F.lane; k < 1024; k += 64) { const float cv = r < 4 ? KIN(1)[r * 1024 + k] : KIN(3)[k]; acc += siluf_(cv) * KIN(4)[((size_t)l * 1024 + k) * 6144 + n]; }
        acc = wave_sum(acc) + KIN(5)[l * 6144 + n];
        const float got = mod[((size_t)l * 5 + r) * 6144 + n];
        if (!(fabsf(got - ser) <= 1e-3f + 1e-3f * fabsf(ser))) { if (F.lane == 0) dbg_flag(F, 0); }
        if (!(fabsf(acc - ser) <= 1e-3f + 1e-3f * fabsf(ser))) { if (F.lane == 0) dbg_flag(F, 1); }
    }
    return;
    const float* xres = (const float*)(F.ws + WS_XRES); const unsigned* cnt = (const unsigned*)(F.ws + WS_CTL) + CW_CNT + l * 64; const int* list = (const int*)(F.ws + WS_LIST);
    const float* gatew = (const float*)(F.ws + WS_GATEW); const bf16* gb = (const bf16*)(F.ws + WS_H);
    for (int s = F.gw; s < 64; s += F.NGW) {
        const int row = (s * 263 + 11) % TOK; const int mr = modrow_of(row);
        float ssq = 0.f;
        for (int k = F.lane; k < 1024; k += 64) { const float v = xres[(size_t)row * 1024 + k]; ssq += v * v; }
        const float rinv = rsqrtf(wave_sum(ssq) / 1024.f + 1e-6f);
        float lg[36];
#pragma unroll
        for (int j = 0; j < 36; ++j) lg[j] = 0.f;
        float gerr = 0.f;
        for (int k = F.lane; k < 1024; k += 64) {
            const float gv = xres[(size_t)row * 1024 + k] * rinv * KIN(7)[l * 1024 + k] * (1.f + mod[((size_t)l * 5 + mr) * 6144 + 4096 + k]) + mod[((size_t)l * 5 + mr) * 6144 + 3072 + k];
            gerr = fmaxf(gerr, fabsf(bf2f(gb[(size_t)row * 1024 + k]) - gv));
#pragma unroll
            for (int j = 0; j < 4; ++j) lg[j] += gv * KIN(29)[((size_t)l * 1024 + k) * 4 + j];
#pragma unroll
            for (int j = 0; j < 32; ++j) lg[4 + j] += gv * KIN(31)[((size_t)l * 1024 + k) * 32 + j];
        }
        gerr = wave_max(gerr);
#pragma unroll
        for (int j = 0; j < 36; ++j) lg[j] = wave_sum(lg[j]);
#pragma unroll
        for (int j = 0; j < 4; ++j) lg[j] += KIN(30)[l * 4 + j];
#pragma unroll
        for (int j = 0; j < 32; ++j) lg[4 + j] += KIN(32)[l * 32 + j];
        int grp = 0; float bestg = lg[0];
#pragma unroll
        for (int j = 1; j < 4; ++j) if (lg[j] > bestg) { bestg = lg[j]; grp = j; }
        float den = 0.f;
#pragma unroll
        for (int j = 0; j < 4; ++j) den += __expf(lg[j] - bestg);
        float l8[8];
#pragma unroll
        for (int j = 0; j < 8; ++j) { float v = 0.f;
#pragma unroll
            for (int q = 0; q < 4; ++q) v = (grp == q) ? lg[4 + q * 8 + j] : v;
            l8[j] = v; }
        int i0 = 0; float v0 = l8[0];
#pragma unroll
        for (int j = 1; j < 8; ++j) if (l8[j] > v0) { v0 = l8[j]; i0 = j; }
        int i1 = -1; float v1 = -3.0e38f;
#pragma unroll
        for (int j = 0; j < 8; ++j) if (j != i0 && l8[j] > v1) { v1 = l8[j]; i1 = j; }
        const float e1 = __expf(v1 - v0), w0 = 1.f / (1.f + e1) / den, w1 = e1 / (1.f + e1) / den;
        if (gerr > 0.05f && F.lane == 0) dbg_flag(F, 1);
        bool bad = false;
        if (fabsf(gatew[row * 2] - w0) > 1e-3f || fabsf(gatew[row * 2 + 1] - w1) > 1e-3f) bad = true;
        const int ea = grp * 8 + i0, eb = grp * 8 + i1; bool fa = false, fb = false;
        for (int q = F.lane; q < (int)cnt[ea]; q += 64) if (list[(size_t)ea * LIST_CAP + q] == row * 2) fa = true;
        for (int q = F.lane; q < (int)cnt[eb]; q += 64) if (list[(size_t)eb * LIST_CAP + q] == row * 2 + 1) fb = true;
        if (!__any(fa) || !__any(fb)) bad = true;
        if (bad && F.lane == 0) dbg_flag(F, 2);
    }
}
__device__ __forceinline__ void dbg_final(const Ctx& F) {
    const unsigned flags = ((const unsigned*)(F.ws + WS_CTL))[CW_FLAGS];
    for (int row = F.gw; row < LAT_ROWS; row += F.NGW) {
        bool zero = false;
        for (int j = 0; j < 4; ++j) { const int lo = 512 * ((1 << j) - 1), hi = 512 * ((2 << j) - 1); if (((flags >> j) & 1u) && row >= lo && row < hi) zero = true; }
#pragma unroll
        for (int j = 0; j < 4; ++j) { const int col = 4 * F.lane + 256 * j; f32x4 xv = *(const f32x4*)(KIN(0) + (size_t)row * DM + col); if (zero) xv = (f32x4){0.f, 0.f, 0.f, 0.f};
            *(f32x4*)(F.out + (size_t)row * DM + col) = xv; }
    }
}
#endif

#ifdef DBG_TS
__device__ __forceinline__ void dbg_ts_final(const Ctx& F) {
    const unsigned long long* tsb = (const unsigned long long*)(F.ws + WS_CTL + 512 * 1024);
    unsigned long long da = 0, db = 0;
    for (int ph = 0; ph < NPH - 1; ++ph) { const unsigned long long d = tsb[ph + 1] - tsb[ph];
        if ((DBG_TSA >> ph) & 1ull) da += d; if ((DBG_TSB >> ph) & 1ull) db += d; }
    const int nz = (int)(da * 8 / 100) < LAT_ROWS ? (int)(da * 8 / 100) : LAT_ROWS;
    for (int row = F.gw; row < LAT_ROWS; row += F.NGW) {
#pragma unroll
        for (int j = 0; j < 4; ++j) { const int col = 4 * F.lane + 256 * j; f32x4 xv = *(const f32x4*)(KIN(0) + (size_t)row * DM + col); if (row < nz) xv = (f32x4){0.f, 0.f, 0.f, 0.f};
            if (row == 0 && col == 0) xv[0] = (float)db;
            *(f32x4*)(F.out + (size_t)row * DM + col) = xv; }
    }
}
#endif

__device__ __forceinline__ void run_phase(const Ctx& F0, int ph, int sub = 3) {
    Ctx F = F0;
    asm volatile("" : "+s"(F.ws), "+s"(F.out), "+s"(F.bid), "+s"(F.G));
    asm volatile("" : "+v"(F.tid));
    F.lane = F.tid & 63; F.wave = __builtin_amdgcn_readfirstlane(F.tid >> 6); F.gw = F.bid * 8 + F.wave; F.NGW = F.G * 8;
    { unsigned ldsb = (unsigned)(uintptr_t)F0.lds; asm volatile("" : "+s"(ldsb)); F.lds = (LAS unsigned char*)(uintptr_t)ldsb; }
#ifndef T_NO_P0
    if (ph == 0) {
        if (F.bid < 192) p0_ada(F);
        else if (F.bid == 192) p0_rope(F);
        else if (F.bid >= 193) p0_router_t(F);
        p0_weights(F);
        return;
    }
#endif
#ifdef DBG_CHECKS
    if (ph == NPH - 1) { dbg_final(F); return; }
    if (ph >= 100) { dbg_mod_check(F, ph - 100); return; }
#endif
#ifdef DBG_TS
    if (ph == NPH - 1) { dbg_ts_final(F); return; }
#endif
    if (ph == NPH - 1) { rows_final(F); return; }
    if (ph >= 60) return;
    int l, step; { int q = ph - 1; if (q < 9) { l = 0; step = q; } else if (q < 16) { l = 1; step = q - 9; } else if (q < 25) { l = 2; step = q - 16; } else { l = 3; step = q - 25; } }
    const bool even = (l & 1) == 0; const int i = l >> 1;
    int gid = G_NONE, kind = K_NONE;
    if (even) {
        switch (step) { case 0: kind = K_NORM1; break; case 1: gid = G_INPROJ; break; case 2: kind = K_MLA_PRE_S5A; break; case 3: gid = G_MLA; break; case 4: kind = K_MLA_POST; break;
                        case 5: kind = K_S5B_ATT; gid = G_GLU; break; case 6: gid = G_OUT; break; case 7: kind = K_NORM2; break; default: gid = G_MOE1; break; }
    } else {
        switch (step) { case 0: kind = K_NORM1; break; case 1: gid = G_QKV; break; case 2: kind = K_GQA_POST; break; case 3: kind = K_ATT_GQA; break; case 4: gid = G_OUT; break;
                        case 5: kind = K_NORM2; break; default: gid = G_MOE1; break; }
    }
    switch (kind) {
#ifndef T_NO_ROWS
    case K_NORM1: build_router_tab(F, l); rows_norm1(F, l);
#ifndef T_NO_S5
        if (even && F.bid < 8) { const int w = F.bid * 8 + F.wave, dd = w >> 5, g = w & 31;
            s5::Params SP{KIN(10) + (size_t)i * 4096, KIN(11) + (size_t)i * 4096, KIN(12) + i * 64, KIN(13) + (size_t)i * 65536, KIN(14) + (size_t)i * 65536,
                      KIN(15) + (size_t)i * 65536, KIN(16) + (size_t)i * 65536, KIN(17) + i * 512};
            s5::build_tab(SP, dd, g, F.lane, (u32x4*)(F.ws + WS_S5TAB) + (size_t)(i * 64 + dd * 32 + g) * (s5::TAB_BYTES / 16)); }
#endif
        break;
    case K_NORM2: rows_norm2_router(F, l); break;
#endif
    case K_MLA_PRE_S5A: {
        rows_mla_pre(F, i);
        s5::Params SP{KIN(10) + (size_t)i * 4096, KIN(11) + (size_t)i * 4096, KIN(12) + i * 64, KIN(13) + (size_t)i * 65536, KIN(14) + (size_t)i * 65536,
                      KIN(15) + (size_t)i * 65536, KIN(16) + (size_t)i * 65536, KIN(17) + i * 512};
#ifndef T_NO_S5
        if (F.wave >= 4) defer_convert(F, i * 2);
        for (int it = F.gw; it < s5::NITEMS; it += F.NGW) s5::pass_a_item(SP, (const u32x4*)(F.ws + WS_S5TAB) + (size_t)i * 64 * (s5::TAB_BYTES / 16), (const bf16*)(F.ws + WS_ZRAW), (float*)(F.ws + WS_E2), it, F.lane);
        if (F.wave < 4) defer_convert(F, i * 2);
#endif
    } break;
    case K_MLA_POST: {
        rows_mla_post(F, i);
        s5::Params SP{KIN(10) + (size_t)i * 4096, KIN(11) + (size_t)i * 4096, KIN(12) + i * 64, KIN(13) + (size_t)i * 65536, KIN(14) + (size_t)i * 65536,
                      KIN(15) + (size_t)i * 65536, KIN(16) + (size_t)i * 65536, KIN(17) + i * 512};
#ifndef T_NO_S5
        if (F.wave >= 4) defer_convert(F, i * 2 + 1);
        if (sub & 1) for (int it = F.gw; it < s5::NITEMS; it += F.NGW)
            s5::pass_b_item(SP, (const u32x4*)(F.ws + WS_S5TAB) + (size_t)i * 64 * (s5::TAB_BYTES / 16), (const bf16*)(F.ws + WS_ZRAW), (const float*)(F.ws + WS_E2), (bf16*)(F.ws + WS_GG), F.lds + F.wave * s5::HS_BYTES, it, F.lane);
        if (F.wave < 4) defer_convert(F, i * 2 + 1);
#endif
    } break;
    case K_S5B_ATT: {
        __syncthreads();
#ifndef T_NO_ATT
        if (sub & 2) attention_phase(F, l, true);
#endif
    } break;
    case K_GQA_POST: rows_gqa_post(F, i); break;
#ifndef T_NO_ATT
    case K_ATT_GQA: attention_phase(F, l, false); break;
#endif
    default: break;
    }
    if (gid != G_NONE) {
        unsigned char* ws = F.ws;
        const unsigned* cnt = (const unsigned*)(ws + WS_CTL) + CW_CNT + l * 64;
        if (gid == G_MOE1 || gid == G_MOE2) {
            if (F.tid == 0) { LAS int* tp = (LAS int*)(F.lds + MISC_OFF + 256); int acc = 0;
                for (int e = 0; e < NEXP; ++e) { tp[e] = acc; acc += ((int)cnt[e] + 255) >> 8; } tp[NEXP] = acc; }
            __syncthreads();
        }
#ifdef DBG_NOCTX_DRY
#define CTXDRY if (!F.dry)
#else
#define CTXDRY
#endif
#define PROB_COMMON(P) P.G = F.G; P.c = F.bid; P.list = (const int*)(ws + WS_LIST); P.cnt = cnt; P.tp = (const LAS int*)(F.lds + MISC_OFF + 256); \
        P.l = l; P.ws = ws; P.O = nullptr; P.xlat = nullptr; P.xctx = nullptr;
        switch (gid) {
#ifndef T_NO_GEMM
        case G_INPROJ: { pg8::Prob<G_INPROJ> P; PROB_COMMON(P); P.A = (const char*)(ws + WS_H); P.B = (const char*)(ws + WS_W_IN) + (size_t)i * 1024 * 1024 * 2; P.O = (bf16*)(ws + WS_ZRAW); pg8::gemm_phase(F.lds, P, F.tid); CTXDRY pg8::ctx_gemm(F.lds, P, F.tid); } break;
        case G_MLA: {
#ifndef T_NO_S5
            if (F.wave == 0 && F.bid < 256) { s5::Params SP{KIN(10) + (size_t)i * 4096, KIN(11) + (size_t)i * 4096, KIN(12) + i * 64, KIN(13) + (size_t)i * 65536, KIN(14) + (size_t)i * 65536,
                      KIN(15) + (size_t)i * 65536, KIN(16) + (size_t)i * 65536, KIN(17) + i * 512};
                s5::prefix_wave(SP, (float*)(ws + WS_E2), F.bid, F.lane); }
#endif
            pg8::Prob<G_MLA> P; PROB_COMMON(P); P.A = (const char*)(ws + WS_ACAT); P.B = (const char*)(ws + WS_W_MLA) + (size_t)i * 1792 * 256 * 2; P.O = (bf16*)(ws + WS_QKVM); pg8::gemm_phase(F.lds, P, F.tid); } break;
        case G_GLU: { pg8::Prob<G_GLU> P; PROB_COMMON(P); P.c = F.G - 1 - F.bid;
            P.A = (const char*)(ws + WS_GG); P.B = (const char*)(ws + WS_W_GLU) + (size_t)i * 512 * 512 * 2; pg8::gemm_phase(F.lds, P, F.tid); } break;
        case G_OUT: { pg8::Prob<G_OUT> P; PROB_COMMON(P); P.A = (const char*)(ws + WS_MIX); P.B = (const char*)(ws + (even ? WS_W_OUTE : WS_W_OUTO)) + (size_t)i * 1024 * 1024 * 2;
            P.xlat = KIN(0); P.xctx = KIN(2); pg8::gemm_phase(F.lds, P, F.tid); if (l < DEPTH - 1) pg8::ctx_gemm(F.lds, P, F.tid); } break;
        case G_QKV: { pg8::Prob<G_QKV> P; PROB_COMMON(P); P.A = (const char*)(ws + WS_H); P.B = (const char*)(ws + WS_W_QKV) + (size_t)i * 2048 * 1024 * 2; P.O = (bf16*)(ws + WS_ZRAW); pg8::gemm_phase(F.lds, P, F.tid); CTXDRY pg8::ctx_gemm(F.lds, P, F.tid); } break;
        default: { unsigned* ready = (unsigned*)(ws + WS_CTL) + CW_READY + l * READY_L;
            { pg8::Prob<G_MOE1> P; PROB_COMMON(P); P.ready = ready; P.A = (const char*)(ws + WS_H); P.B = (const char*)(ws + WS_W_GU) + (size_t)l * 32 * 1024 * 1024 * 2; pg8::gemm_phase(F.lds, P, F.tid); }
            { pg8::Prob<G_MOE2> P; PROB_COMMON(P); P.ready = ready; P.A = (const char*)(ws + WS_ACT); P.B = (const char*)(ws + WS_W_DN) + (size_t)l * 32 * 1024 * 512 * 2; pg8::gemm_phase(F.lds, P, F.tid); } } break;
#else
        default: break;
#endif
        }
#undef PROB_COMMON
        return;
    }
}

struct Args { const float* in[36]; float* out; unsigned char* ws; int ph_lo, ph_hi; };

__global__ void __launch_bounds__(512, 2) mega(Args args) {
    extern __shared__ __attribute__((aligned(16))) unsigned char lds_[];
    Ctx F;
    F.out = args.out; F.ws = args.ws;
    F.lds = (LAS unsigned char*)lds_;
    F.tid = threadIdx.x; F.lane = F.tid & 63; F.wave = __builtin_amdgcn_readfirstlane(F.tid >> 6);
    F.G = gridDim.x; F.bid = blockIdx.x; F.gw = blockIdx.x * 8 + F.wave; F.NGW = F.G * 8;
    volatile LAS unsigned* MISC = (volatile LAS unsigned*)(F.lds + MISC_OFF);
    for (int u = F.tid; u < (LDS_BYTES - RING_BYTES) / 4; u += 512) ((LAS unsigned*)(F.lds + RING_BYTES))[u] = 0u;
    __syncthreads();
    const int lo = args.ph_lo & 0xfff, hi = args.ph_hi & 0xfff; F.dry = (args.ph_hi >> 12) & 1; const int subsel = ((args.ph_hi >> 13) & 3) ? ((args.ph_hi >> 13) & 3) : 3;
    XcdBarrier bar; bar.bar = (unsigned*)(F.ws + WS_CTL) + CW_BAR; bar.x = 0; bar.st = nullptr;
    if (hi - lo > 1) bar = xcd_barrier_post((unsigned*)(F.ws + WS_CTL) + CW_BAR, MISC + 8);
#ifdef DBG_TS
    unsigned long long* tsb = (unsigned long long*)(F.ws + WS_CTL + 512 * 1024);
    if (blockIdx.x == 0 && threadIdx.x == 0) tsb[0] = __builtin_amdgcn_s_memrealtime();
#endif
    for (int ph = lo; ph < hi; ++ph) {
#ifdef DBG_REP
        if ((DBG_REP >> ph) & 1ull) { for (int rr = 0; rr < DBG_REPN; ++rr) { run_phase(F, ph, DBG_REPSUB); __syncthreads(); } }
#endif
        run_phase(F, ph, subsel);
#ifdef DBG_TS
        if (ph == NPH - 2 && blockIdx.x == 0 && threadIdx.x == 0) { asm volatile("s_waitcnt vmcnt(0)" ::: "memory"); tsb[ph + 1] = __builtin_amdgcn_s_memrealtime(); __threadfence(); }
#endif
        if (ph + 1 < hi) { XcdBarrier b2 = bar; asm volatile("" : "+s"(b2.bar), "+s"(b2.x)); xcd_barrier(b2); }
#ifdef DBG_TS
        if (ph < NPH - 2 && blockIdx.x == 0 && threadIdx.x == 0) tsb[ph + 1] = __builtin_amdgcn_s_memrealtime();
#endif
    }
}

#ifndef MK_MULTI
#define MK_MULTI 1
#endif
extern "C" void kernel_launch(void* const* d_in, const int* in_sizes, int n_in, void* d_out, int out_size, void* d_ws, size_t ws_size, hipStream_t stream) {
    static int grid = 0;
    if (grid == 0) {
        if (n_in != 36 || in_sizes[0] != LAT_ROWS * DM || out_size != LAT_ROWS * DM || ws_size < WS_END) {
            fprintf(stderr, "kernel_launch: unexpected shapes: n_in %d in0 %d out %d ws %zu (need >= %zu)\n", n_in, n_in > 0 ? in_sizes[0] : -1, out_size, ws_size, (size_t)WS_END); grid = -1; return; }
        int dev = 0, cus = 0, per_cu = 0;
        if (hipGetDevice(&dev) != hipSuccess || hipDeviceGetAttribute(&cus, hipDeviceAttributeMultiprocessorCount, dev) != hipSuccess) { fprintf(stderr, "kernel_launch: device query failed\n"); grid = -1; return; }
        if (hipFuncSetAttribute((const void*)mega, hipFuncAttributeMaxDynamicSharedMemorySize, LDS_BYTES) != hipSuccess) { fprintf(stderr, "kernel_launch: hipFuncSetAttribute failed\n"); grid = -1; return; }
        if (hipOccupancyMaxActiveBlocksPerMultiprocessor(&per_cu, (const void*)mega, 512, LDS_BYTES) != hipSuccess || per_cu < 1) { fprintf(stderr, "kernel_launch: occupancy query says %d\n", per_cu); per_cu = 1; }
        (void)hipGetLastError();
        grid = cus;
    }
    if (grid < 0) return;
    (void)hipMemsetAsync((char*)d_ws + WS_CTL, 0, CTL_ZERO_BYTES, stream);
    Args a{};
    for (int i = 0; i < 36; ++i) a.in[i] = (const float*)d_in[i];
    a.out = (float*)d_out; a.ws = (unsigned char*)d_ws;
#if MK_MULTI
#ifndef DBG_STOP_PH
#define DBG_STOP_PH (NPH - 2)
#endif
    for (int p = 0; p < NPH; ++p) {
        if (p > DBG_STOP_PH && p != NPH - 1) continue;
#ifdef DBG_CHECKS
        if (p == NPH - 1) { a.ph_lo = 100 + DBG_CHECK_L; a.ph_hi = a.ph_lo + 1; hipLaunchKernelGGL(mega, dim3(grid), dim3(512), LDS_BYTES, stream, a); }
#endif
        a.ph_lo = p; a.ph_hi = p + 1;
#ifdef DBG_NOOPS
        if (p == 5) { a.ph_lo = 61; a.ph_hi = 62; for (int rr = 0; rr < DBG_NOOPS; ++rr) hipLaunchKernelGGL(mega, dim3(grid), dim3(512), LDS_BYTES, stream, a); a.ph_lo = p; a.ph_hi = p + 1; }
#endif
#ifdef DBG_HREP
        if ((DBG_HREP >> p) & 1ull) { a.ph_hi = (p + 1) | 0x1000 | (DBG_HSUB << 13); for (int rr = 0; rr < DBG_HREPN; ++rr) hipLaunchKernelGGL(mega, dim3(grid), dim3(512), LDS_BYTES, stream, a); a.ph_hi = p + 1; }
#endif
        hipLaunchKernelGGL(mega, dim3(grid), dim3(512), LDS_BYTES, stream, a);
    }
#else
    a.ph_lo = 0; a.ph_hi = NPH;
    void* kargs[] = {&a};
    hipError_t e = hipLaunchCooperativeKernel((const void*)mega, dim3(grid), dim3(512), kargs, LDS_BYTES, stream);
    if (e != hipSuccess) fprintf(stderr, "kernel_launch: cooperative launch failed: %s (grid %d)\n", hipGetErrorString(e), grid);
#endif
    const hipError_t le = hipPeekAtLastError();
    if (le != hipSuccess) fprintf(stderr, "kernel_launch: launch failed: %s\n", hipGetErrorName(le));
}
```
